# Optimizing an MI355X kernel written in HIP

```python
import math
import jax
import jax.numpy as jnp
from jax import lax
import numpy as np

D_MODEL = 1024
BATCH = 1
SEQ = 16384
DEPTH = 2

HEAD_DIM = 64
HEADS_PER_MIXER = 4
N_MIXERS = 4
N_HEADS = HEADS_PER_MIXER * N_MIXERS
GROUP_WIDTH = HEADS_PER_MIXER * HEAD_DIM
MIX_WIDTH = N_HEADS * HEAD_DIM
MLA_Q_RANK = 256
MLA_KV_RANK = 128
MLA_NOPE = 64
MLA_ROPE = 32
MLA_V = HEAD_DIM
ROPE_THETA = 10000.0
QBLOCK = 128
MOBA_BLOCK = 256
MOBA_TOPK = 3
DIL_PATTERNS = ((128, 1), (512, 4), (2048, 16))
N_EXPERTS = 32
TOP_K = 4
D_EXPERT = 1024
SWIGLU_LIMIT = 7.0
SWIGLU_ALPHA = 1.702
EXPERT_BLOCK = 128
NORM_EPS = 1e-6
NEG_INF = -1e30
IN_COLS = MLA_Q_RANK + MLA_KV_RANK + MLA_ROPE + 3 * GROUP_WIDTH + HEADS_PER_MIXER + 6 * GROUP_WIDTH

kernel_name = 'hybrid_parallel_heads_mla_fox_moba_dilated_moe'


def rms_norm(x, g):
    xf = x.astype(jnp.float32)
    y = xf * lax.rsqrt(jnp.mean(xf * xf, axis=-1, keepdims=True) + NORM_EPS)
    return (y * g.astype(jnp.float32)).astype(x.dtype)


def alibi_slopes(n):
    return jnp.asarray(2.0 ** (-8.0 * np.arange(1, n + 1) / n), dtype=jnp.float32)


def rope(x, pos):
    half = x.shape[-1] // 2
    inv = 1.0 / (ROPE_THETA ** (jnp.arange(half, dtype=jnp.float32) / half))
    ang = pos.astype(jnp.float32)[:, None] * inv[None, :]
    cos = jnp.cos(ang)[None, :, None, :]
    sin = jnp.sin(ang)[None, :, None, :]
    xf = x.astype(jnp.float32)
    x1, x2 = xf[..., :half], xf[..., half:]
    return jnp.concatenate([x1 * cos - x2 * sin, x2 * cos + x1 * sin], axis=-1).astype(x.dtype)


def pad_seq(a, mult, axis):
    n = a.shape[axis]
    target = -(-n // mult) * mult
    if target == n:
        return a
    widths = [(0, 0)] * a.ndim
    widths[axis] = (0, target - n)
    return jnp.pad(a, widths)


def causal_block_attention(q, k, v, scale, decay_cum=None):
    B, H, S, dq = q.shape
    nb = S // QBLOCK
    qb = q.reshape(B, H, nb, QBLOCK, dq).transpose(2, 0, 1, 3, 4)
    k_pos = jnp.arange(S)

    def one_block(args):
        qi, bi = args
        s = jnp.einsum('bhqd,bhkd->bhqk', qi, k).astype(jnp.float32) * scale
        q_pos = bi * QBLOCK + jnp.arange(QBLOCK)
        if decay_cum is not None:
            fq = lax.dynamic_slice_in_dim(decay_cum, bi * QBLOCK, QBLOCK, axis=2)
            s = s + fq[..., :, None] - decay_cum[..., None, :]
        s = jnp.where(k_pos[None, :] <= q_pos[:, None], s, NEG_INF)
        p = jax.nn.softmax(s, axis=-1)
        return jnp.einsum('bhqk,bhkd->bhqd', p.astype(v.dtype), v)

    out = lax.map(one_block, (qb, jnp.arange(nb)))
    return out.transpose(1, 2, 0, 3, 4).reshape(B, H, S, v.shape[-1])


def moba_attention(q, k, v, slopes):
    B, H, S, d = q.shape
    scale = d ** -0.5
    q, k, v = (pad_seq(a, MOBA_BLOCK, 2) for a in (q, k, v))
    Sp = q.shape[2]
    nblk = Sp // MOBA_BLOCK
    topk = min(MOBA_TOPK, nblk)
    nq = Sp // QBLOCK
    kb = k.reshape(B, H, nblk, MOBA_BLOCK, d)
    vb = v.reshape(B, H, nblk, MOBA_BLOCK, d)
    k_mean = jnp.mean(kb.astype(jnp.float32), axis=3)
    own = jnp.arange(Sp) // MOBA_BLOCK
    past = jnp.arange(nblk)[None, :] < own[:, None]
    gate = jnp.einsum('bhsd,bhnd->bhsn', q.astype(jnp.float32), k_mean)
    gate = jnp.where(past, gate, NEG_INF)
    _, idx = lax.top_k(gate, topk)
    valid = idx < own[:, None]
    chunk = lambda a: a.reshape(B, H, nq, QBLOCK, a.shape[-1]).transpose(2, 0, 1, 3, 4)
    b_ix = jnp.arange(B)[:, None, None, None]
    h_ix = jnp.arange(H)[None, :, None, None]
    rel = jnp.arange(MOBA_BLOCK)
    sl = slopes.astype(jnp.float32)
    n_sel = topk * MOBA_BLOCK

    def one_chunk(args):
        qc, idxc, validc, ci = args
        t = ci * QBLOCK + jnp.arange(QBLOCK)
        kg = kb[b_ix, h_ix, idxc]
        vg = vb[b_ix, h_ix, idxc]
        kpos = idxc[..., None] * MOBA_BLOCK + rel
        s_sel = jnp.einsum('bhqd,bhqnjd->bhqnj', qc, kg).astype(jnp.float32) * scale
        s_sel = s_sel - sl[None, :, None, None, None] * (t[:, None, None] - kpos).astype(jnp.float32)
        s_sel = jnp.where(validc[..., None], s_sel, NEG_INF)
        start = (ci * QBLOCK) // MOBA_BLOCK * MOBA_BLOCK
        ko = lax.dynamic_slice_in_dim(k, start, MOBA_BLOCK, axis=2)
        vo = lax.dynamic_slice_in_dim(v, start, MOBA_BLOCK, axis=2)
        kpos_o = start + rel
        s_own = jnp.einsum('bhqd,bhjd->bhqj', qc, ko).astype(jnp.float32) * scale
        s_own = s_own - sl[None, :, None, None] * (t[:, None] - kpos_o[None, :]).astype(jnp.float32)
        s_own = jnp.where(kpos_o[None, :] <= t[:, None], s_own, NEG_INF)
        s_all = jnp.concatenate([s_sel.reshape(B, H, QBLOCK, n_sel), s_own], axis=-1)
        p = jax.nn.softmax(s_all, axis=-1).astype(v.dtype)
        p_sel = p[..., :n_sel].reshape(B, H, QBLOCK, topk, MOBA_BLOCK)
        return (jnp.einsum('bhqnj,bhqnjd->bhqd', p_sel, vg)
                + jnp.einsum('bhqj,bhjd->bhqd', p[..., n_sel:], vo))

    out = lax.map(one_chunk, (chunk(q), chunk(idx), chunk(valid), jnp.arange(nq)))
    return out.transpose(1, 2, 0, 3, 4).reshape(B, H, Sp, d)[:, :, :S]


def dilated_attention(q, k, v, slopes):
    B, H, S, d = q.shape
    scale = d ** -0.5
    outs, lses = [], []
    for window, r in DIL_PATTERNS:
        span = window // r
        Sp = -(-S // (r * span)) * (r * span)
        L = Sp // r
        nb = L // span

        def to_sub(a):
            dd = a.shape[-1]
            a = pad_seq(a, r * span, 2)
            return a.reshape(B, H, L, r, dd).transpose(0, 1, 3, 2, 4).reshape(B, H, r, nb, span, dd)

        def with_prev(a):
            prev = jnp.concatenate([jnp.zeros_like(a[:, :, :, :1]), a[:, :, :, :-1]], axis=3)
            return jnp.concatenate([prev, a], axis=4)

        qs = to_sub(q)
        kc = with_prev(to_sub(k))
        vc = with_prev(to_sub(v))
        i = jnp.arange(span)
        j = jnp.arange(2 * span)
        dist = i[:, None] + span - j[None, :]
        valid = (dist >= 0) & (dist <= span)
        valid = valid[None] & ((jnp.arange(nb)[:, None, None] > 0) | (j[None, None, :] >= span))
        s = jnp.einsum('bhrnqd,bhrnjd->bhrnqj', qs, kc).astype(jnp.float32) * scale
        s = s - slopes.astype(jnp.float32)[None, :, None, None, None, None] * (dist * r).astype(jnp.float32)
        s = jnp.where(valid, s, NEG_INF)
        lse = jax.nn.logsumexp(s, axis=-1)
        p = jnp.exp(s - lse[..., None])
        o = jnp.einsum('bhrnqj,bhrnjd->bhrnqd', p.astype(v.dtype), vc)
        dv = v.shape[-1]
        outs.append(o.reshape(B, H, r, L, dv).transpose(0, 1, 3, 2, 4).reshape(B, H, Sp, dv)[:, :, :S])
        lses.append(lse.reshape(B, H, r, L).transpose(0, 1, 3, 2).reshape(B, H, Sp)[:, :, :S])
    w = jax.nn.softmax(jnp.stack(lses), axis=0)
    o = jnp.sum(w[..., None] * jnp.stack(outs).astype(jnp.float32), axis=0)
    return o.astype(q.dtype)


def token_mixers(h, w_in, mla_cq_g, mla_w_uq, mla_ckv_g, mla_w_ukv, mla_q_g, mla_k_g,
                 fox_q_g, fox_k_g, fox_b_f, moba_q_g, moba_k_g, dil_q_g, dil_k_g, w_out):
    B, S, _ = h.shape
    Hm = HEADS_PER_MIXER
    proj = h @ w_in
    sizes = [MLA_Q_RANK, MLA_KV_RANK, MLA_ROPE,
             GROUP_WIDTH, GROUP_WIDTH, GROUP_WIDTH, Hm,
             GROUP_WIDTH, GROUP_WIDTH, GROUP_WIDTH,
             GROUP_WIDTH, GROUP_WIDTH, GROUP_WIDTH]
    splits = [int(s) for s in np.cumsum(sizes)[:-1]]
    cq, ckv, kr, fq, fk, fv, flog, mq, mk, mv, dq, dk, dv = jnp.split(proj, splits, axis=-1)
    pos = jnp.arange(S)
    heads = lambda a: a.reshape(B, S, Hm, -1)
    bhsd = lambda a: a.transpose(0, 2, 1, 3)

    q_a = heads(rms_norm(cq, mla_cq_g) @ mla_w_uq)
    kv_a = heads(rms_norm(ckv, mla_ckv_g) @ mla_w_ukv)
    k_a = jnp.concatenate([kv_a[..., :MLA_NOPE],
                           jnp.broadcast_to(kr[:, :, None, :], (B, S, Hm, MLA_ROPE))], axis=-1)
    v_a = kv_a[..., MLA_NOPE:]
    q_a = rms_norm(q_a, mla_q_g)
    k_a = rms_norm(k_a, mla_k_g)
    q_a = jnp.concatenate([q_a[..., :MLA_NOPE], rope(q_a[..., MLA_NOPE:], pos)], axis=-1)
    k_a = jnp.concatenate([k_a[..., :MLA_NOPE], rope(k_a[..., MLA_NOPE:], pos)], axis=-1)
    o_a = causal_block_attention(bhsd(q_a), bhsd(k_a), bhsd(v_a), (MLA_NOPE + MLA_ROPE) ** -0.5)

    log_f = jax.nn.log_sigmoid((flog + fox_b_f).astype(jnp.float32))
    decay_cum = jnp.cumsum(log_f, axis=1).transpose(0, 2, 1)
    o_b = causal_block_attention(bhsd(rms_norm(heads(fq), fox_q_g)), bhsd(rms_norm(heads(fk), fox_k_g)),
                                 bhsd(heads(fv)), HEAD_DIM ** -0.5, decay_cum)

    slopes = alibi_slopes(2 * Hm)
    o_c = moba_attention(bhsd(rms_norm(heads(mq), moba_q_g)), bhsd(rms_norm(heads(mk), moba_k_g)),
                         bhsd(heads(mv)), slopes[1::2])
    o_d = dilated_attention(bhsd(rms_norm(heads(dq), dil_q_g)), bhsd(rms_norm(heads(dk), dil_k_g)),
                            bhsd(heads(dv)), slopes[0::2])

    o = jnp.concatenate([o_a, o_b.astype(o_a.dtype), o_c.astype(o_a.dtype), o_d.astype(o_a.dtype)], axis=1)
    o = o.transpose(0, 2, 1, 3).reshape(B, S, MIX_WIDTH)
    return o @ w_out


def moe_ffn(h, router_w, router_b, w1, b1, w2, b2):
    B, S, D = h.shape
    n_tok = B * S
    hf = h.reshape(n_tok, D)
    logits = (hf @ router_w + router_b).astype(jnp.float32)
    top_val, top_idx = lax.top_k(logits, TOP_K)
    gates = jax.nn.softmax(top_val, axis=-1)
    m = n_tok * TOP_K
    e_flat = top_idx.reshape(m)
    tok_flat = jnp.repeat(jnp.arange(n_tok, dtype=jnp.int32), TOP_K)
    g_flat = gates.reshape(m)
    order = jnp.argsort(e_flat)
    e_sorted = e_flat[order]
    counts = jnp.bincount(e_flat, length=N_EXPERTS)
    padded = (counts + EXPERT_BLOCK - 1) // EXPERT_BLOCK * EXPERT_BLOCK
    pad_end = jnp.cumsum(padded)
    pad_start = pad_end - padded
    start = jnp.cumsum(counts) - counts
    dest = pad_start[e_sorted] + jnp.arange(m) - start[e_sorted]
    m_pad = -(-m // EXPERT_BLOCK) * EXPERT_BLOCK + N_EXPERTS * EXPERT_BLOCK
    row_tok = jnp.zeros((m_pad,), jnp.int32).at[dest].set(tok_flat[order])
    row_gate = jnp.zeros((m_pad,), jnp.float32).at[dest].set(g_flat[order])
    n_blk = m_pad // EXPERT_BLOCK
    blk_expert = jnp.minimum(jnp.searchsorted(pad_end, jnp.arange(n_blk) * EXPERT_BLOCK, side='right'),
                             N_EXPERTS - 1)
    xs = hf[row_tok].reshape(n_blk, EXPERT_BLOCK, D)

    def expert_block(args):
        xb, e = args
        gu = xb @ w1[e] + b1[e]
        g = jnp.minimum(gu[:, :D_EXPERT], SWIGLU_LIMIT)
        u = jnp.clip(gu[:, D_EXPERT:], -SWIGLU_LIMIT, SWIGLU_LIMIT)
        y = (u + 1.0) * g * jax.nn.sigmoid(SWIGLU_ALPHA * g)
        return y @ w2[e] + b2[e]

    ys = lax.map(expert_block, (xs, blk_expert)).reshape(m_pad, D)
    out = jnp.zeros((n_tok, D), jnp.float32).at[row_tok].add(ys.astype(jnp.float32) * row_gate[:, None])
    return out.reshape(B, S, D).astype(h.dtype)


def setup_inputs(seed: int = 0) -> dict:
    key = jax.random.key(seed)
    ks = jax.random.split(key, 27)
    nrm = lambda k, shape, s: s * jax.random.normal(k, shape, jnp.float32)
    gain = lambda k, shape: 1.0 + 0.02 * jax.random.normal(k, shape, jnp.float32)
    L, D, E, F, Hm = DEPTH, D_MODEL, N_EXPERTS, D_EXPERT, HEADS_PER_MIXER
    return {
        'x': nrm(ks[0], (BATCH, SEQ, D), 1.0),
        'c': nrm(ks[1], (BATCH, D), 1.0),
        'w_mod': nrm(ks[2], (L, D, 6 * D), 0.5 * D ** -0.5),
        'b_mod': nrm(ks[3], (L, 6 * D), 0.01),
        'norm1_g': gain(ks[4], (L, D)),
        'norm2_g': gain(ks[5], (L, D)),
        'w_in': nrm(ks[6], (L, D, IN_COLS), D ** -0.5),
        'mla_cq_g': gain(ks[7], (L, MLA_Q_RANK)),
        'mla_w_uq': nrm(ks[8], (L, MLA_Q_RANK, Hm * (MLA_NOPE + MLA_ROPE)), MLA_Q_RANK ** -0.5),
        'mla_ckv_g': gain(ks[9], (L, MLA_KV_RANK)),
        'mla_w_ukv': nrm(ks[10], (L, MLA_KV_RANK, Hm * (MLA_NOPE + MLA_V)), MLA_KV_RANK ** -0.5),
        'mla_q_g': gain(ks[11], (L, MLA_NOPE + MLA_ROPE)),
        'mla_k_g': gain(ks[12], (L, MLA_NOPE + MLA_ROPE)),
        'fox_q_g': gain(ks[13], (L, HEAD_DIM)),
        'fox_k_g': gain(ks[14], (L, HEAD_DIM)),
        'fox_b_f': nrm(ks[15], (L, Hm), 0.1),
        'moba_q_g': gain(ks[16], (L, HEAD_DIM)),
        'moba_k_g': gain(ks[17], (L, HEAD_DIM)),
        'dil_q_g': gain(ks[18], (L, HEAD_DIM)),
        'dil_k_g': gain(ks[19], (L, HEAD_DIM)),
        'w_out': nrm(ks[20], (L, MIX_WIDTH, D), MIX_WIDTH ** -0.5),
        'router_w': nrm(ks[21], (L, D, E), D ** -0.5),
        'router_b': nrm(ks[22], (L, E), 0.01),
        'exp_w1': nrm(ks[23], (L, E, D, 2 * F), D ** -0.5),
        'exp_b1': nrm(ks[24], (L, E, 2 * F), 0.01),
        'exp_w2': nrm(ks[25], (L, E, F, D), F ** -0.5),
        'exp_b2': nrm(ks[26], (L, E, D), 0.01),
    }


def reference(x, c, w_mod, b_mod, norm1_g, norm2_g, w_in, mla_cq_g, mla_w_uq, mla_ckv_g, mla_w_ukv,
              mla_q_g, mla_k_g, fox_q_g, fox_k_g, fox_b_f, moba_q_g, moba_k_g, dil_q_g, dil_k_g, w_out,
              router_w, router_b, exp_w1, exp_b1, exp_w2, exp_b2):
    for l in range(DEPTH):
        mod = jax.nn.silu(c) @ w_mod[l] + b_mod[l]
        sh1, sc1, g1, sh2, sc2, g2 = jnp.split(mod[:, None, :], 6, axis=-1)
        h = rms_norm(x, norm1_g[l]) * (1 + sc1) + sh1
        x = x + g1 * token_mixers(h, w_in[l], mla_cq_g[l], mla_w_uq[l], mla_ckv_g[l], mla_w_ukv[l],
                                  mla_q_g[l], mla_k_g[l], fox_q_g[l], fox_k_g[l], fox_b_f[l],
                                  moba_q_g[l], moba_k_g[l], dil_q_g[l], dil_k_g[l], w_out[l])
        h = rms_norm(x, norm2_g[l]) * (1 + sc2) + sh2
        x = x + g2 * moe_ffn(h, router_w[l], router_b[l], exp_w1[l], exp_b1[l], exp_w2[l], exp_b2[l])
    return x
```

```cpp
#include <hip/hip_runtime.h>
#include <stdint.h>
#include <math.h>
#include <cstdio>

#define DI __device__ __forceinline__
#define LAS __attribute__((address_space(3)))
#define GAS __attribute__((address_space(1)))
namespace pg8 {
#define PG8_LAS __attribute__((address_space(3)))
typedef unsigned short bf16_t;
typedef short bf16x8 __attribute__((ext_vector_type(8)));
typedef float f32x4 __attribute__((ext_vector_type(4)));
typedef unsigned u32x4 __attribute__((ext_vector_type(4)));
constexpr int BM = 256, BK = 64, HALF = 128, HTB = HALF * BK * 2  , STAGE_BYTES = 8 * HTB, NXCD = 8, WGM = 8;

__host__ __device__ __forceinline__ int lds_byte(int r, int c) { const int st = (r >> 4) * 2 + (c >> 5), rr = r & 15, cc = c & 31, ob = rr * 64 + cc * 2; return st * 1024 + (ob ^ (((ob >> 9) & 1) << 5)); }
__host__ __device__ __forceinline__ void stage_rc(int b, int& R, int& C) { const int st = b / 1024, sb = b % 1024, swz = sb ^ (((sb >> 9) & 1) << 5); R = (st >> 1) * 16 + swz / 64; C = (st & 1) * 32 + (swz % 64) / 2; }
__host__ __device__ __forceinline__ int perm32(int rho) { const int n = rho >> 4, i = rho & 15; return 8 * (i >> 2) + 4 * n + (i & 3); }

struct Unit { int pm, pn; };
struct Gemm { const bf16_t* A; const bf16_t* Bt; int M, N, K; };

struct StaticOrder {
    int nM, nN, nwg, G, c;
    __host__ __device__ void init(int M, int N, int G_, int c_) { nM = M / BM; nN = N / BM; nwg = nM * nN; G = G_; c = c_; }
    __host__ __device__ bool next(int i, Unit& u) const {
        const long L = (long)i * G + c; if (L >= nwg) return false;
        int wgid = (int)L; { const int q = nwg / NXCD, r = nwg % NXCD, xcd = wgid % NXCD, off = wgid / NXCD; wgid = (xcd < r ? xcd * (q + 1) : r * (q + 1) + (xcd - r) * q) + off; }
        const int nig = WGM * nN, gid = wgid / nig, fm = gid * WGM, gsz = (nM - fm) < WGM ? (nM - fm) : WGM;
        u.pm = fm + ((wgid % nig) % gsz); u.pn = (wgid % nig) / gsz; return true;
    }
    __device__ __forceinline__ void a_ready(const Unit&) const {}
    __device__ __forceinline__ void done(const Unit&) const {}
};
__device__ __forceinline__ unsigned cvt_pk_bf16(float lo, float hi) { unsigned r; asm volatile("v_cvt_pk_bf16_f32 %0, %1, %2" : "=v"(r) : "v"(lo), "v"(hi)); return r; }
typedef float f32x2 __attribute__((ext_vector_type(2)));
struct EpiBf16Plain {
    static constexpr bool PERM = true, AFTER_DRAIN = false;
    bf16_t* O; int ldc;
    __device__ __forceinline__ void operator()(const f32x4 (&acc)[2][2][4][2], const Unit& u, int wr, int wc, int fr, int fq) const {
        const int row0 = u.pm * BM + wr * 64 + fr, col0 = u.pn * BM + wc * 32 + 8 * fq;
#pragma unroll
        for (int ai = 0; ai < 2; ++ai)
#pragma unroll
            for (int m = 0; m < 4; ++m) { bf16_t* rowp = O + (size_t)(row0 + ai * HALF + m * 16) * ldc + col0;
#pragma unroll
                for (int bj = 0; bj < 2; ++bj) { const f32x4 v0 = acc[ai][bj][m][0], v1 = acc[ai][bj][m][1];
                    u32x4 w; w.x = cvt_pk_bf16(v0[0], v0[1]); w.y = cvt_pk_bf16(v0[2], v0[3]); w.z = cvt_pk_bf16(v1[0], v1[1]); w.w = cvt_pk_bf16(v1[2], v1[3]);
                    *(u32x4*)(rowp + bj * HALF) = w; } }
    }
};
template <class Epi, class Sched, bool STAMP = false>
__device__ __forceinline__ void gemm_phase(PG8_LAS unsigned char* lds, const Gemm g, const Sched& S, const Epi& E, unsigned long long* stamps) {
    int tid_ = threadIdx.x; asm volatile("" : "+v"(tid_));
    const int tid = tid_, wid = __builtin_amdgcn_readfirstlane(tid >> 6), lane = tid & 63, wr = wid >> 2, wc = wid & 3, fr = lane & 15, fq = lane >> 4;
    const int K = g.K, nt = K / BK;
    int ts_lo = 0, ts_hi = 0, nts = 0; const unsigned long long rt_entry = STAMP ? (unsigned long long)wall_clock64() : 0ull;
#define PG8_STAMP() do { if (STAMP && wid == 0 && nts < 64) { const unsigned long long _c = (unsigned long long)clock64(); \
        ts_lo = (lane == nts) ? (int)(unsigned)_c : ts_lo; ts_hi = (lane == nts) ? (int)(unsigned)(_c >> 32) : ts_hi; ++nts; } } while (0)
    PG8_STAMP();
    unsigned voffA[2], voffB[2];
#pragma unroll
    for (int i = 0; i < 2; ++i) { int R, C; stage_rc(tid * 16 + i * 8192, R, C); const int Rb = Epi::PERM ? ((R & ~31) + perm32(R & 31)) : R;
        voffA[i] = (unsigned)(R * K + C) * 2u; voffB[i] = (unsigned)(Rb * K + C) * 2u; }
    const size_t kstep = (size_t)(BK * 2);
    const size_t hstep = (size_t)HALF * K * 2;
    const size_t tstep = 2 * hstep;
    const unsigned ldsw = (unsigned)wid * 1024u;
    const int aoff = lds_byte(wr * 64 + fr, fq * 8), boff = lds_byte(wc * 32 + fr, fq * 8);
#define PG8_SA(b, h) (((b) * 2 + (h)) * HTB)
#define PG8_SB(b, h) ((4 + (b) * 2 + (h)) * HTB)
#define PG8_STAGE(bufoff, gbase, voff) do { _Pragma("unroll") for (int _i = 0; _i < 2; ++_i) \
        __builtin_amdgcn_global_load_lds((const unsigned*)((const char*)(gbase) + (voff)[_i]), (PG8_LAS unsigned*)(lds + (bufoff) + ldsw + _i * 8192), 16, 0, 0); } while (0)
#define PG8_LDA(dst, b, h) do { _Pragma("unroll") for (int m = 0; m < 4; ++m) _Pragma("unroll") for (int k = 0; k < 2; ++k) dst[m][k] = *(const PG8_LAS bf16x8*)(lds + PG8_SA(b, h) + aoff + m * 2048 + k * 1024); } while (0)
#define PG8_LDB(dst, b, h) do { _Pragma("unroll") for (int n = 0; n < 2; ++n) _Pragma("unroll") for (int k = 0; k < 2; ++k) dst[n][k] = *(const PG8_LAS bf16x8*)(lds + PG8_SB(b, h) + boff + n * 2048 + k * 1024); } while (0)
#define PG8_MMA(ai, bj, At, Bt) do { __builtin_amdgcn_s_setprio(1); _Pragma("unroll") for (int m = 0; m < 4; ++m) _Pragma("unroll") for (int n = 0; n < 2; ++n) _Pragma("unroll") for (int k = 0; k < 2; ++k) \
        acc[ai][bj][m][n] = __builtin_amdgcn_mfma_f32_16x16x32_bf16(Bt[n][k], At[m][k], acc[ai][bj][m][n], 0, 0, 0); __builtin_amdgcn_s_setprio(0); } while (0)
#define PG8_WAIT_V(n) asm volatile("s_waitcnt vmcnt(" #n ")" ::: "memory")
#define PG8_WAIT_L(n) asm volatile("s_waitcnt lgkmcnt(" #n ")" ::: "memory")
#define PG8_BAR __builtin_amdgcn_s_barrier()
#define PG8_SCHED __builtin_amdgcn_sched_barrier(0)
    Unit cur, nxt; int ui = 0;
    if (!S.next(0, cur)) return;
    f32x4 acc[2][2][4][2];
#pragma unroll
    for (int a = 0; a < 2; ++a)
#pragma unroll
        for (int b = 0; b < 2; ++b)
#pragma unroll
            for (int m = 0; m < 4; ++m)
#pragma unroll
                for (int n = 0; n < 2; ++n) acc[a][b][m][n] = (f32x4){0.f, 0.f, 0.f, 0.f};
    bf16x8 At[4][2], B0[2][2], B1[2][2];
    const char* cA = (const char*)g.A + (size_t)cur.pm * tstep; const char* cB = (const char*)g.Bt + (size_t)cur.pn * tstep;
    S.a_ready(cur);
    PG8_STAGE(PG8_SB(0, 0), cB, voffB); PG8_STAGE(PG8_SA(0, 0), cA, voffA); PG8_STAGE(PG8_SB(0, 1), cB + hstep, voffB); PG8_STAGE(PG8_SA(0, 1), cA + hstep, voffA);
    if (wr == 1) PG8_BAR;
    PG8_WAIT_V(4); PG8_BAR;
    PG8_STAGE(PG8_SB(1, 0), cB + kstep, voffB); PG8_STAGE(PG8_SA(1, 0), cA + kstep, voffA); PG8_STAGE(PG8_SB(1, 1), cB + hstep + kstep, voffB);
    PG8_WAIT_V(6); PG8_BAR;
    PG8_STAMP();
    for (;;) {
        const bool has_next = S.next(ui + 1, nxt);
        const char* nA = has_next ? (const char*)g.A + (size_t)nxt.pm * tstep : cA; const char* nB = has_next ? (const char*)g.Bt + (size_t)nxt.pn * tstep : cB;
        for (int t = 0; t < nt; t += 2) {
            const bool last = (t == nt - 2);
            const char* a1 = cA + (size_t)(t + 1) * kstep;
            const char* a2 = last ? nA : cA + (size_t)(t + 2) * kstep; const char* b2 = last ? nB : cB + (size_t)(t + 2) * kstep;
            const char* a3 = a2 + kstep; const char* b3 = b2 + kstep;
            if (last && has_next) S.a_ready(nxt);
            PG8_LDB(B0, 0, 0); PG8_SCHED; PG8_LDA(At, 0, 0); PG8_STAGE(PG8_SA(1, 1), a1 + hstep, voffA);
            PG8_WAIT_L(8); PG8_BAR; PG8_WAIT_L(0); PG8_MMA(0, 0, At, B0); PG8_BAR; PG8_SCHED;
            PG8_LDB(B1, 0, 1); PG8_STAGE(PG8_SB(0, 0), b2, voffB);
            PG8_BAR; PG8_WAIT_L(0); PG8_MMA(0, 1, At, B1); PG8_BAR;
            PG8_LDA(At, 0, 1); PG8_STAGE(PG8_SA(0, 0), a2, voffA);
            PG8_BAR; PG8_WAIT_L(0); PG8_MMA(1, 0, At, B0); PG8_BAR; PG8_SCHED;
            PG8_STAGE(PG8_SB(0, 1), b2 + hstep, voffB);
            PG8_WAIT_V(6); PG8_BAR; PG8_MMA(1, 1, At, B1); PG8_BAR;
            PG8_LDB(B0, 1, 0); PG8_SCHED; PG8_LDA(At, 1, 0); PG8_STAGE(PG8_SA(0, 1), a2 + hstep, voffA);
            PG8_WAIT_L(8); PG8_BAR; PG8_WAIT_L(0); PG8_MMA(0, 0, At, B0); PG8_BAR; PG8_SCHED;
            PG8_LDB(B1, 1, 1); PG8_STAGE(PG8_SB(1, 0), b3, voffB);
            PG8_BAR; PG8_WAIT_L(0); PG8_MMA(0, 1, At, B1); PG8_BAR;
            PG8_LDA(At, 1, 1); PG8_STAGE(PG8_SA(1, 0), a3, voffA);
            PG8_BAR; PG8_WAIT_L(0); PG8_MMA(1, 0, At, B0); PG8_BAR; PG8_SCHED;
            PG8_STAGE(PG8_SB(1, 1), b3 + hstep, voffB);
            PG8_WAIT_V(6); PG8_BAR; PG8_MMA(1, 1, At, B1); PG8_BAR;
        }
        PG8_STAMP();
        if constexpr (!Epi::AFTER_DRAIN) { E(acc, cur, wr, wc, fr, fq); S.done(cur); }
        PG8_STAMP();
        if (!has_next) break;
#pragma unroll
        for (int a = 0; a < 2; ++a)
#pragma unroll
            for (int b = 0; b < 2; ++b)
#pragma unroll
                for (int m = 0; m < 4; ++m)
#pragma unroll
                    for (int n = 0; n < 2; ++n) acc[a][b][m][n] = (f32x4){0.f, 0.f, 0.f, 0.f};
        cur = nxt; cA = nA; cB = nB; ++ui;
    }
    PG8_WAIT_V(0);
    if (wr == 0) PG8_BAR;
    PG8_BAR;
    if constexpr (Epi::AFTER_DRAIN) { E.fused(acc, cur, wr, wc, fr, fq, lds, wid, lane); S.done(cur); }
    PG8_STAMP();
    if (STAMP && wid == 0) { stamps[lane] = lane < nts ? (((unsigned long long)(unsigned)ts_hi << 32) | (unsigned)ts_lo) : 0ull;
        if (lane == 62) stamps[62] = rt_entry; if (lane == 63) stamps[63] = (unsigned long long)wall_clock64(); }
#undef PG8_STAMP
#undef PG8_SA
#undef PG8_SB
#undef PG8_STAGE
#undef PG8_LDA
#undef PG8_LDB
#undef PG8_MMA
#undef PG8_WAIT_V
#undef PG8_WAIT_L
#undef PG8_BAR
#undef PG8_SCHED
}
}

#define XB_TMO      128
#define XB_XCNT(j)  (256  + 64 * (j))
#define XB_XSUB(j)  (1280 + 64 * (j))
#define XB_XGEN(j)  (2304 + 64 * (j))
#define XB_TOP      3328
#define XB_TOPGEN   3392
#define XCD_BAR_WORDS 3456
#define XB_SPIN_CAP (1u << 24)
#define LAS __attribute__((address_space(3)))

__device__ __forceinline__ unsigned xb_ld(unsigned* p)              { return __hip_atomic_load(p, __ATOMIC_RELAXED, __HIP_MEMORY_SCOPE_AGENT); }
__device__ __forceinline__ unsigned xb_add(unsigned* p, unsigned v) { return __hip_atomic_fetch_add(p, v, __ATOMIC_RELAXED, __HIP_MEMORY_SCOPE_AGENT); }
__device__ __forceinline__ unsigned xb_xcc_id() { return (unsigned)__builtin_amdgcn_s_getreg((3 << 11) | 20) & 0xFu; }
#define XB_SPIN(cond, bar) do { unsigned _sp = 0; while (cond) { __builtin_amdgcn_s_sleep(1); \
    if ((++_sp & 255u) == 0u) { if (xb_ld(&(bar)[XB_TMO])) break; if (_sp > XB_SPIN_CAP) { atomicAdd(&(bar)[XB_TMO], 1u); break; } } } } while (0)

struct XcdBarrier {
    unsigned* bar; unsigned x;
    volatile LAS unsigned* st;
};

__device__ __forceinline__ XcdBarrier xcd_barrier_post(unsigned* bar, volatile LAS unsigned* st) {
    XcdBarrier b; b.bar = bar; b.x = xb_xcc_id(); b.st = st;
    if (threadIdx.x == 0) (void)xb_add(&bar[XB_XCNT(b.x)], 1u);
    return b;
}
__device__ __forceinline__ void xcd_barrier_complete(unsigned* bar, unsigned x, unsigned& nloc, unsigned& nx) {
    const unsigned G = gridDim.x * gridDim.y * gridDim.z;
    unsigned sum, cnt, mine, sp = 0u;
    for (;;) {
        sum = 0u; cnt = 0u; mine = 0u;
#pragma unroll
        for (unsigned j = 0; j < 16; ++j) { const unsigned c = xb_ld(&bar[XB_XCNT(j)]); sum += c; cnt += (c > 0u) ? 1u : 0u; mine = (j == x) ? c : mine; }
        if (sum == G) break;
        __builtin_amdgcn_s_sleep(1);
        if ((++sp & 255u) == 0u) { if (xb_ld(&bar[XB_TMO])) break; if (sp > XB_SPIN_CAP) { atomicAdd(&bar[XB_TMO], 1u); break; } }
    }
    nloc = mine > 0u ? mine : 1u; nx = cnt > 0u ? cnt : 1u;
}

__device__ __forceinline__ void xcd_barrier(const XcdBarrier& b) {
    asm volatile("s_waitcnt vmcnt(0)" ::: "memory");
    __syncthreads();
    if (threadIdx.x == 0) {
        unsigned* bar = b.bar;
        __builtin_amdgcn_s_waitcnt(0);
        unsigned nloc = b.st[0], nx = b.st[1];
        if (nloc == 0u) { xcd_barrier_complete(bar, b.x, nloc, nx); b.st[0] = nloc; b.st[1] = nx; }
        const unsigned old = xb_add(&bar[XB_XSUB(b.x)], 1u);
        const unsigned gen = old / nloc;
        if (old + 1u == (gen + 1u) * nloc) {
            __builtin_amdgcn_fence(__ATOMIC_RELEASE, "agent");
            asm volatile("s_waitcnt vmcnt(0)" ::: "memory");
            const unsigned og = xb_add(&bar[XB_TOP], 1u);
            const unsigned tg = og / nx;
            if (og + 1u == (tg + 1u) * nx) xb_add(&bar[XB_TOPGEN], 1u);
            else XB_SPIN(xb_ld(&bar[XB_TOPGEN]) == tg, bar);
            __builtin_amdgcn_fence(__ATOMIC_ACQUIRE, "agent");
            xb_add(&bar[XB_XGEN(b.x)], 1u);
            asm volatile("s_waitcnt vmcnt(0)" ::: "memory");
        } else {
            XB_SPIN(xb_ld(&bar[XB_XGEN(b.x)]) == gen, bar);
            __builtin_amdgcn_fence(__ATOMIC_ACQUIRE, "agent");
            asm volatile("s_waitcnt vmcnt(0)" ::: "memory");
        }
    }
    __syncthreads();
}

typedef unsigned short bf16_t;
typedef short bf16x8 __attribute__((ext_vector_type(8)));
typedef float f32x4 __attribute__((ext_vector_type(4)));
typedef float f32x16 __attribute__((ext_vector_type(16)));
typedef unsigned u32x4 __attribute__((ext_vector_type(4)));
typedef unsigned u32x2 __attribute__((ext_vector_type(2)));
typedef float f32x2_t __attribute__((ext_vector_type(2)));
typedef __bf16 bf16x2_t __attribute__((ext_vector_type(2)));

constexpr int SEQ = 16384, DM = 1024, NLAYER = 2;
constexpr int IN_COLS = 2724, NP = 2816;
constexpr int NEXP = 32, TOPK = 4, FEXP = 1024;
constexpr int MAXROWS = SEQ * TOPK + NEXP * 256;
constexpr int NWAVES = 8, NTHREADS = 512;
constexpr float EPS = 1e-6f;
constexpr float LOG2E = 1.4426950408889634f;
constexpr float QSCALE64 = 0.125f * LOG2E;
constexpr float QSCALE96 = 0.10206207261596577f * LOG2E;

constexpr int PC_CQ = 0, PC_CKV = 256, PC_KR = 384, PC_FLOG = 416, PC_FQ = 448, PC_FK = 704, PC_FV = 960, PC_MQ = 1216, PC_MK = 1472, PC_MV = 1728, PC_DQ = 1984, PC_DK = 2240, PC_DV = 2496;

constexpr size_t MiB = 1u << 20;
constexpr size_t WS_CTL = 0, CTL_ZERO_BYTES = 1 * MiB;
constexpr size_t WS_META = 1 * MiB;
constexpr size_t WS_W1T = 2 * MiB;
constexpr size_t WS_WOT = 14 * MiB;
constexpr size_t WS_WUQ = 18 * MiB;
constexpr size_t WS_WUKV = 19 * MiB;
constexpr size_t WS_WE1 = 32 * MiB;
constexpr size_t WS_WE2 = 288 * MiB;
constexpr size_t WS_H = 416 * MiB;
constexpr size_t WS_PROJ = 448 * MiB;
constexpr size_t WS_QA = 536 * MiB, WS_KA = 548 * MiB, WS_VAT = 560 * MiB;
constexpr size_t WS_QB = 568 * MiB, WS_KB = 576 * MiB, WS_VBT = 584 * MiB;
constexpr size_t WS_QC = 592 * MiB, WS_KC = 600 * MiB, WS_VCT = 608 * MiB;
constexpr size_t WS_QD = 616 * MiB, WS_KD = 624 * MiB, WS_VDT = 632 * MiB;
constexpr size_t WS_FLOC = 640 * MiB;
constexpr size_t WS_FTILE = 640 * MiB + 256 * 1024;
constexpr size_t WS_KSUM = 640 * MiB + 512 * 1024;
constexpr size_t WS_O = 642 * MiB;
constexpr size_t WS_X1 = 674 * MiB;
constexpr size_t WS_XC = 738 * MiB;
constexpr size_t WS_XS = 802 * MiB;
constexpr size_t WS_Y1 = 946 * MiB;
constexpr size_t WS_Y2 = 1090 * MiB;
constexpr size_t WS_TOKI = 1234 * MiB;
constexpr size_t WS_END = 1236 * MiB;
constexpr size_t META_MOD = 0;
constexpr size_t META_OFF = 64 * 1024;
constexpr size_t META_TILE = 68 * 1024;
constexpr int CW_BAR = 4096;
constexpr int CW_QUEUE = 8192;
constexpr int CW_ECNT = 12288;

constexpr int GEN_BYTES = 139264;
constexpr int LDSCTL_OFF = GEN_BYTES;
constexpr int LDS_BYTES = GEN_BYTES + 1024;

DI float bf2f(bf16_t b) { return __uint_as_float(((unsigned)b) << 16); }
DI unsigned pk2(float lo, float hi) { f32x2_t v = {lo, hi}; bf16x2_t b = __builtin_convertvector(v, bf16x2_t); return __builtin_bit_cast(unsigned, b); }
DI bf16_t f2bf(float f) { return (bf16_t)(pk2(f, 0.f) & 0xffffu); }
DI float wave_sum(float v) {
#pragma unroll
    for (int o = 1; o < 64; o <<= 1) v += __shfl_xor(v, o);
    return v;
}
DI float wave_max(float v) {
#pragma unroll
    for (int o = 1; o < 64; o <<= 1) v = fmaxf(v, __shfl_xor(v, o));
    return v;
}
DI void unpack8(const bf16x8 r, float (&x)[8]) {
#pragma unroll
    for (int i = 0; i < 8; ++i) x[i] = bf2f((bf16_t)r[i]);
}
DI u32x4 pack8(const float (&y)[8]) { u32x4 w; w.x = pk2(y[0], y[1]); w.y = pk2(y[2], y[3]); w.z = pk2(y[4], y[5]); w.w = pk2(y[6], y[7]); return w; }
DI int crow(int r, int hi) { return (r & 3) + 8 * (r >> 2) + 4 * hi; }
#define MFMA32(a, b, c) __builtin_amdgcn_mfma_f32_32x32x16_bf16((a), (b), (c), 0, 0, 0)

struct Args { const float* in[27]; float* out; unsigned char* ws; int ph_lo, ph_hi; };
typedef const __attribute__((address_space(4))) Args* KArgP;
struct Frame {
    LAS unsigned char* lds;
    unsigned char* ws;
    unsigned* ctl;
    KArgP ap;
    int tid, lane, wave, G;
    DI const float* in(int i) const { return ap->in[i]; }
    DI void refresh() { int t = threadIdx.x; asm volatile("" : "+v"(t)); tid = t; lane = t & 63; wave = __builtin_amdgcn_readfirstlane(t >> 6); }
};
enum { I_X = 0, I_C, I_WMOD, I_BMOD, I_N1G, I_N2G, I_WIN, I_CQG, I_WUQ, I_CKVG, I_WUKV, I_MQG, I_MKG, I_FQG, I_FKG, I_FBF, I_MOQG, I_MOKG, I_DQG, I_DKG, I_WOUT, I_RW, I_RB, I_EW1, I_EB1, I_EW2, I_EB2 };

DI int map_win(int n) {
    if (n < 416) return n;
    if (n < 420) return 1184 + (n - 416);
    if (n < 448) return -1;
    if (n < 1216) return n - 32;
    if (n < 2752) return n - 28;
    return -1;
}
DI int map_w1(int n) { return ((n >> 7) & 1) * 1024 + (n >> 8) * 128 + (n & 127); }
template <int MAP> DI void transpose_item(const float* W, int K, int Nsrc, bf16_t* WT, int k0, int n0, LAS float* scr, int lane) {
    const int nn = n0 + (lane & 31);
    const int ns = (MAP == 0) ? nn : (MAP == 1 ? map_win(nn) : map_w1(nn));
    float v[32];
#pragma unroll
    for (int i = 0; i < 32; ++i) { const int kk = 2 * i + (lane >> 5); v[i] = (ns >= 0) ? W[(size_t)(k0 + kk) * Nsrc + ns] : 0.f; }
#pragma unroll
    for (int i = 0; i < 32; ++i) { const int kk = 2 * i + (lane >> 5); scr[kk * 33 + (lane & 31)] = v[i]; }
    asm volatile("s_waitcnt lgkmcnt(0)" ::: "memory");
    const int c = lane & 7;
#pragma unroll
    for (int j = 0; j < 4; ++j) { const int n = (lane >> 3) + 8 * j; const LAS float* s = scr + (8 * c) * 33 + n;
        u32x4 o; o.x = pk2(s[0 * 33], s[1 * 33]); o.y = pk2(s[2 * 33], s[3 * 33]); o.z = pk2(s[4 * 33], s[5 * 33]); o.w = pk2(s[6 * 33], s[7 * 33]);
        *(u32x4*)(WT + (size_t)(n0 + n) * K + k0 + 8 * c) = o; }
    asm volatile("s_waitcnt lgkmcnt(0)" ::: "memory");
}
DI void norm_mod_store(const f32x4 (&v)[4], const float* g, const float* sc, const float* sh, bf16_t* hrow, int lane) {
    float ss = 0.f;
#pragma unroll
    for (int j = 0; j < 4; ++j) ss += (v[j].x * v[j].x + v[j].y * v[j].y) + (v[j].z * v[j].z + v[j].w * v[j].w);
    ss = wave_sum(ss);
    const float rstd = 1.0f / sqrtf(ss * (1.0f / DM) + EPS);
#pragma unroll
    for (int j = 0; j < 4; ++j) {
        const int c = 4 * lane + 256 * j;
        const f32x4 g4 = *(const f32x4*)(g + c), s4 = *(const f32x4*)(sc + c), h4 = *(const f32x4*)(sh + c);
        const f32x4 y = (v[j] * rstd) * g4 * (s4 + 1.0f) + h4;
        u32x2 w; w.x = pk2(y.x, y.y); w.y = pk2(y.z, y.w);
        *(u32x2*)(hrow + c) = w;
    }
}
DI void phase_prologue(Frame& F) {
    const int tid = F.tid, lane = F.lane, wave = F.wave;
    float* mod = (float*)(F.ws + WS_META + META_MOD);
    if (blockIdx.x < 192) {
        LAS float* scv = (LAS float*)F.lds;
        LAS float* part = (LAS float*)(F.lds + 4096);
        for (int i = tid; i < DM; i += NTHREADS) { const float cv = F.in(I_C)[i]; scv[i] = cv / (1.0f + __expf(-cv)); }
        __syncthreads();
        const int l = blockIdx.x / 96, col = (blockIdx.x % 96) * 64 + lane;
        const float* wm = F.in(I_WMOD) + (size_t)l * DM * 6144 + col;
        float acc = 0.f;
#pragma unroll 8
        for (int k = wave * 128; k < wave * 128 + 128; ++k) acc += scv[k] * wm[(size_t)k * 6144];
        part[wave * 64 + lane] = acc;
        __syncthreads();
        if (wave == 0) { float s = 0.f;
#pragma unroll
            for (int w = 0; w < 8; ++w) s += part[w * 64 + lane];
            mod[l * 6144 + col] = s + F.in(I_BMOD)[l * 6144 + col]; }
        __syncthreads();
    }
    {
        LAS float* scr = (LAS float*)(F.lds + 8192 + wave * 8704);
        const int gw = blockIdx.x * NWAVES + wave, NGW = F.G * NWAVES;
        constexpr int T_E1 = 32 * 16 * 64, T_E2 = 32 * 16 * 32, T_W1 = 16 * 88, T_WO = 16 * 32, T_UQ = 4 * 12, T_UKV = 2 * 16;
        constexpr int T_LAYER = T_E1 + T_E2 + T_W1 + T_WO + T_UQ + T_UKV;
        for (int it = gw; it < NLAYER * T_LAYER; it += NGW) {
            const int l = it / T_LAYER; int r = it % T_LAYER;
            if (r < T_E1) { const int e = r / (16 * 64), q = r % (16 * 64), kb = q / 64, nb = q % 64;
                transpose_item<2>(F.in(I_EW1) + ((size_t)l * NEXP + e) * DM * 2048, DM, 2048, (bf16_t*)(F.ws + WS_WE1) + ((size_t)l * NEXP + e) * 2048 * DM, 64 * kb, 32 * nb, scr, lane); continue; }
            r -= T_E1;
            if (r < T_E2) { const int e = r / (16 * 32), q = r % (16 * 32), kb = q / 32, nb = q % 32;
                transpose_item<0>(F.in(I_EW2) + ((size_t)l * NEXP + e) * FEXP * DM, FEXP, DM, (bf16_t*)(F.ws + WS_WE2) + ((size_t)l * NEXP + e) * DM * FEXP, 64 * kb, 32 * nb, scr, lane); continue; }
            r -= T_E2;
            if (r < T_W1) { const int kb = r / 88, nb = r % 88;
                transpose_item<1>(F.in(I_WIN) + (size_t)l * DM * IN_COLS, DM, IN_COLS, (bf16_t*)(F.ws + WS_W1T) + (size_t)l * NP * DM, 64 * kb, 32 * nb, scr, lane); continue; }
            r -= T_W1;
            if (r < T_WO) { const int kb = r / 32, nb = r % 32;
                transpose_item<0>(F.in(I_WOUT) + (size_t)l * DM * DM, DM, DM, (bf16_t*)(F.ws + WS_WOT) + (size_t)l * DM * DM, 64 * kb, 32 * nb, scr, lane); continue; }
            r -= T_WO;
            if (r < T_UQ) { const int kb = r / 12, nb = r % 12;
                transpose_item<0>(F.in(I_WUQ) + (size_t)l * 256 * 384, 256, 384, (bf16_t*)(F.ws + WS_WUQ) + (size_t)l * 384 * 256, 64 * kb, 32 * nb, scr, lane); continue; }
            r -= T_UQ;
            { const int kb = r / 16, nb = r % 16;
                transpose_item<0>(F.in(I_WUKV) + (size_t)l * 128 * 512, 128, 512, (bf16_t*)(F.ws + WS_WUKV) + (size_t)l * 512 * 128, 64 * kb, 32 * nb, scr, lane); }
        }
    }
}
DI void phase_norm1_l0(Frame& F) {
    const float* mod = (const float*)(F.ws + WS_META + META_MOD);
    const int gw = blockIdx.x * NWAVES + F.wave, NGW = F.G * NWAVES;
    for (int m = gw; m < SEQ; m += NGW) {
        const f32x4* xr = (const f32x4*)(F.in(I_X) + (size_t)m * DM) + F.lane;
        f32x4 v[4];
#pragma unroll
        for (int j = 0; j < 4; ++j) v[j] = xr[64 * j];
        norm_mod_store(v, F.in(I_N1G), mod + 1 * DM  , mod + 0 * DM  , (bf16_t*)(F.ws + WS_H) + (size_t)m * DM, F.lane);
    }
}

constexpr double rope_rev(int j) {
    return j == 0 ? 0.15915494309189535 : j == 1 ? 0.08949940160889101 : j == 2 ? 0.050329212104487035 : j == 3 ? 0.0283021958306234 : j == 4 ? 0.015915494309189534 :
           j == 5 ? 0.008949940160889102 : j == 6 ? 0.005032921210448704 : j == 7 ? 0.00283021958306234 : j == 8 ? 0.0015915494309189536 : j == 9 ? 0.0008949940160889102 :
           j == 10 ? 0.0005032921210448703 : j == 11 ? 0.00028302195830623395 : j == 12 ? 0.00015915494309189535 : j == 13 ? 8.949940160889102e-05 : j == 14 ? 5.0329212104487035e-05 : 2.8302195830623396e-05;
}
template <int JB> DI void rope_cs(int t, int hi, float& sn, float& cs) {
    const double c = hi ? rope_rev(JB + 4) : rope_rev(JB);
    const double rev = (double)t * c;
    const float fr = (float)(rev - __builtin_rint(rev));
    sn = __builtin_amdgcn_sinf(fr); cs = __builtin_amdgcn_cosf(fr);
}
DI void phase_postproj(Frame& F, int l) {
    const int tid = F.tid, lane = F.lane, wave = F.wave;
    const bf16_t* proj = (const bf16_t*)(F.ws + WS_PROJ);
    LAS bf16_t* KCl = (LAS bf16_t*)(F.lds);
    LAS bf16_t* AQ = (LAS bf16_t*)(F.lds + 32768);
    LAS bf16_t* AKV = (LAS bf16_t*)(F.lds + 32768 + 33792);
    for (int tile = blockIdx.x; tile < SEQ / 64; tile += F.G) {
        const int t0 = tile * 64;
        {
            const int sub = tid & 7, vslot = tid >> 3;
            for (int it = 0; it < 24; ++it) {
                const int v = it * 64 + vslot, tok = v / 24, gq = v % 24, typ = gq >> 2, hh = gq & 3;
                const int cb = (typ == 0 ? PC_FQ : typ == 1 ? PC_FK : typ == 2 ? PC_MQ : typ == 3 ? PC_MK : typ == 4 ? PC_DQ : PC_DK) + 64 * hh + 8 * sub;
                const bf16x8 raw = *(const bf16x8*)(proj + (size_t)(t0 + tok) * NP + cb);
                float x[8]; unpack8(raw, x);
                float ss = 0.f;
#pragma unroll
                for (int i = 0; i < 8; ++i) ss += x[i] * x[i];
                ss += __shfl_xor(ss, 1); ss += __shfl_xor(ss, 2); ss += __shfl_xor(ss, 4);
                const float rstd = 1.0f / sqrtf(ss * (1.0f / 64.0f) + EPS);
                const float* gp = F.in(typ == 0 ? I_FQG : typ == 1 ? I_FKG : typ == 2 ? I_MOQG : typ == 3 ? I_MOKG : typ == 4 ? I_DQG : I_DKG) + l * 64 + 8 * sub;
                const float qs = ((typ & 1) == 0) ? QSCALE64 : 1.0f;
                const f32x4 g0 = *(const f32x4*)gp, g1 = *(const f32x4*)(gp + 4);
                float y[8];
#pragma unroll
                for (int i = 0; i < 4; ++i) { y[i] = x[i] * rstd * g0[i] * qs; y[4 + i] = x[4 + i] * rstd * g1[i] * qs; }
                const u32x4 w = pack8(y);
                const size_t dsto = (typ == 0 ? WS_QB : typ == 1 ? WS_KB : typ == 2 ? WS_QC : typ == 3 ? WS_KC : typ == 4 ? WS_QD : WS_KD);
                *(u32x4*)((bf16_t*)(F.ws + dsto) + ((size_t)hh * SEQ + t0 + tok) * 64 + 8 * sub) = w;
                if (typ == 3) *(LAS u32x4*)(KCl + (hh * 64 + tok) * 64 + 8 * sub) = w;
            }
        }
        __syncthreads();
        if (wave < 4) { float s = 0.f;
            for (int tok = 0; tok < 64; ++tok) s += bf2f(KCl[(wave * 64 + tok) * 64 + lane]);
            ((float*)(F.ws + WS_KSUM))[((size_t)wave * 256 + tile) * 64 + lane] = s; }
        for (int rnd = 0; rnd < 2; ++rnd) {
            const int pi = wave + 8 * rnd, mixer = pi >> 2, hh = pi & 3;
            LAS bf16_t* vt = (LAS bf16_t*)(F.lds + 32768 + wave * 9216);
            if (pi < 12) {
                const bf16_t* rp = proj + (size_t)(t0 + lane) * NP + (mixer == 0 ? PC_FV : mixer == 1 ? PC_MV : PC_DV) + 64 * hh;
#pragma unroll
                for (int i = 0; i < 8; ++i) { const bf16x8 r = *(const bf16x8*)(rp + 8 * i);
#pragma unroll
                    for (int e = 0; e < 8; ++e) vt[(8 * i + e) * 72 + lane] = (bf16_t)r[e]; }
            }
            __syncthreads();
            if (pi < 12) {
                bf16_t* dst = (bf16_t*)(F.ws + (mixer == 0 ? WS_VBT : mixer == 1 ? WS_VCT : WS_VDT)) + (size_t)hh * 64 * SEQ;
#pragma unroll
                for (int ps = 0; ps < 8; ++ps) { const int d = 8 * ps + (lane >> 3), c = lane & 7;
                    const u32x4 val = *(const LAS u32x4*)(vt + d * 72 + 8 * c);
                    *(u32x4*)(dst + (size_t)d * SEQ + t0 + 8 * c) = val; }
            }
            __syncthreads();
        }
        for (int it = 0; it < 4; ++it) {
            const int tok = it * 16 + wave * 2 + (lane >> 5), sub = lane & 31;
            const bf16x8 raw = *(const bf16x8*)(proj + (size_t)(t0 + tok) * NP + PC_CQ + 8 * sub);
            float x[8]; unpack8(raw, x);
            float ss = 0.f;
#pragma unroll
            for (int i = 0; i < 8; ++i) ss += x[i] * x[i];
            ss += __shfl_xor(ss, 1); ss += __shfl_xor(ss, 2); ss += __shfl_xor(ss, 4); ss += __shfl_xor(ss, 8); ss += __shfl_xor(ss, 16);
            const float rstd = 1.0f / sqrtf(ss * (1.0f / 256.0f) + EPS);
            const float* gp = F.in(I_CQG) + l * 256 + 8 * sub;
            const f32x4 g0 = *(const f32x4*)gp, g1 = *(const f32x4*)(gp + 4);
            float y[8];
#pragma unroll
            for (int i = 0; i < 4; ++i) { y[i] = x[i] * rstd * g0[i]; y[4 + i] = x[4 + i] * rstd * g1[i]; }
            *(LAS u32x4*)(AQ + tok * 264 + 8 * sub) = pack8(y);
        }
        for (int it = 0; it < 2; ++it) {
            const int tok = it * 32 + wave * 4 + (lane >> 4), sub = lane & 15;
            const bf16x8 raw = *(const bf16x8*)(proj + (size_t)(t0 + tok) * NP + PC_CKV + 8 * sub);
            float x[8]; unpack8(raw, x);
            float ss = 0.f;
#pragma unroll
            for (int i = 0; i < 8; ++i) ss += x[i] * x[i];
            ss += __shfl_xor(ss, 1); ss += __shfl_xor(ss, 2); ss += __shfl_xor(ss, 4); ss += __shfl_xor(ss, 8);
            const float rstd = 1.0f / sqrtf(ss * (1.0f / 128.0f) + EPS);
            const float* gp = F.in(I_CKVG) + l * 128 + 8 * sub;
            const f32x4 g0 = *(const f32x4*)gp, g1 = *(const f32x4*)(gp + 4);
            float y[8];
#pragma unroll
            for (int i = 0; i < 4; ++i) { y[i] = x[i] * rstd * g0[i]; y[4 + i] = x[4 + i] * rstd * g1[i]; }
            *(LAS u32x4*)(AKV + tok * 136 + 8 * sub) = pack8(y);
        }
        __syncthreads();
        {
            const int tg = wave & 1, hh = wave >> 1, r32 = lane & 31, hi = lane >> 5, t = t0 + 32 * tg + r32;
            {
                f32x16 acc[3];
#pragma unroll
                for (int i = 0; i < 3; ++i)
#pragma unroll
                    for (int r = 0; r < 16; ++r) acc[i][r] = 0.f;
                const bf16_t* wq = (const bf16_t*)(F.ws + WS_WUQ) + (size_t)l * 384 * 256 + (size_t)(96 * hh + r32) * 256 + 8 * hi;
                const LAS bf16_t* aq = AQ + (32 * tg + r32) * 264 + 8 * hi;
#pragma unroll 4
                for (int ks = 0; ks < 16; ++ks) {
                    const bf16x8 b = *(const LAS bf16x8*)(aq + 16 * ks);
#pragma unroll
                    for (int i = 0; i < 3; ++i) { const bf16x8 a = *(const bf16x8*)(wq + (size_t)i * 32 * 256 + 16 * ks); acc[i] = MFMA32(a, b, acc[i]); }
                }
                float ss = 0.f;
#pragma unroll
                for (int i = 0; i < 3; ++i)
#pragma unroll
                    for (int r = 0; r < 16; ++r) ss += acc[i][r] * acc[i][r];
                ss += __shfl_xor(ss, 32);
                const float rstd = 1.0f / sqrtf(ss * (1.0f / 96.0f) + EPS);
                const float* gq = F.in(I_MQG) + l * 96;
#pragma unroll
                for (int i = 0; i < 3; ++i)
#pragma unroll
                    for (int g4 = 0; g4 < 4; ++g4) { const f32x4 gv = *(const f32x4*)(gq + 32 * i + 8 * g4 + 4 * hi);
#pragma unroll
                        for (int e = 0; e < 4; ++e) acc[i][4 * g4 + e] *= rstd * gv[e]; }
#define ROPE_Q(r) { float sn, cs; rope_cs<((r) & 3) + 8 * ((r) >> 2)>(t, hi, sn, cs); const float x1 = acc[2][r], x2 = acc[2][(r) + 8]; acc[2][r] = x1 * cs - x2 * sn; acc[2][(r) + 8] = x2 * cs + x1 * sn; }
                ROPE_Q(0) ROPE_Q(1) ROPE_Q(2) ROPE_Q(3) ROPE_Q(4) ROPE_Q(5) ROPE_Q(6) ROPE_Q(7)
#undef ROPE_Q
                bf16_t* qd = (bf16_t*)(F.ws + WS_QA) + ((size_t)hh * SEQ + t) * 96 + 4 * hi;
#pragma unroll
                for (int i = 0; i < 3; ++i)
#pragma unroll
                    for (int g4 = 0; g4 < 4; ++g4) { u32x2 w; w.x = pk2(acc[i][4 * g4] * QSCALE96, acc[i][4 * g4 + 1] * QSCALE96); w.y = pk2(acc[i][4 * g4 + 2] * QSCALE96, acc[i][4 * g4 + 3] * QSCALE96);
                        *(u32x2*)(qd + 32 * i + 8 * g4) = w; }
            }
            {
                f32x16 acc[4];
#pragma unroll
                for (int i = 0; i < 4; ++i)
#pragma unroll
                    for (int r = 0; r < 16; ++r) acc[i][r] = 0.f;
                const bf16_t* wkv = (const bf16_t*)(F.ws + WS_WUKV) + (size_t)l * 512 * 128 + (size_t)(128 * hh + r32) * 128 + 8 * hi;
                const LAS bf16_t* akv = AKV + (32 * tg + r32) * 136 + 8 * hi;
#pragma unroll 2
                for (int ks = 0; ks < 8; ++ks) {
                    const bf16x8 b = *(const LAS bf16x8*)(akv + 16 * ks);
#pragma unroll
                    for (int i = 0; i < 4; ++i) { const bf16x8 a = *(const bf16x8*)(wkv + (size_t)i * 32 * 128 + 16 * ks); acc[i] = MFMA32(a, b, acc[i]); }
                }
                float kr[16];
#pragma unroll
                for (int g4 = 0; g4 < 4; ++g4) { const u32x2 w = *(const u32x2*)(proj + (size_t)t * NP + PC_KR + 8 * g4 + 4 * hi);
                    kr[4 * g4 + 0] = bf2f((bf16_t)(w.x & 0xffffu)); kr[4 * g4 + 1] = bf2f((bf16_t)(w.x >> 16)); kr[4 * g4 + 2] = bf2f((bf16_t)(w.y & 0xffffu)); kr[4 * g4 + 3] = bf2f((bf16_t)(w.y >> 16)); }
                float ss = 0.f;
#pragma unroll
                for (int r = 0; r < 16; ++r) ss += acc[0][r] * acc[0][r] + acc[1][r] * acc[1][r] + kr[r] * kr[r];
                ss += __shfl_xor(ss, 32);
                const float rstd = 1.0f / sqrtf(ss * (1.0f / 96.0f) + EPS);
                const float* gk = F.in(I_MKG) + l * 96;
                bf16_t* kd = (bf16_t*)(F.ws + WS_KA) + ((size_t)hh * SEQ + t) * 96 + 4 * hi;
#pragma unroll
                for (int i = 0; i < 2; ++i)
#pragma unroll
                    for (int g4 = 0; g4 < 4; ++g4) { const f32x4 gv = *(const f32x4*)(gk + 32 * i + 8 * g4 + 4 * hi);
                        u32x2 w; w.x = pk2(acc[i][4 * g4] * rstd * gv[0], acc[i][4 * g4 + 1] * rstd * gv[1]); w.y = pk2(acc[i][4 * g4 + 2] * rstd * gv[2], acc[i][4 * g4 + 3] * rstd * gv[3]);
                        *(u32x2*)(kd + 32 * i + 8 * g4) = w; }
#pragma unroll
                for (int g4 = 0; g4 < 4; ++g4) { const f32x4 gv = *(const f32x4*)(gk + 64 + 8 * g4 + 4 * hi);
#pragma unroll
                    for (int e = 0; e < 4; ++e) kr[4 * g4 + e] *= rstd * gv[e]; }
#define ROPE_K(r) { float sn, cs; rope_cs<((r) & 3) + 8 * ((r) >> 2)>(t, hi, sn, cs); const float x1 = kr[r], x2 = kr[(r) + 8]; kr[r] = x1 * cs - x2 * sn; kr[(r) + 8] = x2 * cs + x1 * sn; }
                ROPE_K(0) ROPE_K(1) ROPE_K(2) ROPE_K(3) ROPE_K(4) ROPE_K(5) ROPE_K(6) ROPE_K(7)
#undef ROPE_K
#pragma unroll
                for (int g4 = 0; g4 < 4; ++g4) { u32x2 w; w.x = pk2(kr[4 * g4], kr[4 * g4 + 1]); w.y = pk2(kr[4 * g4 + 2], kr[4 * g4 + 3]); *(u32x2*)(kd + 64 + 8 * g4) = w; }
                bf16_t* vd = (bf16_t*)(F.ws + WS_VAT) + (size_t)hh * 64 * SEQ + t;
#pragma unroll
                for (int i = 2; i < 4; ++i)
#pragma unroll
                    for (int r = 0; r < 16; ++r) vd[(size_t)(32 * (i - 2) + crow(r, hi)) * SEQ] = f2bf(acc[i][r]);
            }
        }
        if (wave < 4) {
            const int hh = wave;
            const float z = bf2f(proj[(size_t)(t0 + lane) * NP + PC_FLOG + hh]) + F.in(I_FBF)[l * 4 + hh];
            float sc = (fminf(z, 0.f) - log1pf(expf(-fabsf(z)))) * LOG2E;
#pragma unroll
            for (int d = 1; d < 64; d <<= 1) { const float o = __shfl_up(sc, d); if (lane >= d) sc += o; }
            ((float*)(F.ws + WS_FLOC))[(size_t)hh * SEQ + t0 + lane] = sc;
            if (lane == 63) ((float*)(F.ws + WS_FTILE))[hh * 256 + tile] = sc;
        }
        __syncthreads();
    }
}

DI int swap23(int x) { return (x & ~12) | ((x & 4) << 1) | ((x & 8) >> 1); }
struct AttnShared { const LAS float* kmean; const LAS float* fpre; float fox_cut; };
template <int MODE> DI void attn_unit(Frame& F, const AttnShared& A, int hh, int qt) {
    constexpr int DQ = (MODE == 0) ? 96 : 64, NKS = DQ / 16;
    constexpr size_t QOFF = (MODE == 0 ? WS_QA : MODE == 1 ? WS_QB : MODE == 2 ? WS_QC : WS_QD);
    constexpr size_t KOFF = (MODE == 0 ? WS_KA : MODE == 1 ? WS_KB : MODE == 2 ? WS_KC : WS_KD);
    constexpr size_t VOFF = (MODE == 0 ? WS_VAT : MODE == 1 ? WS_VBT : MODE == 2 ? WS_VCT : WS_VDT);
    const int lane = F.lane, r32 = lane & 31, hi = lane >> 5, t = 32 * qt + r32;
    const bf16_t* Qp = (const bf16_t*)(F.ws + QOFF) + ((size_t)hh * SEQ + t) * DQ + 8 * hi;
    const bf16_t* Kp = (const bf16_t*)(F.ws + KOFF) + (size_t)hh * SEQ * DQ + (size_t)swap23(r32) * DQ + 8 * hi;
    const bf16_t* Vp = (const bf16_t*)(F.ws + VOFF) + ((size_t)hh * 64 + r32) * SEQ + 8 * hi;
    bf16x8 qf[NKS];
#pragma unroll
    for (int ks = 0; ks < NKS; ++ks) qf[ks] = *(const bf16x8*)(Qp + 16 * ks);
    float m = -1e30f, lsum = 0.f;
    f32x16 o0, o1;
#pragma unroll
    for (int r = 0; r < 16; ++r) { o0[r] = 0.f; o1[r] = 0.f; }

    float Fq = 0.f, Ffirst = 0.f;
    const float* floc = (const float*)(F.ws + WS_FLOC) + (size_t)hh * SEQ;
    float slope2 = 0.f;
    unsigned long long selmask = 0ull, need = 0ull;
    const int ownb = qt >> 3;
    if constexpr (MODE == 1) {
        Fq = A.fpre[hh * 256 + (t >> 6)] + floc[t];
        Ffirst = A.fpre[hh * 256 + ((32 * qt) >> 6)] + floc[32 * qt];
    }
    if constexpr (MODE == 2) slope2 = exp2f(-(float)(2 * hh + 2)) * LOG2E;
    if constexpr (MODE == 3) slope2 = exp2f(-(float)(2 * hh + 1)) * LOG2E;
    if constexpr (MODE == 2) {
        float qv[64];
        { const bf16_t* qrow = (const bf16_t*)(F.ws + WS_QC) + ((size_t)hh * SEQ + t) * 64;
#pragma unroll
          for (int i = 0; i < 8; ++i) { const bf16x8 r = *(const bf16x8*)(qrow + 8 * i);
#pragma unroll
              for (int e = 0; e < 8; ++e) qv[8 * i + e] = bf2f((bf16_t)r[e]); } }
        float v1 = -INFINITY, v2 = -INFINITY, v3 = -INFINITY; int i1 = -1, i2 = -1, i3 = -1;
        for (int n = hi; n < ownb; n += 2) {
            const LAS f32x4* km = (const LAS f32x4*)(A.kmean + (hh * 64 + n) * 64);
            float g0 = 0.f, g1 = 0.f;
#pragma unroll
            for (int d4 = 0; d4 < 16; d4 += 2) { const f32x4 k0 = km[d4], k1 = km[d4 + 1];
                g0 += qv[4 * d4] * k0.x + qv[4 * d4 + 1] * k0.y + qv[4 * d4 + 2] * k0.z + qv[4 * d4 + 3] * k0.w;
                g1 += qv[4 * d4 + 4] * k1.x + qv[4 * d4 + 5] * k1.y + qv[4 * d4 + 6] * k1.z + qv[4 * d4 + 7] * k1.w; }
            const float g = g0 + g1;
            if (g > v1) { v3 = v2; i3 = i2; v2 = v1; i2 = i1; v1 = g; i1 = n; }
            else if (g > v2) { v3 = v2; i3 = i2; v2 = g; i2 = n; }
            else if (g > v3) { v3 = g; i3 = n; }
        }
        float pv[3]; int pi[3];
        pv[0] = __shfl_xor(v1, 32); pv[1] = __shfl_xor(v2, 32); pv[2] = __shfl_xor(v3, 32);
        pi[0] = __shfl_xor(i1, 32); pi[1] = __shfl_xor(i2, 32); pi[2] = __shfl_xor(i3, 32);
#pragma unroll
        for (int c = 0; c < 3; ++c) {
            const float g = pv[c]; const int n = pi[c];
            if (n >= 0) {
                if (g > v1 || (g == v1 && n < i1)) { v3 = v2; i3 = i2; v2 = v1; i2 = i1; v1 = g; i1 = n; }
                else if (g > v2 || (g == v2 && n < i2)) { v3 = v2; i3 = i2; v2 = g; i2 = n; }
                else if (g > v3 || (g == v3 && n < i3)) { v3 = g; i3 = n; }
            }
        }
        if (i1 >= 0) selmask |= 1ull << i1;
        if (i2 >= 0) selmask |= 1ull << i2;
        if (i3 >= 0) selmask |= 1ull << i3;
        unsigned lo = (unsigned)selmask, hi32 = (unsigned)(selmask >> 32);
#pragma unroll
        for (int o = 1; o < 64; o <<= 1) { lo |= (unsigned)__shfl_xor((int)lo, o); hi32 |= (unsigned)__shfl_xor((int)hi32, o); }
        need = ((unsigned long long)(unsigned)__builtin_amdgcn_readfirstlane((int)hi32) << 32) | (unsigned)__builtin_amdgcn_readfirstlane((int)lo);
    }

    bf16x8 kfA[NKS], vfA[4], kfB[NKS], vfB[4];
#define LOAD_TILE(kf, vf, kt_) do { const bf16_t* kp_ = Kp + (size_t)(kt_) * 32 * DQ; _Pragma("unroll") for (int ks = 0; ks < NKS; ++ks) kf[ks] = *(const bf16x8*)(kp_ + 16 * ks); \
        const bf16_t* vp_ = Vp + 32 * (kt_); vf[0] = *(const bf16x8*)(vp_); vf[1] = *(const bf16x8*)(vp_ + 16); vf[2] = *(const bf16x8*)(vp_ + (size_t)32 * SEQ); vf[3] = *(const bf16x8*)(vp_ + (size_t)32 * SEQ + 16); } while (0)

    int kt = qt;
    LOAD_TILE(kfA, vfA, kt);
    for (;;) {
        int nk = -1;
        if constexpr (MODE == 0) nk = kt - 1;
        if constexpr (MODE == 3) nk = (kt - 1 >= qt - 64) ? kt - 1 : -1;
        if constexpr (MODE == 1) {
            nk = kt - 1;
            if (nk >= 0) { const float flast = A.fpre[hh * 256 + (nk >> 1)] + floc[32 * nk + 31];
                if (Ffirst - flast < -A.fox_cut) nk = -1; }
            nk = __builtin_amdgcn_readfirstlane(nk);
        }
        if constexpr (MODE == 2) {
            if ((kt & 7) != 0) nk = kt - 1;
            else { if (need != 0ull) { const int n = 63 - __builtin_clzll(need); need &= ~(1ull << n); nk = 8 * n + 7; } else nk = -1; }
        }
        if (nk >= 0) LOAD_TILE(kfB, vfB, nk);
        f32x16 s;
#pragma unroll
        for (int r = 0; r < 16; ++r) s[r] = 0.f;
#pragma unroll
        for (int ks = 0; ks < NKS; ++ks) s = MFMA32(kfA[ks], qf[ks], s);
        const int d0 = 32 * (qt - kt) + r32 - 8 * hi;
        if constexpr (MODE == 0) {
            if (kt == qt) {
#pragma unroll
                for (int i = 0; i < 16; ++i) if (d0 - (16 * (i >> 3) + (i & 7)) < 0) s[i] = -INFINITY;
            }
        }
        if constexpr (MODE == 1) {
            const float* fb = floc + 32 * kt + 8 * hi; const float pre = A.fpre[hh * 256 + (kt >> 1)];
            const f32x4 f0 = *(const f32x4*)fb, f1 = *(const f32x4*)(fb + 4), f2 = *(const f32x4*)(fb + 16), f3 = *(const f32x4*)(fb + 20);
            const float base = Fq - pre;
#pragma unroll
            for (int e = 0; e < 4; ++e) { s[e] += base - f0[e]; s[4 + e] += base - f1[e]; s[8 + e] += base - f2[e]; s[12 + e] += base - f3[e]; }
            if (kt == qt) {
#pragma unroll
                for (int i = 0; i < 16; ++i) if (d0 - (16 * (i >> 3) + (i & 7)) < 0) s[i] = -INFINITY;
            }
        }
        if constexpr (MODE == 2) {
            const int kb = kt >> 3;
            const bool allowed = (kb == ownb) || (((selmask >> kb) & 1ull) != 0ull);
#pragma unroll
            for (int i = 0; i < 16; ++i) { const int dl = d0 - (16 * (i >> 3) + (i & 7)); s[i] = (allowed && dl >= 0) ? s[i] - slope2 * (float)dl : -INFINITY; }
        }
        if constexpr (MODE == 3) {
#pragma unroll
            for (int i = 0; i < 16; ++i) { const int dl = d0 - (16 * (i >> 3) + (i & 7));
                const int w = (dl <= 128 ? 1 : 0) + (((dl & 3) == 0 && dl <= 512) ? 1 : 0) + (((dl & 15) == 0 && dl <= 2048) ? 1 : 0);
                const float lw = (w == 3) ? 1.5849625007211562f : (w == 2 ? 1.0f : 0.0f);
                s[i] = (dl >= 0 && w > 0) ? s[i] - slope2 * (float)dl + lw : -INFINITY; }
        }
        float mloc = s[0];
#pragma unroll
        for (int i = 1; i < 16; ++i) mloc = fmaxf(mloc, s[i]);
        mloc = fmaxf(mloc, __shfl_xor(mloc, 32));
        const float mnew = fmaxf(m, mloc), alpha = __builtin_amdgcn_exp2f(m - mnew);
        m = mnew;
        float p[16], psum = 0.f;
#pragma unroll
        for (int i = 0; i < 16; ++i) { p[i] = __builtin_amdgcn_exp2f(s[i] - mnew); psum += p[i]; }
        lsum = lsum * alpha + psum;
#pragma unroll
        for (int r = 0; r < 16; ++r) { o0[r] *= alpha; o1[r] *= alpha; }
        u32x4 w0, w1;
        w0.x = pk2(p[0], p[1]); w0.y = pk2(p[2], p[3]); w0.z = pk2(p[4], p[5]); w0.w = pk2(p[6], p[7]);
        w1.x = pk2(p[8], p[9]); w1.y = pk2(p[10], p[11]); w1.z = pk2(p[12], p[13]); w1.w = pk2(p[14], p[15]);
        const bf16x8 pf0 = __builtin_bit_cast(bf16x8, w0), pf1 = __builtin_bit_cast(bf16x8, w1);
        o0 = MFMA32(vfA[0], pf0, o0); o0 = MFMA32(vfA[1], pf1, o0);
        o1 = MFMA32(vfA[2], pf0, o1); o1 = MFMA32(vfA[3], pf1, o1);
        if (nk < 0) break;
#pragma unroll
        for (int ks = 0; ks < NKS; ++ks) kfA[ks] = kfB[ks];
#pragma unroll
        for (int i = 0; i < 4; ++i) vfA[i] = vfB[i];
        kt = nk;
    }
#undef LOAD_TILE
    const float ltot = lsum + __shfl_xor(lsum, 32), inv = 1.0f / ltot;
    bf16_t* od = (bf16_t*)(F.ws + WS_O) + (size_t)t * DM + (4 * MODE + hh) * 64 + 4 * hi;
#pragma unroll
    for (int g4 = 0; g4 < 4; ++g4) {
        u32x2 w; w.x = pk2(o0[4 * g4] * inv, o0[4 * g4 + 1] * inv); w.y = pk2(o0[4 * g4 + 2] * inv, o0[4 * g4 + 3] * inv); *(u32x2*)(od + 8 * g4) = w;
        u32x2 z; z.x = pk2(o1[4 * g4] * inv, o1[4 * g4 + 1] * inv); z.y = pk2(o1[4 * g4 + 2] * inv, o1[4 * g4 + 3] * inv); *(u32x2*)(od + 32 + 8 * g4) = z;
    }
}
DI int grab_unit(unsigned* ctr, int lane) {
    int u = 0;
    if (lane == 0) u = (int)__hip_atomic_fetch_add(ctr, 1u, __ATOMIC_RELAXED, __HIP_MEMORY_SCOPE_AGENT);
    return __builtin_amdgcn_readfirstlane(u);
}
DI void phase_attention(Frame& F, int l) {
    const int tid = F.tid, lane = F.lane;
    LAS float* kmean = (LAS float*)F.lds;
    LAS float* fpre = (LAS float*)(F.lds + 65536);
    LAS float* misc = (LAS float*)(F.lds + 65536 + 4096);
    const float* ksum = (const float*)(F.ws + WS_KSUM);
    for (int idx = tid; idx < 4 * 64 * 64; idx += NTHREADS) {
        const int hh = idx >> 12, n = (idx >> 6) & 63, d = idx & 63;
        const float* kp = ksum + ((size_t)hh * 256 + 4 * n) * 64 + d;
        kmean[idx] = ((kp[0] + kp[64]) + (kp[128] + kp[192])) * (1.0f / 256.0f);
    }
    if (tid < 4) { const float* ft = (const float*)(F.ws + WS_FTILE) + tid * 256; float run = 0.f;
        for (int i = 0; i < 256; ++i) { fpre[tid * 256 + i] = run; run += ft[i]; } }
    if (F.wave == 1) {
        const float gq = wave_max(fabsf(F.in(I_FQG)[l * 64 + lane])), gk = wave_max(fabsf(F.in(I_FKG)[l * 64 + lane]));
        if (lane == 0) misc[0] = (40.0f + 2.0f * 8.0f * 1.03f * gq * gk) * LOG2E;
    }
    __syncthreads();
    AttnShared A; A.kmean = kmean; A.fpre = fpre; A.fox_cut = misc[0];
    unsigned* q = F.ctl + CW_QUEUE + 64 * (l * 4);
    for (;;) { const int u = grab_unit(q + 0 * 64, lane); if (u >= 2048) break; attn_unit<0>(F, A, u & 3, 511 - (u >> 2)); }
    for (;;) { const int u = grab_unit(q + 2 * 64, lane); if (u >= 2048) break; attn_unit<2>(F, A, u & 3, 511 - (u >> 2)); }
    for (;;) { const int u = grab_unit(q + 3 * 64, lane); if (u >= 2048) break; attn_unit<3>(F, A, u & 3, 511 - (u >> 2)); }
    for (;;) { const int u = grab_unit(q + 1 * 64, lane); if (u >= 2048) break; attn_unit<1>(F, A, u & 3, 511 - (u >> 2)); }
}

struct EpiGateRes {
    static constexpr bool PERM = false, AFTER_DRAIN = false;
    const float* xin; float* xout; const float* gate;
    DI void operator()(const pg8::f32x4 (&acc)[2][2][4][2], const pg8::Unit& u, int wr, int wc, int fr, int fq) const {
        const int row0 = u.pm * 256 + wr * 64 + fr, col0 = u.pn * 256 + wc * 32 + 4 * fq;
        pg8::f32x4 gv[2][2];
#pragma unroll
        for (int bj = 0; bj < 2; ++bj)
#pragma unroll
            for (int n = 0; n < 2; ++n) gv[bj][n] = *(const pg8::f32x4*)(gate + col0 + bj * 128 + n * 16);
#pragma unroll
        for (int ai = 0; ai < 2; ++ai)
#pragma unroll
            for (int m = 0; m < 4; ++m) { const size_t off = (size_t)(row0 + ai * 128 + m * 16) * DM + col0;
#pragma unroll
                for (int bj = 0; bj < 2; ++bj)
#pragma unroll
                    for (int n = 0; n < 2; ++n) { const pg8::f32x4 xi = *(const pg8::f32x4*)(xin + off + bj * 128 + n * 16);
                        *(pg8::f32x4*)(xout + off + bj * 128 + n * 16) = xi + gv[bj][n] * acc[ai][bj][m][n]; } }
    }
};
struct GroupedOrder {
    const int* tile_e; int nMt, NT, G, c;
    DI bool next(int i, pg8::Unit& u) const {
        const long L = (long)i * G + c; if (L >= (long)nMt * NT) return false;
        const int mt = (int)(L / NT), nt = (int)(L % NT);
        u.pm = mt; u.pn = tile_e[mt] * NT + nt; return true;
    }
    DI void a_ready(const pg8::Unit&) const {}
    DI void done(const pg8::Unit&) const {}
};
struct EpiSwiglu {
    static constexpr bool PERM = true, AFTER_DRAIN = false;
    bf16_t* Y; const float* b1;
    DI void operator()(const pg8::f32x4 (&acc)[2][2][4][2], const pg8::Unit& u, int wr, int wc, int fr, int fq) const {
        const int e = u.pn >> 3, nt = u.pn & 7;
        const int row0 = u.pm * 256 + wr * 64 + fr, col0 = nt * 128 + wc * 32 + 8 * fq;
        const float* bp = b1 + (size_t)e * 2048 + col0;
        pg8::f32x4 bg[2], bu[2];
#pragma unroll
        for (int n = 0; n < 2; ++n) { bg[n] = *(const pg8::f32x4*)(bp + 4 * n); bu[n] = *(const pg8::f32x4*)(bp + 1024 + 4 * n); }
#pragma unroll
        for (int ai = 0; ai < 2; ++ai)
#pragma unroll
            for (int m = 0; m < 4; ++m) {
                float y[8];
#pragma unroll
                for (int n = 0; n < 2; ++n) { const pg8::f32x4 gg = acc[ai][0][m][n] + bg[n], uu = acc[ai][1][m][n] + bu[n];
#pragma unroll
                    for (int j = 0; j < 4; ++j) { const float g = fminf(gg[j], 7.0f), uc = fminf(fmaxf(uu[j], -7.0f), 7.0f);
                        y[4 * n + j] = (uc + 1.0f) * g / (1.0f + __expf(-1.702f * g)); } }
                *(u32x4*)(Y + (size_t)(row0 + ai * 128 + m * 16) * FEXP + col0) = pack8(y);
            }
    }
};
struct EpiDown {
    static constexpr bool PERM = true, AFTER_DRAIN = false;
    bf16_t* Y; const float* b2;
    DI void operator()(const pg8::f32x4 (&acc)[2][2][4][2], const pg8::Unit& u, int wr, int wc, int fr, int fq) const {
        const int e = u.pn >> 2, nt = u.pn & 3;
        const int row0 = u.pm * 256 + wr * 64 + fr, col0 = nt * 256 + wc * 32 + 8 * fq;
        const float* bp = b2 + (size_t)e * DM + col0;
        pg8::f32x4 bv[2][2];
#pragma unroll
        for (int bj = 0; bj < 2; ++bj)
#pragma unroll
            for (int n = 0; n < 2; ++n) bv[bj][n] = *(const pg8::f32x4*)(bp + bj * 128 + 4 * n);
#pragma unroll
        for (int ai = 0; ai < 2; ++ai)
#pragma unroll
            for (int m = 0; m < 4; ++m)
#pragma unroll
                for (int bj = 0; bj < 2; ++bj) {
                    const pg8::f32x4 v0 = acc[ai][bj][m][0] + bv[bj][0], v1 = acc[ai][bj][m][1] + bv[bj][1];
                    u32x4 w; w.x = pk2(v0[0], v0[1]); w.y = pk2(v0[2], v0[3]); w.z = pk2(v1[0], v1[1]); w.w = pk2(v1[2], v1[3]);
                    *(u32x4*)(Y + (size_t)(row0 + ai * 128 + m * 16) * DM + col0 + bj * 128) = w;
                }
    }
};

DI void phase_router(Frame& F, int l) {
    const int tid = F.tid, lane = F.lane, wave = F.wave;
    constexpr int WST = 1028;
    LAS float* wrt = (LAS float*)F.lds;
    LAS unsigned* cnt = (LAS unsigned*)(F.lds + 131584);
    LAS unsigned* basew = (LAS unsigned*)(F.lds + 131584 + 128);
    LAS int* info_e = (LAS int*)(F.lds + 131584 + 256);
    LAS float* info_g = (LAS float*)(F.lds + 131584 + 256 + 1024);
    const float* rw = F.in(I_RW) + (size_t)l * DM * NEXP;
    for (int idx = tid; idx < DM * NEXP; idx += NTHREADS) { const int c = idx >> 5, e = idx & 31; wrt[e * WST + c] = rw[idx]; }
    const float* mod = (const float*)(F.ws + WS_META + META_MOD) + l * 6144;
    const float* x1 = (const float*)(F.ws + WS_X1);
    bf16_t* h2 = (bf16_t*)(F.ws + WS_H);
    int* toki = (int*)(F.ws + WS_TOKI); float* tokg = (float*)(F.ws + WS_TOKI + 256 * 1024);
    unsigned* gcnt = F.ctl + CW_ECNT + 64 * l;
    for (int tile = blockIdx.x; tile < SEQ / 64; tile += F.G) {
        if (tid < 32) cnt[tid] = 0u;
        __syncthreads();
        for (int rr = 0; rr < 8; ++rr) {
            const int tl = wave * 8 + rr, tok = tile * 64 + tl;
            const f32x4* xr = (const f32x4*)(x1 + (size_t)tok * DM) + lane;
            f32x4 v[4]; float ss = 0.f;
#pragma unroll
            for (int j = 0; j < 4; ++j) { v[j] = xr[64 * j]; ss += (v[j].x * v[j].x + v[j].y * v[j].y) + (v[j].z * v[j].z + v[j].w * v[j].w); }
            ss = wave_sum(ss);
            const float rstd = 1.0f / sqrtf(ss * (1.0f / DM) + EPS);
            f32x4 hv[4];
#pragma unroll
            for (int j = 0; j < 4; ++j) { const int c = 4 * lane + 256 * j;
                const f32x4 g4 = *(const f32x4*)(F.in(I_N2G) + l * DM + c), s4 = *(const f32x4*)(mod + 4 * DM + c), h4 = *(const f32x4*)(mod + 3 * DM + c);
                hv[j] = (v[j] * rstd) * g4 * (s4 + 1.0f) + h4;
                u32x2 w; w.x = pk2(hv[j].x, hv[j].y); w.y = pk2(hv[j].z, hv[j].w); *(u32x2*)(h2 + (size_t)tok * DM + c) = w; }
            float pe[32];
#pragma unroll
            for (int e = 0; e < 32; ++e) { float a = 0.f;
#pragma unroll
                for (int j = 0; j < 4; ++j) { const f32x4 w4 = *(const LAS f32x4*)(wrt + e * WST + 4 * lane + 256 * j); a += hv[j].x * w4.x + hv[j].y * w4.y + hv[j].z * w4.z + hv[j].w * w4.w; }
                pe[e] = a; }
            { const bool up = (lane & 32) != 0;
#pragma unroll
              for (int e = 0; e < 16; ++e) { const float send = up ? pe[e] : pe[e + 16], keep = up ? pe[e + 16] : pe[e]; pe[e] = keep + __shfl_xor(send, 32); } }
            { const bool up = (lane & 16) != 0;
#pragma unroll
              for (int e = 0; e < 8; ++e) { const float send = up ? pe[e] : pe[e + 8], keep = up ? pe[e + 8] : pe[e]; pe[e] = keep + __shfl_xor(send, 16); } }
            { const bool up = (lane & 8) != 0;
#pragma unroll
              for (int e = 0; e < 4; ++e) { const float send = up ? pe[e] : pe[e + 4], keep = up ? pe[e + 4] : pe[e]; pe[e] = keep + __shfl_xor(send, 8); } }
            { const bool up = (lane & 4) != 0;
#pragma unroll
              for (int e = 0; e < 2; ++e) { const float send = up ? pe[e] : pe[e + 2], keep = up ? pe[e + 2] : pe[e]; pe[e] = keep + __shfl_xor(send, 4); } }
            { const bool up = (lane & 2) != 0; const float send = up ? pe[0] : pe[1], keep = up ? pe[1] : pe[0]; pe[0] = keep + __shfl_xor(send, 2); }
            pe[0] += __shfl_xor(pe[0], 1);
            const int my_e = ((lane >> 5) & 1) * 16 + ((lane >> 4) & 1) * 8 + ((lane >> 3) & 1) * 4 + ((lane >> 2) & 1) * 2 + ((lane >> 1) & 1);
            float val = pe[0] + F.in(I_RB)[l * NEXP + my_e];
            float tv[4]; int te[4];
#pragma unroll
            for (int k = 0; k < 4; ++k) {
                float bv = val; int be = my_e;
#pragma unroll
                for (int o = 1; o < 64; o <<= 1) { const float ov = __shfl_xor(bv, o); const int oe = __shfl_xor(be, o); if (ov > bv || (ov == bv && oe < be)) { bv = ov; be = oe; } }
                tv[k] = bv; te[k] = be; if (my_e == be) val = -INFINITY;
            }
            const float e1 = __expf(tv[1] - tv[0]), e2 = __expf(tv[2] - tv[0]), e3 = __expf(tv[3] - tv[0]);
            const float rs = 1.0f / (1.0f + e1 + e2 + e3);
            if (lane < 4) {
                const int ee = lane == 0 ? te[0] : lane == 1 ? te[1] : lane == 2 ? te[2] : te[3];
                const float gg = (lane == 0 ? 1.0f : lane == 1 ? e1 : lane == 2 ? e2 : e3) * rs;
                const unsigned slot = __hip_atomic_fetch_add(cnt + ee, 1u, __ATOMIC_RELAXED, __HIP_MEMORY_SCOPE_WORKGROUP);
                info_e[tl * 4 + lane] = (ee << 20) | (int)slot; info_g[tl * 4 + lane] = gg;
            }
        }
        __syncthreads();
        if (tid < 32) basew[tid] = __hip_atomic_fetch_add(gcnt + tid, cnt[tid], __ATOMIC_RELAXED, __HIP_MEMORY_SCOPE_AGENT);
        __syncthreads();
        if (tid < 256) { const int ie = info_e[tid]; const int ee = ie >> 20, slot = ie & 0xfffff;
            toki[(size_t)tile * 256 + tid] = (ee << 20) | (int)(basew[ee] + (unsigned)slot); tokg[(size_t)tile * 256 + tid] = info_g[tid]; }
        __syncthreads();
    }
}
DI void phase_gather(Frame& F, int l) {
    const int tid = F.tid, lane = F.lane, wave = F.wave;
    LAS int* offs = (LAS int*)F.lds;
    if (tid == 0) { int run = 0; const unsigned* gcnt = F.ctl + CW_ECNT + 64 * l;
        int* goff = (int*)(F.ws + WS_META + META_OFF) + l * 64; int* gtile = (int*)(F.ws + WS_META + META_TILE) + l * 512;
        for (int e = 0; e < NEXP; ++e) { const int c = (int)__hip_atomic_load(gcnt + e, __ATOMIC_RELAXED, __HIP_MEMORY_SCOPE_AGENT); offs[e] = run;
            if (blockIdx.x == 0) { goff[e] = run; for (int i = 0; i < (c + 255) / 256; ++i) gtile[run / 256 + i] = e; }
            run += ((c + 255) / 256) * 256; }
        offs[32] = run; if (blockIdx.x == 0) { goff[32] = run; gtile[511] = run / 256; } }
    __syncthreads();
    const int* toki = (const int*)(F.ws + WS_TOKI);
    const bf16_t* h2 = (const bf16_t*)(F.ws + WS_H); bf16_t* xs = (bf16_t*)(F.ws + WS_XS);
    const int gw = blockIdx.x * NWAVES + wave, NGW = F.G * NWAVES;
    for (int item = gw; item < SEQ * TOPK; item += NGW) {
        const int ie = toki[item], ee = ie >> 20, slot = ie & 0xfffff, tok = item >> 2;
        const size_t row = (size_t)offs[ee] + slot;
        const u32x4* src = (const u32x4*)(h2 + (size_t)tok * DM) + lane; u32x4* dst = (u32x4*)(xs + row * DM) + lane;
        const u32x4 a = src[0], b = src[64]; dst[0] = a; dst[64] = b;
    }
}
DI void phase_combine(Frame& F, int l) {
    const int lane = F.lane;
    const float* mod = (const float*)(F.ws + WS_META + META_MOD) + l * 6144;
    const int* goff = (const int*)(F.ws + WS_META + META_OFF) + l * 64;
    const int* toki = (const int*)(F.ws + WS_TOKI); const float* tokg = (const float*)(F.ws + WS_TOKI + 256 * 1024);
    const float* x1 = (const float*)(F.ws + WS_X1); const bf16_t* y2 = (const bf16_t*)(F.ws + WS_Y2);
    float* xo = (l == NLAYER - 1) ? F.ap->out : (float*)(F.ws + WS_XC);
    const int gw = blockIdx.x * NWAVES + F.wave, NGW = F.G * NWAVES;
    for (int tok = gw; tok < SEQ; tok += NGW) {
        f32x4 acc[4];
#pragma unroll
        for (int j = 0; j < 4; ++j) acc[j] = (f32x4){0.f, 0.f, 0.f, 0.f};
#pragma unroll
        for (int k = 0; k < 4; ++k) {
            const int ie = toki[tok * 4 + k]; const float g = tokg[tok * 4 + k];
            const size_t row = (size_t)goff[ie >> 20] + (ie & 0xfffff);
            const u32x2* yr = (const u32x2*)(y2 + row * DM) + lane;
#pragma unroll
            for (int j = 0; j < 4; ++j) { const u32x2 w = yr[64 * j];
                acc[j].x += g * bf2f((bf16_t)(w.x & 0xffffu)); acc[j].y += g * bf2f((bf16_t)(w.x >> 16)); acc[j].z += g * bf2f((bf16_t)(w.y & 0xffffu)); acc[j].w += g * bf2f((bf16_t)(w.y >> 16)); }
        }
        f32x4 v[4];
#pragma unroll
        for (int j = 0; j < 4; ++j) { const int c = 4 * lane + 256 * j;
            const f32x4 xi = *(const f32x4*)(x1 + (size_t)tok * DM + c), g2 = *(const f32x4*)(mod + 5 * DM + c);
            v[j] = xi + g2 * acc[j];
            *(f32x4*)(xo + (size_t)tok * DM + c) = v[j]; }
        if (l + 1 < NLAYER) { const float* mod1 = (const float*)(F.ws + WS_META + META_MOD) + (l + 1) * 6144;
            norm_mod_store(v, F.in(I_N1G) + (l + 1) * DM, mod1 + 1 * DM, mod1 + 0 * DM, (bf16_t*)(F.ws + WS_H) + (size_t)tok * DM, lane); }
    }
}

#ifndef PH_MASK
#define PH_MASK 0xFFFF
#endif
#define PHON(k) (((PH_MASK) >> (k)) & 1)
constexpr int N_PHASES = 2 + 9 * NLAYER;
__global__ void __launch_bounds__(NTHREADS, 2) mk_fwd(Args args) {
    extern __shared__ __attribute__((aligned(16))) unsigned char lds_raw[];
    Frame F;
    F.lds = (LAS unsigned char*)lds_raw; F.ws = args.ws; F.ctl = (unsigned*)(args.ws + WS_CTL);
    F.ap = (KArgP)__builtin_amdgcn_kernarg_segment_ptr();
    F.refresh(); F.G = gridDim.x;
    volatile LAS unsigned* MISC = (volatile LAS unsigned*)(F.lds + LDSCTL_OFF);
    for (int u = F.tid; u < (LDS_BYTES - LDSCTL_OFF) / 4; u += NTHREADS) MISC[u] = 0u;
    __syncthreads();
    const int lo = args.ph_lo, hi = args.ph_hi;
    XcdBarrier bar; bar.bar = F.ctl + CW_BAR; bar.x = 0; bar.st = MISC + 8;
    if (hi - lo > 1) bar = xcd_barrier_post(F.ctl + CW_BAR, MISC + 8);
#define IN(k) (lo <= (k) && (k) < hi)
#define SEAM(k) do { if (IN(k) && IN((k) + 1)) xcd_barrier(bar); } while (0)
    if (PHON(0) && IN(0)) { F.refresh(); phase_prologue(F); }
    SEAM(0);
    if (PHON(1) && IN(1)) { F.refresh(); phase_norm1_l0(F); }
    SEAM(1);
    for (int l = 0; l < NLAYER; ++l) {
        const int pb = 2 + 9 * l;
        const float* mod = (const float*)(F.ws + WS_META + META_MOD) + l * 6144;
        if (PHON(2) && IN(pb + 0)) {
            pg8::Gemm g{(const pg8::bf16_t*)(F.ws + WS_H), (const pg8::bf16_t*)(F.ws + WS_W1T) + (size_t)l * NP * DM, SEQ, NP, DM};
            pg8::StaticOrder S; S.init(SEQ, NP, F.G, (int)blockIdx.x);
            pg8::EpiBf16Plain E{(pg8::bf16_t*)(F.ws + WS_PROJ), NP};
            pg8::gemm_phase<pg8::EpiBf16Plain, pg8::StaticOrder>(F.lds, g, S, E, nullptr);
        }
        SEAM(pb + 0);
        if (PHON(3) && IN(pb + 1)) { F.refresh(); phase_postproj(F, l); }
        SEAM(pb + 1);
        if (PHON(4) && IN(pb + 2)) { F.refresh(); phase_attention(F, l); }
        SEAM(pb + 2);
        if (PHON(5) && IN(pb + 3)) {
            pg8::Gemm g{(const pg8::bf16_t*)(F.ws + WS_O), (const pg8::bf16_t*)(F.ws + WS_WOT) + (size_t)l * DM * DM, SEQ, DM, DM};
            pg8::StaticOrder S; S.init(SEQ, DM, F.G, (int)blockIdx.x);
            EpiGateRes E{(l == 0) ? F.in(I_X) : (const float*)(F.ws + WS_XC), (float*)(F.ws + WS_X1), mod + 2 * DM};
            pg8::gemm_phase<EpiGateRes, pg8::StaticOrder>(F.lds, g, S, E, nullptr);
        }
        SEAM(pb + 3);
        if (PHON(6) && IN(pb + 4)) { F.refresh(); phase_router(F, l); }
        SEAM(pb + 4);
        if (PHON(7) && IN(pb + 5)) { F.refresh(); phase_gather(F, l); }
        SEAM(pb + 5);
        if (PHON(8) && IN(pb + 6)) {
            const int* gtile = (const int*)(F.ws + WS_META + META_TILE) + l * 512;
            pg8::Gemm g{(const pg8::bf16_t*)(F.ws + WS_XS), (const pg8::bf16_t*)(F.ws + WS_WE1) + (size_t)l * NEXP * 2048 * DM, MAXROWS, NEXP * 2048, DM};
            GroupedOrder S{gtile, gtile[511], 8, F.G, (int)blockIdx.x};
            EpiSwiglu E{(bf16_t*)(F.ws + WS_Y1), F.in(I_EB1) + (size_t)l * NEXP * 2048};
            pg8::gemm_phase<EpiSwiglu, GroupedOrder>(F.lds, g, S, E, nullptr);
        }
        SEAM(pb + 6);
        if (PHON(9) && IN(pb + 7)) {
            const int* gtile = (const int*)(F.ws + WS_META + META_TILE) + l * 512;
            pg8::Gemm g{(const pg8::bf16_t*)(F.ws + WS_Y1), (const pg8::bf16_t*)(F.ws + WS_WE2) + (size_t)l * NEXP * DM * FEXP, MAXROWS, NEXP * DM, FEXP};
            GroupedOrder S{gtile, gtile[511], 4, F.G, (int)blockIdx.x};
            EpiDown E{(bf16_t*)(F.ws + WS_Y2), F.in(I_EB2) + (size_t)l * NEXP * DM};
            pg8::gemm_phase<EpiDown, GroupedOrder>(F.lds, g, S, E, nullptr);
        }
        SEAM(pb + 7);
        if (PHON(10) && IN(pb + 8)) { F.refresh(); phase_combine(F, l); }
        SEAM(pb + 8);
    }
#undef IN
#undef SEAM
}

#ifndef MK_PER_PHASE
#define MK_PER_PHASE 1
#endif
extern "C" void kernel_launch(void* const* d_in, const int* in_sizes, int n_in, void* d_out, int out_size, void* d_ws, size_t ws_size, hipStream_t stream) {
    static int grid = 0;
    if (grid == 0) {
        if (n_in != 27 || out_size != SEQ * DM || ws_size < WS_END) { fprintf(stderr, "kernel_launch: unexpected shapes (n_in %d, out %d, ws %zu)\n", n_in, out_size, ws_size); grid = -1; return; }
        int dev = 0, cus = 0, per_cu = 0;
        if (hipGetDevice(&dev) != hipSuccess || hipDeviceGetAttribute(&cus, hipDeviceAttributeMultiprocessorCount, dev) != hipSuccess) { grid = -1; return; }
        if (hipFuncSetAttribute((const void*)mk_fwd, hipFuncAttributeMaxDynamicSharedMemorySize, LDS_BYTES) != hipSuccess) { fprintf(stderr, "kernel_launch: hipFuncSetAttribute failed\n"); grid = -1; return; }
        if (hipOccupancyMaxActiveBlocksPerMultiprocessor(&per_cu, (const void*)mk_fwd, NTHREADS, LDS_BYTES) != hipSuccess || per_cu < 1) fprintf(stderr, "kernel_launch: occupancy query reports %d\n", per_cu);
        (void)hipGetLastError();
        grid = cus;
    }
    if (grid < 0) return;
    (void)in_sizes;
    if (hipMemsetAsync((char*)d_ws + WS_CTL, 0, CTL_ZERO_BYTES, stream) != hipSuccess) return;
    Args a{};
    for (int i = 0; i < 27; ++i) a.in[i] = (const float*)d_in[i];
    a.out = (float*)d_out; a.ws = (unsigned char*)d_ws;
#if MK_PER_PHASE
    for (int p = 0; p < N_PHASES; ++p) { a.ph_lo = p; a.ph_hi = p + 1; hipLaunchKernelGGL(mk_fwd, dim3(grid), dim3(NTHREADS), LDS_BYTES, stream, a); }
#else
    a.ph_lo = 0; a.ph_hi = N_PHASES;
    hipLaunchKernelGGL(mk_fwd, dim3(grid), dim3(NTHREADS), LDS_BYTES, stream, a);
#endif
}
```

```cpp
#include <hip/hip_runtime.h>
#include <stdint.h>
#include <math.h>
#include <cstdio>
#include <type_traits>

#define DI __device__ __forceinline__
#define LAS __attribute__((address_space(3)))
#define GAS __attribute__((address_space(1)))
namespace pg8 {
#define PG8_LAS __attribute__((address_space(3)))
typedef unsigned short bf16_t;
typedef short bf16x8 __attribute__((ext_vector_type(8)));
typedef float f32x4 __attribute__((ext_vector_type(4)));
typedef unsigned u32x4 __attribute__((ext_vector_type(4)));
constexpr int BM = 256, BK = 64, HALF = 128, HTB = HALF * BK * 2  , STAGE_BYTES = 8 * HTB, NXCD = 8, WGM = 8;

__host__ __device__ __forceinline__ int lds_byte(int r, int c) { const int st = (r >> 4) * 2 + (c >> 5), rr = r & 15, cc = c & 31, ob = rr * 64 + cc * 2; return st * 1024 + (ob ^ (((ob >> 9) & 1) << 5)); }
__host__ __device__ __forceinline__ void stage_rc(int b, int& R, int& C) { const int st = b / 1024, sb = b % 1024, swz = sb ^ (((sb >> 9) & 1) << 5); R = (st >> 1) * 16 + swz / 64; C = (st & 1) * 32 + (swz % 64) / 2; }
__host__ __device__ __forceinline__ int perm32(int rho) { const int n = rho >> 4, i = rho & 15; return 8 * (i >> 2) + 4 * n + (i & 3); }

struct Unit { int pm, pn; };
struct Gemm { const bf16_t* A; const bf16_t* Bt; int M, N, K; };

struct StaticOrder {
    int nM, nN, nwg, G, c;
    __host__ __device__ void init(int M, int N, int G_, int c_) { nM = M / BM; nN = N / BM; nwg = nM * nN; G = G_; c = c_; }
    __host__ __device__ bool next(int i, Unit& u) const {
        const long L = (long)i * G + c; if (L >= nwg) return false;
        int wgid = (int)L; { const int q = nwg / NXCD, r = nwg % NXCD, xcd = wgid % NXCD, off = wgid / NXCD; wgid = (xcd < r ? xcd * (q + 1) : r * (q + 1) + (xcd - r) * q) + off; }
        const int nig = WGM * nN, gid = wgid / nig, fm = gid * WGM, gsz = (nM - fm) < WGM ? (nM - fm) : WGM;
        u.pm = fm + ((wgid % nig) % gsz); u.pn = (wgid % nig) / gsz; return true;
    }
    __device__ __forceinline__ void a_ready(const Unit&) const {}
    __device__ __forceinline__ void done(const Unit&) const {}
};
__device__ __forceinline__ unsigned cvt_pk_bf16(float lo, float hi) { unsigned r; asm volatile("v_cvt_pk_bf16_f32 %0, %1, %2" : "=v"(r) : "v"(lo), "v"(hi)); return r; }
typedef float f32x2 __attribute__((ext_vector_type(2)));
struct EpiBf16Plain {
    static constexpr bool PERM = true, AFTER_DRAIN = false;
    bf16_t* O; int ldc;
    __device__ __forceinline__ void operator()(const f32x4 (&acc)[2][2][4][2], const Unit& u, int wr, int wc, int fr, int fq) const {
        const int row0 = u.pm * BM + wr * 64 + fr, col0 = u.pn * BM + wc * 32 + 8 * fq;
#pragma unroll
        for (int ai = 0; ai < 2; ++ai)
#pragma unroll
            for (int m = 0; m < 4; ++m) { bf16_t* rowp = O + (size_t)(row0 + ai * HALF + m * 16) * ldc + col0;
#pragma unroll
                for (int bj = 0; bj < 2; ++bj) { const f32x4 v0 = acc[ai][bj][m][0], v1 = acc[ai][bj][m][1];
                    u32x4 w; w.x = cvt_pk_bf16(v0[0], v0[1]); w.y = cvt_pk_bf16(v0[2], v0[3]); w.z = cvt_pk_bf16(v1[0], v1[1]); w.w = cvt_pk_bf16(v1[2], v1[3]);
                    *(u32x4*)(rowp + bj * HALF) = w; } }
    }
};
template <class Epi, class Sched, bool STAMP = false, bool GATHER = false, int ESZ = 2>
__device__ __forceinline__ void gemm_phase(PG8_LAS unsigned char* lds, const Gemm g, const Sched& S, const Epi& E, unsigned long long* stamps) {
    int tid_ = threadIdx.x; asm volatile("" : "+v"(tid_));
    const int tid = tid_, wid = __builtin_amdgcn_readfirstlane(tid >> 6), lane = tid & 63, wr = wid >> 2, wc = wid & 3, fr = lane & 15, fq = lane >> 4;
    const int K = g.K, Kb = K * ESZ  , nt = Kb / (BK * 2);
    int ts_lo = 0, ts_hi = 0, nts = 0; const unsigned long long rt_entry = STAMP ? (unsigned long long)wall_clock64() : 0ull;
#define PG8_STAMP() do { if (STAMP && wid == 0 && nts < 64) { const unsigned long long _c = (unsigned long long)clock64(); \
        ts_lo = (lane == nts) ? (int)(unsigned)_c : ts_lo; ts_hi = (lane == nts) ? (int)(unsigned)(_c >> 32) : ts_hi; ++nts; } } while (0)
    PG8_STAMP();
    unsigned voffA[2], voffB[2];
    int gaR[2]; unsigned gaC2[2];
#pragma unroll
    for (int i = 0; i < 2; ++i) { int R, C; stage_rc(tid * 16 + i * 8192, R, C); const int Rb = Epi::PERM ? ((R & ~31) + perm32(R & 31)) : R;
        voffA[i] = (unsigned)(R * Kb + C * 2); voffB[i] = (unsigned)(Rb * Kb + C * 2); gaR[i] = R; gaC2[i] = (unsigned)C * 2u; }
    unsigned gaCur[2][2], gaNxt[2][2];
#define PG8_GAFILL(dst, u_) do { _Pragma("unroll") for (int h_ = 0; h_ < 2; ++h_) _Pragma("unroll") for (int i_ = 0; i_ < 2; ++i_) dst[h_][i_] = (unsigned)S.arow(u_, h_ * HALF + gaR[i_]) * (unsigned)Kb + gaC2[i_]; } while (0)
#define PG8_STAGE_A(bufoff, kb_, h_, nx_) do { if constexpr (GATHER) { _Pragma("unroll") for (int _i = 0; _i < 2; ++_i) \
        __builtin_amdgcn_global_load_lds((const unsigned*)((const char*)g.A + (kb_) + ((nx_) ? gaNxt[h_][_i] : gaCur[h_][_i])), (PG8_LAS unsigned*)(lds + (bufoff) + ldsw + _i * 8192), 16, 0, 0); } \
        else { PG8_STAGE(bufoff, ((nx_) ? nA : cA) + (kb_) + (h_) * hstep, voffA); } } while (0)
    const size_t kstep = (size_t)(BK * 2);
    const size_t hstep = (size_t)HALF * Kb;
    const size_t tstep = 2 * hstep;
    const unsigned ldsw = (unsigned)wid * 1024u;
    constexpr int KOFF = (ESZ == 2) ? 1024 : 16;
    int mxscale = 0x7F7F7F7F; asm volatile("" : "+v"(mxscale));
    const int aoff = lds_byte(wr * 64 + fr, ESZ == 2 ? fq * 8 : fq * 16), boff = lds_byte(wc * 32 + fr, ESZ == 2 ? fq * 8 : fq * 16);
#define PG8_SA(b, h) (((b) * 2 + (h)) * HTB)
#define PG8_SB(b, h) ((4 + (b) * 2 + (h)) * HTB)
#define PG8_STAGE(bufoff, gbase, voff) do { _Pragma("unroll") for (int _i = 0; _i < 2; ++_i) \
        __builtin_amdgcn_global_load_lds((const unsigned*)((const char*)(gbase) + (voff)[_i]), (PG8_LAS unsigned*)(lds + (bufoff) + ldsw + _i * 8192), 16, 0, 0); } while (0)
#define PG8_LDA(dst, b, h) do { _Pragma("unroll") for (int m = 0; m < 4; ++m) _Pragma("unroll") for (int k = 0; k < 2; ++k) dst[m][k] = *(const PG8_LAS bf16x8*)(lds + PG8_SA(b, h) + aoff + m * 2048 + k * KOFF); } while (0)
#define PG8_LDB(dst, b, h) do { _Pragma("unroll") for (int n = 0; n < 2; ++n) _Pragma("unroll") for (int k = 0; k < 2; ++k) dst[n][k] = *(const PG8_LAS bf16x8*)(lds + PG8_SB(b, h) + boff + n * 2048 + k * KOFF); } while (0)
#define PG8_MMA(ai, bj, At, Bt) do { __builtin_amdgcn_s_setprio(1); _Pragma("unroll") for (int m = 0; m < 4; ++m) _Pragma("unroll") for (int n = 0; n < 2; ++n) { \
        if constexpr (ESZ == 2) { _Pragma("unroll") for (int k = 0; k < 2; ++k) acc[ai][bj][m][n] = __builtin_amdgcn_mfma_f32_16x16x32_bf16(Bt[n][k], At[m][k], acc[ai][bj][m][n], 0, 0, 0); } \
        else { typedef int i32x4_ __attribute__((ext_vector_type(4))); typedef int i32x8_ __attribute__((ext_vector_type(8))); \
            const i32x8_ b8_ = __builtin_shufflevector(__builtin_bit_cast(i32x4_, Bt[n][0]), __builtin_bit_cast(i32x4_, Bt[n][1]), 0, 1, 2, 3, 4, 5, 6, 7); \
            const i32x8_ a8_ = __builtin_shufflevector(__builtin_bit_cast(i32x4_, At[m][0]), __builtin_bit_cast(i32x4_, At[m][1]), 0, 1, 2, 3, 4, 5, 6, 7); \
            asm volatile("v_mfma_scale_f32_16x16x128_f8f6f4 %0, %1, %2, %0, %3, %3 op_sel_hi:[0,0,0]" : "+v"(acc[ai][bj][m][n]) : "v"(b8_), "v"(a8_), "v"(mxscale)); } } \
        __builtin_amdgcn_s_setprio(0); } while (0)
#define PG8_WAIT_V(n) asm volatile("s_waitcnt vmcnt(" #n ")" ::: "memory")
#define PG8_WAIT_L(n) asm volatile("s_waitcnt lgkmcnt(" #n ")" ::: "memory")
#define PG8_BAR __builtin_amdgcn_s_barrier()
#define PG8_SCHED __builtin_amdgcn_sched_barrier(0)
    Unit cur, nxt; int ui = 0;
    if (!S.next(0, cur)) return;
    f32x4 acc[2][2][4][2];
#pragma unroll
    for (int a = 0; a < 2; ++a)
#pragma unroll
        for (int b = 0; b < 2; ++b)
#pragma unroll
            for (int m = 0; m < 4; ++m)
#pragma unroll
                for (int n = 0; n < 2; ++n) acc[a][b][m][n] = (f32x4){0.f, 0.f, 0.f, 0.f};
    bf16x8 At[4][2], B0[2][2], B1[2][2];
    const char* cA = (const char*)g.A + (size_t)cur.pm * tstep; const char* cB = (const char*)g.Bt + (size_t)cur.pn * tstep;
    S.a_ready(cur);
    const char* nA = cA; if constexpr (GATHER) { PG8_GAFILL(gaCur, cur); _Pragma("unroll") for (int h_ = 0; h_ < 2; ++h_) _Pragma("unroll") for (int i_ = 0; i_ < 2; ++i_) gaNxt[h_][i_] = gaCur[h_][i_]; }
    PG8_STAGE(PG8_SB(0, 0), cB, voffB); PG8_STAGE_A(PG8_SA(0, 0), 0, 0, false); PG8_STAGE(PG8_SB(0, 1), cB + hstep, voffB); PG8_STAGE_A(PG8_SA(0, 1), 0, 1, false);
    if (wr == 1) PG8_BAR;
    PG8_WAIT_V(4); PG8_BAR;
    PG8_STAGE(PG8_SB(1, 0), cB + kstep, voffB); PG8_STAGE_A(PG8_SA(1, 0), kstep, 0, false); PG8_STAGE(PG8_SB(1, 1), cB + hstep + kstep, voffB);
    PG8_WAIT_V(6); PG8_BAR;
    PG8_STAMP();
    for (;;) {
        const bool has_next = S.next(ui + 1, nxt);
        nA = has_next ? (const char*)g.A + (size_t)nxt.pm * tstep : cA; const char* nB = has_next ? (const char*)g.Bt + (size_t)nxt.pn * tstep : cB;
        if constexpr (GATHER) { if (has_next && ui == 0) PG8_GAFILL(gaNxt, nxt); }
        for (int t = 0; t < nt; t += 2) {
            const bool last = (t == nt - 2);
            const size_t ka1 = (size_t)(t + 1) * kstep;
            const size_t ka2 = last ? 0 : (size_t)(t + 2) * kstep; const char* b2 = last ? nB : cB + (size_t)(t + 2) * kstep;
            const size_t ka3 = ka2 + kstep; const char* b3 = b2 + kstep;
            const bool nxa = last && has_next;
            if (last && has_next) S.a_ready(nxt);
            PG8_LDB(B0, 0, 0); PG8_SCHED; PG8_LDA(At, 0, 0); PG8_STAGE_A(PG8_SA(1, 1), ka1, 1, false);
            PG8_WAIT_L(8); PG8_BAR; PG8_WAIT_L(0); PG8_MMA(0, 0, At, B0); PG8_BAR; PG8_SCHED;
            PG8_LDB(B1, 0, 1); PG8_STAGE(PG8_SB(0, 0), b2, voffB);
            PG8_BAR; PG8_WAIT_L(0); PG8_MMA(0, 1, At, B1); PG8_BAR;
            PG8_LDA(At, 0, 1); PG8_STAGE_A(PG8_SA(0, 0), ka2, 0, nxa);
            PG8_BAR; PG8_WAIT_L(0); PG8_MMA(1, 0, At, B0); PG8_BAR; PG8_SCHED;
            PG8_STAGE(PG8_SB(0, 1), b2 + hstep, voffB);
            PG8_WAIT_V(6); PG8_BAR; PG8_MMA(1, 1, At, B1); PG8_BAR;
            PG8_LDB(B0, 1, 0); PG8_SCHED; PG8_LDA(At, 1, 0); PG8_STAGE_A(PG8_SA(0, 1), ka2, 1, nxa);
            PG8_WAIT_L(8); PG8_BAR; PG8_WAIT_L(0); PG8_MMA(0, 0, At, B0); PG8_BAR; PG8_SCHED;
            PG8_LDB(B1, 1, 1); PG8_STAGE(PG8_SB(1, 0), b3, voffB);
            PG8_BAR; PG8_WAIT_L(0); PG8_MMA(0, 1, At, B1); PG8_BAR;
            PG8_LDA(At, 1, 1); PG8_STAGE_A(PG8_SA(1, 0), ka3, 0, nxa);
            PG8_BAR; PG8_WAIT_L(0); PG8_MMA(1, 0, At, B0); PG8_BAR; PG8_SCHED;
            PG8_STAGE(PG8_SB(1, 1), b3 + hstep, voffB);
            PG8_WAIT_V(6); PG8_BAR; PG8_MMA(1, 1, At, B1); PG8_BAR;
        }
        PG8_STAMP();
        if constexpr (GATHER) { Unit n2_; if (has_next && S.next(ui + 2, n2_)) PG8_GAFILL(gaCur, n2_); }
        if constexpr (ESZ == 1) asm volatile("s_nop 15\n\ts_nop 15\n\ts_nop 7" ::: "memory");
        if constexpr (!Epi::AFTER_DRAIN) { E(acc, cur, wr, wc, fr, fq); S.done(cur); }
        PG8_STAMP();
        if (!has_next) break;
#pragma unroll
        for (int a = 0; a < 2; ++a)
#pragma unroll
            for (int b = 0; b < 2; ++b)
#pragma unroll
                for (int m = 0; m < 4; ++m)
#pragma unroll
                    for (int n = 0; n < 2; ++n) acc[a][b][m][n] = (f32x4){0.f, 0.f, 0.f, 0.f};
        cur = nxt; cA = nA; cB = nB; ++ui;
        if constexpr (GATHER) { _Pragma("unroll") for (int h_ = 0; h_ < 2; ++h_) _Pragma("unroll") for (int i_ = 0; i_ < 2; ++i_) { const unsigned t_ = gaCur[h_][i_]; gaCur[h_][i_] = gaNxt[h_][i_]; gaNxt[h_][i_] = t_; } }
    }
    PG8_WAIT_V(0);
    if (wr == 0) PG8_BAR;
    PG8_BAR;
    if constexpr (Epi::AFTER_DRAIN) { E.fused(acc, cur, wr, wc, fr, fq, lds, wid, lane); S.done(cur); }
    PG8_STAMP();
    if (STAMP && wid == 0) { stamps[lane] = lane < nts ? (((unsigned long long)(unsigned)ts_hi << 32) | (unsigned)ts_lo) : 0ull;
        if (lane == 62) stamps[62] = rt_entry; if (lane == 63) stamps[63] = (unsigned long long)wall_clock64(); }
#undef PG8_STAMP
#undef PG8_SA
#undef PG8_SB
#undef PG8_STAGE
#undef PG8_STAGE_A
#undef PG8_GAFILL
#undef PG8_LDA
#undef PG8_LDB
#undef PG8_MMA
#undef PG8_WAIT_V
#undef PG8_WAIT_L
#undef PG8_BAR
#undef PG8_SCHED
}
}

#define XB_TMO      128
#define XB_XCNT(j)  (256  + 64 * (j))
#define XB_XSUB(j)  (1280 + 64 * (j))
#define XB_XGEN(j)  (2304 + 64 * (j))
#define XB_TOP      3328
#define XB_TOPGEN   3392
#define XCD_BAR_WORDS 3456
#define XB_SPIN_CAP (1u << 24)
#define LAS __attribute__((address_space(3)))

__device__ __forceinline__ unsigned xb_ld(unsigned* p)              { return __hip_atomic_load(p, __ATOMIC_RELAXED, __HIP_MEMORY_SCOPE_AGENT); }
__device__ __forceinline__ unsigned xb_add(unsigned* p, unsigned v) { return __hip_atomic_fetch_add(p, v, __ATOMIC_RELAXED, __HIP_MEMORY_SCOPE_AGENT); }
__device__ __forceinline__ unsigned xb_xcc_id() { return (unsigned)__builtin_amdgcn_s_getreg((3 << 11) | 20) & 0xFu; }
#define XB_SPIN(cond, bar) do { unsigned _sp = 0; while (cond) { __builtin_amdgcn_s_sleep(1); \
    if ((++_sp & 255u) == 0u) { if (xb_ld(&(bar)[XB_TMO])) break; if (_sp > XB_SPIN_CAP) { atomicAdd(&(bar)[XB_TMO], 1u); break; } } } } while (0)

struct XcdBarrier {
    unsigned* bar; unsigned x;
    volatile LAS unsigned* st;
};

__device__ __forceinline__ XcdBarrier xcd_barrier_post(unsigned* bar, volatile LAS unsigned* st) {
    XcdBarrier b; b.bar = bar; b.x = xb_xcc_id(); b.st = st;
    if (threadIdx.x == 0) (void)xb_add(&bar[XB_XCNT(b.x)], 1u);
    return b;
}
__device__ __forceinline__ void xcd_barrier_complete(unsigned* bar, unsigned x, unsigned& nloc, unsigned& nx) {
    const unsigned G = gridDim.x * gridDim.y * gridDim.z;
    unsigned sum, cnt, mine, sp = 0u;
    for (;;) {
        sum = 0u; cnt = 0u; mine = 0u;
#pragma unroll
        for (unsigned j = 0; j < 16; ++j) { const unsigned c = xb_ld(&bar[XB_XCNT(j)]); sum += c; cnt += (c > 0u) ? 1u : 0u; mine = (j == x) ? c : mine; }
        if (sum == G) break;
        __builtin_amdgcn_s_sleep(1);
        if ((++sp & 255u) == 0u) { if (xb_ld(&bar[XB_TMO])) break; if (sp > XB_SPIN_CAP) { atomicAdd(&bar[XB_TMO], 1u); break; } }
    }
    nloc = mine > 0u ? mine : 1u; nx = cnt > 0u ? cnt : 1u;
}

__device__ __forceinline__ void xcd_barrier(const XcdBarrier& b) {
    asm volatile("s_waitcnt vmcnt(0)" ::: "memory");
    __syncthreads();
    if (threadIdx.x == 0) {
        unsigned* bar = b.bar;
        __builtin_amdgcn_s_waitcnt(0);
        unsigned nloc = b.st[0], nx = b.st[1];
        if (nloc == 0u) { xcd_barrier_complete(bar, b.x, nloc, nx); b.st[0] = nloc; b.st[1] = nx; }
        const unsigned old = xb_add(&bar[XB_XSUB(b.x)], 1u);
        const unsigned gen = old / nloc;
        if (old + 1u == (gen + 1u) * nloc) {
            __builtin_amdgcn_fence(__ATOMIC_RELEASE, "agent");
            asm volatile("s_waitcnt vmcnt(0)" ::: "memory");
            const unsigned og = xb_add(&bar[XB_TOP], 1u);
            const unsigned tg = og / nx;
            if (og + 1u == (tg + 1u) * nx) xb_add(&bar[XB_TOPGEN], 1u);
            else XB_SPIN(xb_ld(&bar[XB_TOPGEN]) == tg, bar);
            __builtin_amdgcn_fence(__ATOMIC_ACQUIRE, "agent");
            xb_add(&bar[XB_XGEN(b.x)], 1u);
            asm volatile("s_waitcnt vmcnt(0)" ::: "memory");
        } else {
            XB_SPIN(xb_ld(&bar[XB_XGEN(b.x)]) == gen, bar);
            __builtin_amdgcn_fence(__ATOMIC_ACQUIRE, "agent");
            asm volatile("s_waitcnt vmcnt(0)" ::: "memory");
        }
    }
    __syncthreads();
}

typedef unsigned short bf16_t;
typedef short bf16x8 __attribute__((ext_vector_type(8)));
typedef float f32x4 __attribute__((ext_vector_type(4)));
typedef float f32x16 __attribute__((ext_vector_type(16)));
typedef unsigned u32x4 __attribute__((ext_vector_type(4)));
typedef unsigned u32x2 __attribute__((ext_vector_type(2)));
typedef float f32x2_t __attribute__((ext_vector_type(2)));
typedef __bf16 bf16x2_t __attribute__((ext_vector_type(2)));

constexpr int SEQ = 16384, DM = 1024, NLAYER = 2;
constexpr int IN_COLS = 2724, NP = 2816;
constexpr int NEXP = 32, TOPK = 4, FEXP = 1024;
constexpr int MAXROWS = SEQ * TOPK + NEXP * 256;
constexpr int NWAVES = 8, NTHREADS = 512;
constexpr float EPS = 1e-6f;
constexpr float LOG2E = 1.4426950408889634f;
constexpr float QSCALE64 = 0.125f * LOG2E;
constexpr float QSCALE96 = 0.10206207261596577f * LOG2E;

constexpr int PC_CQ = 0, PC_CKV = 256, PC_KR = 384, PC_FLOG = 416, PC_FQ = 448, PC_FK = 704, PC_FV = 960, PC_MQ = 1216, PC_MK = 1472, PC_MV = 1728, PC_DQ = 1984, PC_DK = 2240, PC_DV = 2496;

constexpr size_t MiB = 1u << 20;
constexpr size_t WS_CTL = 0, CTL_ZERO_BYTES = 1 * MiB;
constexpr size_t WS_META = 1 * MiB;
constexpr size_t WS_W1T = 2 * MiB;
constexpr size_t WS_WOT = 14 * MiB;
constexpr size_t WS_WUQ = 18 * MiB;
constexpr size_t WS_WUKV = 19 * MiB;
constexpr size_t WS_WE1 = 32 * MiB;
constexpr size_t WS_WE2 = 288 * MiB;
constexpr size_t WS_H = 416 * MiB;
constexpr size_t WS_PROJ = 448 * MiB;
constexpr size_t WS_QA = 536 * MiB, WS_KA = 548 * MiB, WS_VAT = 560 * MiB;
constexpr size_t WS_QB = 568 * MiB, WS_KB = 576 * MiB, WS_VBT = 584 * MiB;
constexpr size_t WS_QC = 592 * MiB, WS_KC = 600 * MiB, WS_VCT = 608 * MiB;
constexpr size_t WS_QD = 616 * MiB, WS_KD = 624 * MiB, WS_VDT = 632 * MiB;
constexpr size_t WS_FLOC = 640 * MiB;
constexpr size_t WS_FTILE = 640 * MiB + 256 * 1024;
constexpr size_t WS_KSUM = 640 * MiB + 512 * 1024;
constexpr size_t WS_O = 642 * MiB;
constexpr size_t WS_X1 = 674 * MiB;
constexpr size_t WS_XC = 738 * MiB;
constexpr size_t WS_XS = 802 * MiB;
constexpr size_t WS_Y1 = 946 * MiB;
constexpr size_t WS_Y2 = 1090 * MiB;
constexpr size_t WS_TOKI = 1234 * MiB;
constexpr size_t WS_BLIST = 1236 * MiB;
constexpr size_t WS_PM = 1252 * MiB;
constexpr size_t WS_PO = 1254 * MiB;
constexpr size_t WS_DM = 1286 * MiB;
constexpr size_t WS_DO = 1288 * MiB;
constexpr size_t WS_INV = 1320 * MiB;
constexpr size_t WS_H8 = 1322 * MiB;
constexpr size_t WS_END = 1340 * MiB;
constexpr size_t META_MOD = 0;
constexpr size_t META_OFF = 64 * 1024;
constexpr size_t META_TILE = 68 * 1024;
constexpr int CW_BAR = 4096;
constexpr int CW_QUEUE = 8192;
constexpr int CW_ECNT = 12288;
constexpr int CW_BCNT = 16384;
constexpr int CW_MQ = 20480;
constexpr int CW_YCNT = 24576;

constexpr int GEN_BYTES = 139264;
constexpr int LDSCTL_OFF = GEN_BYTES;
constexpr int LDS_BYTES = GEN_BYTES + 1024;

DI float bf2f(bf16_t b) { return __uint_as_float(((unsigned)b) << 16); }
DI unsigned pk2(float lo, float hi) { f32x2_t v = {lo, hi}; bf16x2_t b = __builtin_convertvector(v, bf16x2_t); return __builtin_bit_cast(unsigned, b); }
DI bf16_t f2bf(float f) { return (bf16_t)(pk2(f, 0.f) & 0xffffu); }
DI float wave_sum(float v) {
#pragma unroll
    for (int o = 1; o < 64; o <<= 1) v += __shfl_xor(v, o);
    return v;
}
DI float wave_max(float v) {
#pragma unroll
    for (int o = 1; o < 64; o <<= 1) v = fmaxf(v, __shfl_xor(v, o));
    return v;
}
DI void unpack8(const bf16x8 r, float (&x)[8]) {
#pragma unroll
    for (int i = 0; i < 8; ++i) x[i] = bf2f((bf16_t)r[i]);
}
DI u32x4 pack8(const float (&y)[8]) { u32x4 w; w.x = pk2(y[0], y[1]); w.y = pk2(y[2], y[3]); w.z = pk2(y[4], y[5]); w.w = pk2(y[6], y[7]); return w; }
#ifndef UP_FP8
#define UP_FP8 1
#endif
#ifndef MOE_FP8
#define MOE_FP8 1
#endif
constexpr float WSCALE = 32.0f, WINV = 1.0f / 32.0f;
DI unsigned pk4_fp8(float a, float b, float c, float d) { int w = 0; w = __builtin_amdgcn_cvt_pk_fp8_f32(a, b, w, false); w = __builtin_amdgcn_cvt_pk_fp8_f32(c, d, w, true); return (unsigned)w; }
DI int crow(int r, int hi) { return (r & 3) + 8 * (r >> 2) + 4 * hi; }
DI float max_x32(float v) { const auto rr = __builtin_amdgcn_permlane32_swap(__float_as_uint(v), __float_as_uint(v), false, false); return fmaxf(__uint_as_float(rr[0]), __uint_as_float(rr[1])); }
DI float sum_x32(float v) { const auto rr = __builtin_amdgcn_permlane32_swap(__float_as_uint(v), __float_as_uint(v), false, false); return __uint_as_float(rr[0]) + __uint_as_float(rr[1]); }
#define MFMA32(a, b, c) __builtin_amdgcn_mfma_f32_32x32x16_bf16((a), (b), (c), 0, 0, 0)

struct Args { const float* in[27]; float* out; unsigned char* ws; int ph_lo, ph_hi; };
typedef const __attribute__((address_space(4))) Args* KArgP;
struct Frame {
    LAS unsigned char* lds;
    unsigned char* ws;
    unsigned* ctl;
    KArgP ap;
    int tid, lane, wave, G;
    DI const float* in(int i) const { return ap->in[i]; }
    DI void refresh() { int t = threadIdx.x; asm volatile("" : "+v"(t)); tid = t; lane = t & 63; wave = __builtin_amdgcn_readfirstlane(t >> 6); }
};
enum { I_X = 0, I_C, I_WMOD, I_BMOD, I_N1G, I_N2G, I_WIN, I_CQG, I_WUQ, I_CKVG, I_WUKV, I_MQG, I_MKG, I_FQG, I_FKG, I_FBF, I_MOQG, I_MOKG, I_DQG, I_DKG, I_WOUT, I_RW, I_RB, I_EW1, I_EB1, I_EW2, I_EB2 };

DI int map_win(int n) {
    if (n < 416) return n;
    if (n < 420) return 1184 + (n - 416);
    if (n < 448) return -1;
    if (n < 1216) return n - 32;
    if (n < 2752) return n - 28;
    return -1;
}
DI int map_w1(int n) { return ((n >> 7) & 1) * 1024 + (n >> 8) * 128 + (n & 127); }
template <int MAP> DI void transpose_item(const float* W, int K, int Nsrc, bf16_t* WT, int k0, int n0, LAS float* scr, int lane) {
    const int nn = n0 + (lane & 31);
    const int ns = (MAP == 0) ? nn : (MAP == 1 ? map_win(nn) : map_w1(nn));
    float v[32];
#pragma unroll
    for (int i = 0; i < 32; ++i) { const int kk = 2 * i + (lane >> 5); v[i] = (ns >= 0) ? W[(size_t)(k0 + kk) * Nsrc + ns] : 0.f; }
#pragma unroll
    for (int i = 0; i < 32; ++i) { const int kk = 2 * i + (lane >> 5); scr[kk * 33 + (lane & 31)] = v[i]; }
    asm volatile("s_waitcnt lgkmcnt(0)" ::: "memory");
    const int c = lane & 7;
#pragma unroll
    for (int j = 0; j < 4; ++j) { const int n = (lane >> 3) + 8 * j; const LAS float* s = scr + (8 * c) * 33 + n;
        u32x4 o; o.x = pk2(s[0 * 33], s[1 * 33]); o.y = pk2(s[2 * 33], s[3 * 33]); o.z = pk2(s[4 * 33], s[5 * 33]); o.w = pk2(s[6 * 33], s[7 * 33]);
        *(u32x4*)(WT + (size_t)(n0 + n) * K + k0 + 8 * c) = o; }
    asm volatile("s_waitcnt lgkmcnt(0)" ::: "memory");
}
DI void norm_mod_store(const f32x4 (&v)[4], const float* g, const float* sc, const float* sh, bf16_t* hrow, int lane) {
    float ss = 0.f;
#pragma unroll
    for (int j = 0; j < 4; ++j) ss += (v[j].x * v[j].x + v[j].y * v[j].y) + (v[j].z * v[j].z + v[j].w * v[j].w);
    ss = wave_sum(ss);
    const float rstd = 1.0f / sqrtf(ss * (1.0f / DM) + EPS);
#pragma unroll
    for (int j = 0; j < 4; ++j) {
        const int c = 4 * lane + 256 * j;
        const f32x4 g4 = *(const f32x4*)(g + c), s4 = *(const f32x4*)(sc + c), h4 = *(const f32x4*)(sh + c);
        const f32x4 y = (v[j] * rstd) * g4 * (s4 + 1.0f) + h4;
        u32x2 w; w.x = pk2(y.x, y.y); w.y = pk2(y.z, y.w);
        *(u32x2*)(hrow + c) = w;
    }
}
#ifndef BG_CONVERT
#define BG_CONVERT 1
#endif
DI void phase_prologue(Frame& F) {
    const int tid = F.tid, lane = F.lane, wave = F.wave;
    float* mod = (float*)(F.ws + WS_META + META_MOD);
    if (blockIdx.x < 192) {
        LAS float* scv = (LAS float*)F.lds;
        LAS float* part = (LAS float*)(F.lds + 4096);
        for (int i = tid; i < DM; i += NTHREADS) { const float cv = F.in(I_C)[i]; scv[i] = cv / (1.0f + __expf(-cv)); }
        __syncthreads();
        const int l = blockIdx.x / 96, col = (blockIdx.x % 96) * 64 + lane;
        const float* wm = F.in(I_WMOD) + (size_t)l * DM * 6144 + col;
        float acc = 0.f;
#pragma unroll 8
        for (int k = wave * 128; k < wave * 128 + 128; ++k) acc += scv[k] * wm[(size_t)k * 6144];
        part[wave * 64 + lane] = acc;
        __syncthreads();
        if (wave == 0) { float s = 0.f;
#pragma unroll
            for (int w = 0; w < 8; ++w) s += part[w * 64 + lane];
            mod[l * 6144 + col] = s + F.in(I_BMOD)[l * 6144 + col]; }
        __syncthreads();
    }
    {
        LAS float* scr = (LAS float*)(F.lds + 8192 + wave * 8704);
        const int gw = blockIdx.x * NWAVES + wave, NGW = F.G * NWAVES;
        constexpr int T_E1 = 32 * 16 * 64, T_E2 = 32 * 16 * 32, T_W1 = 16 * 88, T_WO = 16 * 32, T_UQ = 4 * 12, T_UKV = 2 * 16;
        constexpr int T_LAYER = T_E1 + T_E2 + T_W1 + T_WO + T_UQ + T_UKV;
        for (int it = gw; it < NLAYER * T_LAYER; it += NGW) {
            const int l = it / T_LAYER; int r = it % T_LAYER;
            if (BG_CONVERT && r < T_E1 + T_E2) continue;
            if (r < T_E1) { const int e = r / (16 * 64), q = r % (16 * 64), kb = q / 64, nb = q % 64;
                transpose_item<2>(F.in(I_EW1) + ((size_t)l * NEXP + e) * DM * 2048, DM, 2048, (bf16_t*)(F.ws + WS_WE1) + ((size_t)l * NEXP + e) * 2048 * DM, 64 * kb, 32 * nb, scr, lane); continue; }
            r -= T_E1;
            if (r < T_E2) { const int e = r / (16 * 32), q = r % (16 * 32), kb = q / 32, nb = q % 32;
                transpose_item<0>(F.in(I_EW2) + ((size_t)l * NEXP + e) * FEXP * DM, FEXP, DM, (bf16_t*)(F.ws + WS_WE2) + ((size_t)l * NEXP + e) * DM * FEXP, 64 * kb, 32 * nb, scr, lane); continue; }
            r -= T_E2;
            if (r < T_W1) { const int kb = r / 88, nb = r % 88;
                transpose_item<1>(F.in(I_WIN) + (size_t)l * DM * IN_COLS, DM, IN_COLS, (bf16_t*)(F.ws + WS_W1T) + (size_t)l * NP * DM, 64 * kb, 32 * nb, scr, lane); continue; }
            r -= T_W1;
            if (r < T_WO) { const int kb = r / 32, nb = r % 32;
                transpose_item<0>(F.in(I_WOUT) + (size_t)l * DM * DM, DM, DM, (bf16_t*)(F.ws + WS_WOT) + (size_t)l * DM * DM, 64 * kb, 32 * nb, scr, lane); continue; }
            r -= T_WO;
            if (r < T_UQ) { const int kb = r / 12, nb = r % 12;
                transpose_item<0>(F.in(I_WUQ) + (size_t)l * 256 * 384, 256, 384, (bf16_t*)(F.ws + WS_WUQ) + (size_t)l * 384 * 256, 64 * kb, 32 * nb, scr, lane); continue; }
            r -= T_UQ;
            { const int kb = r / 16, nb = r % 16;
                transpose_item<0>(F.in(I_WUKV) + (size_t)l * 128 * 512, 128, 512, (bf16_t*)(F.ws + WS_WUKV) + (size_t)l * 512 * 128, 64 * kb, 32 * nb, scr, lane); }
        }
    }
}
DI void phase_norm1_l0(Frame& F) {
    const float* mod = (const float*)(F.ws + WS_META + META_MOD);
    const int gw = blockIdx.x * NWAVES + F.wave, NGW = F.G * NWAVES;
    for (int m = gw; m < SEQ; m += 2 * NGW) {
        const int m2 = m + NGW;
        const f32x4* xr = (const f32x4*)(F.in(I_X) + (size_t)m * DM) + F.lane;
        const f32x4* xr2 = (const f32x4*)(F.in(I_X) + (size_t)(m2 < SEQ ? m2 : m) * DM) + F.lane;
        f32x4 v[4], w[4];
#pragma unroll
        for (int j = 0; j < 4; ++j) { v[j] = xr[64 * j]; w[j] = xr2[64 * j]; }
        norm_mod_store(v, F.in(I_N1G), mod + 1 * DM  , mod + 0 * DM  , (bf16_t*)(F.ws + WS_H) + (size_t)m * DM, F.lane);
        if (m2 < SEQ) norm_mod_store(w, F.in(I_N1G), mod + 1 * DM, mod + 0 * DM, (bf16_t*)(F.ws + WS_H) + (size_t)m2 * DM, F.lane);
    }
}

constexpr double rope_rev(int j) {
    return j == 0 ? 0.15915494309189535 : j == 1 ? 0.08949940160889101 : j == 2 ? 0.050329212104487035 : j == 3 ? 0.0283021958306234 : j == 4 ? 0.015915494309189534 :
           j == 5 ? 0.008949940160889102 : j == 6 ? 0.005032921210448704 : j == 7 ? 0.00283021958306234 : j == 8 ? 0.0015915494309189536 : j == 9 ? 0.0008949940160889102 :
           j == 10 ? 0.0005032921210448703 : j == 11 ? 0.00028302195830623395 : j == 12 ? 0.00015915494309189535 : j == 13 ? 8.949940160889102e-05 : j == 14 ? 5.0329212104487035e-05 : 2.8302195830623396e-05;
}
template <int JB> DI void rope_cs(int t, int hi, float& sn, float& cs) {
    const double c = hi ? rope_rev(JB + 4) : rope_rev(JB);
    const double rev = (double)t * c;
    const float fr = (float)(rev - __builtin_rint(rev));
    sn = __builtin_amdgcn_sinf(fr); cs = __builtin_amdgcn_cosf(fr);
}
DI void phase_postproj(Frame& F, int l) {
    const int tid = F.tid, lane = F.lane, wave = F.wave;
    const bf16_t* proj = (const bf16_t*)(F.ws + WS_PROJ);
    LAS bf16_t* KCl = (LAS bf16_t*)(F.lds);
    LAS bf16_t* AQ = (LAS bf16_t*)(F.lds + 32768);
    LAS bf16_t* AKV = (LAS bf16_t*)(F.lds + 32768 + 33792);
    for (int tile = blockIdx.x; tile < SEQ / 64; tile += F.G) {
        const int t0 = tile * 64;
        {
            const int sub = tid & 7, vslot = tid >> 3;
            for (int it0 = 0; it0 < 24; it0 += 4) {
              bf16x8 raw4[4];
#pragma unroll
              for (int q = 0; q < 4; ++q) { const int v = (it0 + q) * 64 + vslot, tok = v / 24, gq = v % 24, typ = gq >> 2, hh = gq & 3;
                const int cb = (typ == 0 ? PC_FQ : typ == 1 ? PC_FK : typ == 2 ? PC_MQ : typ == 3 ? PC_MK : typ == 4 ? PC_DQ : PC_DK) + 64 * hh + 8 * sub;
                raw4[q] = *(const bf16x8*)(proj + (size_t)(t0 + tok) * NP + cb); }
#pragma unroll
              for (int q = 0; q < 4; ++q) { const int it = it0 + q;
                const int v = it * 64 + vslot, tok = v / 24, gq = v % 24, typ = gq >> 2, hh = gq & 3;
                const bf16x8 raw = raw4[q];
                float x[8]; unpack8(raw, x);
                float ss = 0.f;
#pragma unroll
                for (int i = 0; i < 8; ++i) ss += x[i] * x[i];
                ss += __shfl_xor(ss, 1); ss += __shfl_xor(ss, 2); ss += __shfl_xor(ss, 4);
                const float rstd = 1.0f / sqrtf(ss * (1.0f / 64.0f) + EPS);
                const float* gp = F.in(typ == 0 ? I_FQG : typ == 1 ? I_FKG : typ == 2 ? I_MOQG : typ == 3 ? I_MOKG : typ == 4 ? I_DQG : I_DKG) + l * 64 + 8 * sub;
                const float qs = ((typ & 1) == 0) ? QSCALE64 : 1.0f;
                const f32x4 g0 = *(const f32x4*)gp, g1 = *(const f32x4*)(gp + 4);
                float y[8];
#pragma unroll
                for (int i = 0; i < 4; ++i) { y[i] = x[i] * rstd * g0[i] * qs; y[4 + i] = x[4 + i] * rstd * g1[i] * qs; }
                const u32x4 w = pack8(y);
                const size_t dsto = (typ == 0 ? WS_QB : typ == 1 ? WS_KB : typ == 2 ? WS_QC : typ == 3 ? WS_KC : typ == 4 ? WS_QD : WS_KD);
                *(u32x4*)((bf16_t*)(F.ws + dsto) + ((size_t)hh * SEQ + t0 + tok) * 64 + 8 * sub) = w;
                if (typ == 3) *(LAS u32x4*)(KCl + (hh * 64 + tok) * 64 + 8 * sub) = w;
              }
            }
        }
        __syncthreads();
        if (wave < 4) { float s = 0.f;
            for (int tok = 0; tok < 64; ++tok) s += bf2f(KCl[(wave * 64 + tok) * 64 + lane]);
            ((float*)(F.ws + WS_KSUM))[((size_t)wave * 256 + tile) * 64 + lane] = s; }
        {
            bf16x8 vr[2][8];
#pragma unroll
            for (int rnd = 0; rnd < 2; ++rnd) { const int pi = wave + 8 * rnd, mixer = pi >> 2, hh = pi & 3;
                const bf16_t* rp = proj + (size_t)(t0 + lane) * NP + ((pi < 12) ? (mixer == 0 ? PC_FV : mixer == 1 ? PC_MV : PC_DV) + 64 * hh : PC_FV);
#pragma unroll
                for (int i = 0; i < 8; ++i) vr[rnd][i] = *(const bf16x8*)(rp + 8 * i); }
#pragma unroll
            for (int rnd = 0; rnd < 2; ++rnd) {
                const int pi = wave + 8 * rnd, mixer = pi >> 2, hh = pi & 3;
                LAS bf16_t* vt = (LAS bf16_t*)(F.lds + 32768 + wave * 9216);
                if (pi < 12) {
#pragma unroll
                    for (int i = 0; i < 8; ++i) {
#pragma unroll
                        for (int e = 0; e < 8; ++e) vt[(8 * i + e) * 72 + lane] = (bf16_t)vr[rnd][i][e]; }
                }
                __syncthreads();
                if (pi < 12) {
                    bf16_t* dst = (bf16_t*)(F.ws + (mixer == 0 ? WS_VBT : mixer == 1 ? WS_VCT : WS_VDT)) + (size_t)hh * 64 * SEQ;
#pragma unroll
                    for (int ps = 0; ps < 8; ++ps) { const int d = 8 * ps + (lane >> 3), c = lane & 7;
                        const u32x4 val = *(const LAS u32x4*)(vt + d * 72 + 8 * c);
                        *(u32x4*)(dst + (size_t)d * SEQ + t0 + 8 * c) = val; }
                }
                __syncthreads();
            }
        }
        for (int it = 0; it < 4; ++it) {
            const int tok = it * 16 + wave * 2 + (lane >> 5), sub = lane & 31;
            const bf16x8 raw = *(const bf16x8*)(proj + (size_t)(t0 + tok) * NP + PC_CQ + 8 * sub);
            float x[8]; unpack8(raw, x);
            float ss = 0.f;
#pragma unroll
            for (int i = 0; i < 8; ++i) ss += x[i] * x[i];
            ss += __shfl_xor(ss, 1); ss += __shfl_xor(ss, 2); ss += __shfl_xor(ss, 4); ss += __shfl_xor(ss, 8); ss += __shfl_xor(ss, 16);
            const float rstd = 1.0f / sqrtf(ss * (1.0f / 256.0f) + EPS);
            const float* gp = F.in(I_CQG) + l * 256 + 8 * sub;
            const f32x4 g0 = *(const f32x4*)gp, g1 = *(const f32x4*)(gp + 4);
            float y[8];
#pragma unroll
            for (int i = 0; i < 4; ++i) { y[i] = x[i] * rstd * g0[i]; y[4 + i] = x[4 + i] * rstd * g1[i]; }
            *(LAS u32x4*)(AQ + tok * 264 + 8 * sub) = pack8(y);
        }
        for (int it = 0; it < 2; ++it) {
            const int tok = it * 32 + wave * 4 + (lane >> 4), sub = lane & 15;
            const bf16x8 raw = *(const bf16x8*)(proj + (size_t)(t0 + tok) * NP + PC_CKV + 8 * sub);
            float x[8]; unpack8(raw, x);
            float ss = 0.f;
#pragma unroll
            for (int i = 0; i < 8; ++i) ss += x[i] * x[i];
            ss += __shfl_xor(ss, 1); ss += __shfl_xor(ss, 2); ss += __shfl_xor(ss, 4); ss += __shfl_xor(ss, 8);
            const float rstd = 1.0f / sqrtf(ss * (1.0f / 128.0f) + EPS);
            const float* gp = F.in(I_CKVG) + l * 128 + 8 * sub;
            const f32x4 g0 = *(const f32x4*)gp, g1 = *(const f32x4*)(gp + 4);
            float y[8];
#pragma unroll
            for (int i = 0; i < 4; ++i) { y[i] = x[i] * rstd * g0[i]; y[4 + i] = x[4 + i] * rstd * g1[i]; }
            *(LAS u32x4*)(AKV + tok * 136 + 8 * sub) = pack8(y);
        }
        __syncthreads();
        {
            const int tg = wave & 1, hh = wave >> 1, r32 = lane & 31, hi = lane >> 5, t = t0 + 32 * tg + r32;
            {
                f32x16 acc[3];
#pragma unroll
                for (int i = 0; i < 3; ++i)
#pragma unroll
                    for (int r = 0; r < 16; ++r) acc[i][r] = 0.f;
                const bf16_t* wq = (const bf16_t*)(F.ws + WS_WUQ) + (size_t)l * 384 * 256 + (size_t)(96 * hh + r32) * 256 + 8 * hi;
                const LAS bf16_t* aq = AQ + (32 * tg + r32) * 264 + 8 * hi;
#pragma unroll 8
                for (int ks = 0; ks < 16; ++ks) {
                    const bf16x8 b = *(const LAS bf16x8*)(aq + 16 * ks);
#pragma unroll
                    for (int i = 0; i < 3; ++i) { const bf16x8 a = *(const bf16x8*)(wq + (size_t)i * 32 * 256 + 16 * ks); acc[i] = MFMA32(a, b, acc[i]); }
                }
                float ss = 0.f;
#pragma unroll
                for (int i = 0; i < 3; ++i)
#pragma unroll
                    for (int r = 0; r < 16; ++r) ss += acc[i][r] * acc[i][r];
                ss += __shfl_xor(ss, 32);
                const float rstd = 1.0f / sqrtf(ss * (1.0f / 96.0f) + EPS);
                const float* gq = F.in(I_MQG) + l * 96;
#pragma unroll
                for (int i = 0; i < 3; ++i)
#pragma unroll
                    for (int g4 = 0; g4 < 4; ++g4) { const f32x4 gv = *(const f32x4*)(gq + 32 * i + 8 * g4 + 4 * hi);
#pragma unroll
                        for (int e = 0; e < 4; ++e) acc[i][4 * g4 + e] *= rstd * gv[e]; }
#define ROPE_Q(r) { float sn, cs; rope_cs<((r) & 3) + 8 * ((r) >> 2)>(t, hi, sn, cs); const float x1 = acc[2][r], x2 = acc[2][(r) + 8]; acc[2][r] = x1 * cs - x2 * sn; acc[2][(r) + 8] = x2 * cs + x1 * sn; }
                ROPE_Q(0) ROPE_Q(1) ROPE_Q(2) ROPE_Q(3) ROPE_Q(4) ROPE_Q(5) ROPE_Q(6) ROPE_Q(7)
#undef ROPE_Q
                bf16_t* qd = (bf16_t*)(F.ws + WS_QA) + ((size_t)hh * SEQ + t) * 96 + 4 * hi;
#pragma unroll
                for (int i = 0; i < 3; ++i)
#pragma unroll
                    for (int g4 = 0; g4 < 4; ++g4) { u32x2 w; w.x = pk2(acc[i][4 * g4] * QSCALE96, acc[i][4 * g4 + 1] * QSCALE96); w.y = pk2(acc[i][4 * g4 + 2] * QSCALE96, acc[i][4 * g4 + 3] * QSCALE96);
                        *(u32x2*)(qd + 32 * i + 8 * g4) = w; }
            }
            {
                f32x16 acc[4];
#pragma unroll
                for (int i = 0; i < 4; ++i)
#pragma unroll
                    for (int r = 0; r < 16; ++r) acc[i][r] = 0.f;
                const bf16_t* wkv = (const bf16_t*)(F.ws + WS_WUKV) + (size_t)l * 512 * 128 + (size_t)(128 * hh + r32) * 128 + 8 * hi;
                const LAS bf16_t* akv = AKV + (32 * tg + r32) * 136 + 8 * hi;
#pragma unroll 4
                for (int ks = 0; ks < 8; ++ks) {
                    const bf16x8 b = *(const LAS bf16x8*)(akv + 16 * ks);
#pragma unroll
                    for (int i = 0; i < 4; ++i) { const bf16x8 a = *(const bf16x8*)(wkv + (size_t)i * 32 * 128 + 16 * ks); acc[i] = MFMA32(a, b, acc[i]); }
                }
                float kr[16];
#pragma unroll
                for (int g4 = 0; g4 < 4; ++g4) { const u32x2 w = *(const u32x2*)(proj + (size_t)t * NP + PC_KR + 8 * g4 + 4 * hi);
                    kr[4 * g4 + 0] = bf2f((bf16_t)(w.x & 0xffffu)); kr[4 * g4 + 1] = bf2f((bf16_t)(w.x >> 16)); kr[4 * g4 + 2] = bf2f((bf16_t)(w.y & 0xffffu)); kr[4 * g4 + 3] = bf2f((bf16_t)(w.y >> 16)); }
                float ss = 0.f;
#pragma unroll
                for (int r = 0; r < 16; ++r) ss += acc[0][r] * acc[0][r] + acc[1][r] * acc[1][r] + kr[r] * kr[r];
                ss += __shfl_xor(ss, 32);
                const float rstd = 1.0f / sqrtf(ss * (1.0f / 96.0f) + EPS);
                const float* gk = F.in(I_MKG) + l * 96;
                bf16_t* kd = (bf16_t*)(F.ws + WS_KA) + ((size_t)hh * SEQ + t) * 96 + 4 * hi;
#pragma unroll
                for (int i = 0; i < 2; ++i)
#pragma unroll
                    for (int g4 = 0; g4 < 4; ++g4) { const f32x4 gv = *(const f32x4*)(gk + 32 * i + 8 * g4 + 4 * hi);
                        u32x2 w; w.x = pk2(acc[i][4 * g4] * rstd * gv[0], acc[i][4 * g4 + 1] * rstd * gv[1]); w.y = pk2(acc[i][4 * g4 + 2] * rstd * gv[2], acc[i][4 * g4 + 3] * rstd * gv[3]);
                        *(u32x2*)(kd + 32 * i + 8 * g4) = w; }
#pragma unroll
                for (int g4 = 0; g4 < 4; ++g4) { const f32x4 gv = *(const f32x4*)(gk + 64 + 8 * g4 + 4 * hi);
#pragma unroll
                    for (int e = 0; e < 4; ++e) kr[4 * g4 + e] *= rstd * gv[e]; }
#define ROPE_K(r) { float sn, cs; rope_cs<((r) & 3) + 8 * ((r) >> 2)>(t, hi, sn, cs); const float x1 = kr[r], x2 = kr[(r) + 8]; kr[r] = x1 * cs - x2 * sn; kr[(r) + 8] = x2 * cs + x1 * sn; }
                ROPE_K(0) ROPE_K(1) ROPE_K(2) ROPE_K(3) ROPE_K(4) ROPE_K(5) ROPE_K(6) ROPE_K(7)
#undef ROPE_K
#pragma unroll
                for (int g4 = 0; g4 < 4; ++g4) { u32x2 w; w.x = pk2(kr[4 * g4], kr[4 * g4 + 1]); w.y = pk2(kr[4 * g4 + 2], kr[4 * g4 + 3]); *(u32x2*)(kd + 64 + 8 * g4) = w; }
                bf16_t* vd = (bf16_t*)(F.ws + WS_VAT) + (size_t)hh * 64 * SEQ + t;
#pragma unroll
                for (int i = 2; i < 4; ++i)
#pragma unroll
                    for (int r = 0; r < 16; ++r) vd[(size_t)(32 * (i - 2) + crow(r, hi)) * SEQ] = f2bf(acc[i][r]);
            }
        }
        if (wave < 4) {
            const int hh = wave;
            const float z = bf2f(proj[(size_t)(t0 + lane) * NP + PC_FLOG + hh]) + F.in(I_FBF)[l * 4 + hh];
            float sc = (fminf(z, 0.f) - log1pf(expf(-fabsf(z)))) * LOG2E;
#pragma unroll
            for (int d = 1; d < 64; d <<= 1) { const float o = __shfl_up(sc, d); if (lane >= d) sc += o; }
            ((float*)(F.ws + WS_FLOC))[(size_t)hh * SEQ + t0 + lane] = -sc;
            if (lane == 63) ((float*)(F.ws + WS_FTILE))[hh * 256 + tile] = sc;
        }
        __syncthreads();
    }
}

DI int swap23(int x) { return (x & ~12) | ((x & 4) << 1) | ((x & 8) >> 1); }
struct AttnShared { const LAS float* kmean; const LAS float* fpre; float fox_cut; };
DI void fox_unit(Frame& F, const AttnShared& A, int hh, int qt) {
    int tid_ = threadIdx.x; asm volatile("" : "+v"(tid_));
    const int lane = tid_ & 63, r32 = lane & 31, hi = lane >> 5, t = 32 * qt + r32;
    const float* nfloc = (const float*)(F.ws + WS_FLOC) + (size_t)hh * SEQ;
    const unsigned char* Kbase = (const unsigned char*)((const bf16_t*)(F.ws + WS_KB) + (size_t)hh * SEQ * 64);
    const unsigned char* Vbase = (const unsigned char*)((const bf16_t*)(F.ws + WS_VBT) + (size_t)hh * 64 * SEQ);
    const unsigned kofs = (unsigned)(swap23(r32) * 64 + 8 * hi) * 2u, vofs = (unsigned)(r32 * SEQ + 8 * hi) * 2u, cofs = 32u * (unsigned)hi;
    bf16x8 qf[4];
    { const bf16_t* Qp = (const bf16_t*)(F.ws + WS_QB) + ((size_t)hh * SEQ + t) * 64 + 8 * hi;
#pragma unroll
      for (int ks = 0; ks < 4; ++ks) qf[ks] = *(const bf16x8*)(Qp + 16 * ks); }
    const float Fq = A.fpre[hh * 256 + (t >> 6)] - nfloc[t];
    const float Ffirst = __builtin_bit_cast(float, __builtin_amdgcn_readfirstlane(__builtin_bit_cast(int, A.fpre[hh * 256 + ((32 * qt) >> 6)] - nfloc[32 * qt])));
    float m = 0.f, lsum = 0.f;
    f32x16 o0, o1;
#pragma unroll
    for (int r = 0; r < 16; ++r) { o0[r] = 0.f; o1[r] = 0.f; }
    bf16x8 kfA[4], vfA[4], kfB[4], vfB[4]; f32x16 cfA, cfB; float preA = 0.f, preB = 0.f;
#define FX_LOAD(kf, vf, cf, pre, kt_) do { \
        const GAS unsigned char* kb_ = (const GAS unsigned char*)(Kbase + (size_t)(kt_) * (32 * 64 * 2)); asm volatile("" : "+s"(kb_)); unsigned ko_ = kofs; asm volatile("" : "+v"(ko_)); \
        _Pragma("unroll") for (int ks = 0; ks < 4; ++ks) kf[ks] = *(const GAS bf16x8*)(kb_ + ko_ + 32 * ks); \
        const GAS unsigned char* v0_ = (const GAS unsigned char*)(Vbase + (size_t)(kt_) * 64); asm volatile("" : "+s"(v0_)); \
        const GAS unsigned char* v1_ = (const GAS unsigned char*)(Vbase + (size_t)(kt_) * 64 + (size_t)32 * SEQ * 2); asm volatile("" : "+s"(v1_)); unsigned vo_ = vofs; asm volatile("" : "+v"(vo_)); \
        vf[0] = *(const GAS bf16x8*)(v0_ + vo_); vf[1] = *(const GAS bf16x8*)(v0_ + vo_ + 32); vf[2] = *(const GAS bf16x8*)(v1_ + vo_); vf[3] = *(const GAS bf16x8*)(v1_ + vo_ + 32); \
        const GAS unsigned char* c_ = (const GAS unsigned char*)(nfloc + 32 * (kt_)); asm volatile("" : "+s"(c_)); unsigned co_ = cofs; asm volatile("" : "+v"(co_)); \
        { const f32x4 f0 = *(const GAS f32x4*)(c_ + co_), f1 = *(const GAS f32x4*)(c_ + co_ + 16), f2 = *(const GAS f32x4*)(c_ + co_ + 64), f3 = *(const GAS f32x4*)(c_ + co_ + 80); \
          _Pragma("unroll") for (int e = 0; e < 4; ++e) { cf[e] = f0[e]; cf[4 + e] = f1[e]; cf[8 + e] = f2[e]; cf[12 + e] = f3[e]; } } \
        pre = A.fpre[hh * 256 + ((kt_) >> 1)]; } while (0)
#define FX_NEXT(cf, pre, kt_) ({ int nk_ = (kt_) - 1; if (nk_ >= 0) { const float ff_ = __builtin_bit_cast(float, __builtin_amdgcn_readfirstlane(__builtin_bit_cast(int, pre - cf[0]))); \
        if (Ffirst - ff_ < -A.fox_cut) nk_ = -1; } nk_; })
    auto compute = [&](const bf16x8 (&kf)[4], const bf16x8 (&vf)[4], const f32x16& cf, const float pre, auto diagc) __attribute__((always_inline)) {
        f32x16 s = MFMA32(kf[0], qf[0], cf);
#pragma unroll
        for (int ks = 1; ks < 4; ++ks) s = MFMA32(kf[ks], qf[ks], s);
        if constexpr (decltype(diagc)::value) {
            const int d0 = r32 - 8 * hi;
#pragma unroll
            for (int i = 0; i < 16; ++i) if (d0 - (16 * (i >> 3) + (i & 7)) < 0) s[i] = -INFINITY;
        }
        float mj = m - (Fq - pre);
        float rm = fmaxf(s[0], s[1]);
#pragma unroll
        for (int i = 2; i < 16; ++i) rm = fmaxf(rm, s[i]);
        rm = max_x32(rm) - mj;
        if (__any(rm > 8.0f)) {
            const float dl = fmaxf(rm, 0.f), alpha = __builtin_amdgcn_exp2f(-dl);
            m += dl; mj += dl; lsum *= alpha;
#pragma unroll
            for (int r = 0; r < 16; ++r) { o0[r] *= alpha; o1[r] *= alpha; }
        }
        float p[16], psum = 0.f;
#pragma unroll
        for (int i = 0; i < 16; ++i) { p[i] = __builtin_amdgcn_exp2f(s[i] - mj); psum += p[i]; }
        lsum += psum;
        u32x4 w0, w1;
        w0.x = pk2(p[0], p[1]); w0.y = pk2(p[2], p[3]); w0.z = pk2(p[4], p[5]); w0.w = pk2(p[6], p[7]);
        w1.x = pk2(p[8], p[9]); w1.y = pk2(p[10], p[11]); w1.z = pk2(p[12], p[13]); w1.w = pk2(p[14], p[15]);
        const bf16x8 pf0 = __builtin_bit_cast(bf16x8, w0), pf1 = __builtin_bit_cast(bf16x8, w1);
        o0 = MFMA32(vf[0], pf0, o0); o0 = MFMA32(vf[1], pf1, o0);
        o1 = MFMA32(vf[2], pf0, o1); o1 = MFMA32(vf[3], pf1, o1);
    };
    int kt = qt;
    FX_LOAD(kfA, vfA, cfA, preA, kt);
    {   int nk = FX_NEXT(cfA, preA, kt);
        if (nk >= 0) FX_LOAD(kfB, vfB, cfB, preB, nk);
        compute(kfA, vfA, cfA, preA, std::true_type{});
        kt = nk; }
    while (kt >= 0) {
        int nk = FX_NEXT(cfB, preB, kt);
        if (nk >= 0) FX_LOAD(kfA, vfA, cfA, preA, nk);
        compute(kfB, vfB, cfB, preB, std::false_type{});
        kt = nk; if (kt < 0) break;
        nk = FX_NEXT(cfA, preA, kt);
        if (nk >= 0) FX_LOAD(kfB, vfB, cfB, preB, nk);
        compute(kfA, vfA, cfA, preA, std::false_type{});
        kt = nk;
    }
#undef FX_LOAD
#undef FX_NEXT
    const float ltot = sum_x32(lsum), inv = 1.0f / ltot;
    bf16_t* od = (bf16_t*)(F.ws + WS_O) + (size_t)t * DM + (4 + hh) * 64 + 4 * hi;
#pragma unroll
    for (int g4 = 0; g4 < 4; ++g4) {
        u32x2 w; w.x = pk2(o0[4 * g4] * inv, o0[4 * g4 + 1] * inv); w.y = pk2(o0[4 * g4 + 2] * inv, o0[4 * g4 + 3] * inv); *(u32x2*)(od + 8 * g4) = w;
        u32x2 z; z.x = pk2(o1[4 * g4] * inv, o1[4 * g4 + 1] * inv); z.y = pk2(o1[4 * g4 + 2] * inv, o1[4 * g4 + 3] * inv); *(u32x2*)(od + 32 + 8 * g4) = z;
    }
}

constexpr int BG_ITEMS = 32 * 32 * 64 + 32 * 32 * 32;
constexpr int ATT_BGSCR_OFF = 98816;
static_assert(UP_FP8 && MOE_FP8, "the background engine writes fp8");
struct BgConv {
    int it, stride, l, itp;
    DI void init(int gw, int ngw, int layer) { it = gw; stride = ngw; l = layer; itp = -1; }
    DI void finish(Frame& F, int wave, int lane) {
        const int id = itp; if (id < 0) return;
        unsigned char* dst; int K;
        if (id < 65536) { const int e = id >> 11, q = id & 2047, kb = q >> 6, nb = q & 63; dst = F.ws + WS_WE1 + (((size_t)l * NEXP + e) * 2048 * DM + (size_t)(32 * nb) * DM + 32 * kb); K = DM; }
        else { const int r = id - 65536, e = r >> 10, q = r & 1023, kb = q >> 5, nb = q & 31; dst = F.ws + WS_WE2 + (((size_t)l * NEXP + e) * DM * FEXP + (size_t)(32 * nb) * FEXP + 32 * kb); K = FEXP; }
        const LAS float* sp = (const LAS float*)(F.lds + ATT_BGSCR_OFF + wave * 4096) + (lane >> 5) * 512 + (lane & 31);
        float v[16];
#pragma unroll
        for (int i = 0; i < 16; ++i) v[i] = sp[32 * i];
        u32x4 o; o.x = pk4_fp8(v[0] * WSCALE, v[1] * WSCALE, v[2] * WSCALE, v[3] * WSCALE); o.y = pk4_fp8(v[4] * WSCALE, v[5] * WSCALE, v[6] * WSCALE, v[7] * WSCALE);
        o.z = pk4_fp8(v[8] * WSCALE, v[9] * WSCALE, v[10] * WSCALE, v[11] * WSCALE); o.w = pk4_fp8(v[12] * WSCALE, v[13] * WSCALE, v[14] * WSCALE, v[15] * WSCALE);
        *(u32x4*)(dst + (size_t)(lane & 31) * K + 16 * (lane >> 5)) = o;
        itp = -1;
    }
    template <bool UNCOND> DI void request(Frame& F, int wave, int lane) {
        if (it >= BG_ITEMS) {
            if (UNCOND) { const GAS unsigned char* rb = (const GAS unsigned char*)F.in(I_EW1); LAS unsigned char* scr = F.lds + ATT_BGSCR_OFF + wave * 4096;
#pragma unroll
                for (int i = 0; i < 4; ++i) { asm volatile("" : "+s"(rb)); __builtin_amdgcn_global_load_lds((const GAS unsigned*)rb, (LAS unsigned*)(scr + 1024 * i), 16, 0, 0); } }
            return;
        }
        const float* W; int Nsrc, k0, n0; bool m2;
        if (it < 65536) { const int e = it >> 11, q = it & 2047, kb = q >> 6, nb = q & 63; W = F.in(I_EW1) + ((size_t)l * NEXP + e) * DM * 2048; Nsrc = 2048; k0 = 32 * kb; n0 = 32 * nb; m2 = true; }
        else { const int r = it - 65536, e = r >> 10, q = r & 1023, kb = q >> 5, nb = q & 31; W = F.in(I_EW2) + ((size_t)l * NEXP + e) * FEXP * DM; Nsrc = DM; k0 = 32 * kb; n0 = 32 * nb; m2 = false; }
        const int ns = m2 ? map_w1(n0) : n0;
        const unsigned char* rowb = (const unsigned char*)(W + (size_t)k0 * Nsrc + ns);
        const unsigned boff = (unsigned)((lane >> 3) * Nsrc + 4 * (lane & 7)) * 4u;
        LAS unsigned char* scr = F.lds + ATT_BGSCR_OFF + wave * 4096;
#pragma unroll
        for (int i = 0; i < 4; ++i) { const GAS unsigned char* rb = (const GAS unsigned char*)(rowb + (size_t)(32 * i) * Nsrc); asm volatile("" : "+s"(rb));
            __builtin_amdgcn_global_load_lds((const GAS unsigned*)(rb + boff), (LAS unsigned*)(scr + 1024 * i), 16, 0, 0); }
        itp = it; it += stride;
    }
    DI void drain(Frame& F, int wave, int lane) { asm volatile("s_waitcnt vmcnt(0)" ::: "memory"); finish(F, wave, lane); }
    DI void rest(Frame& F, int wave, int lane) {
        while (it < BG_ITEMS) { request<false>(F, wave, lane); asm volatile("s_waitcnt vmcnt(0)" ::: "memory"); finish(F, wave, lane); asm volatile("s_waitcnt lgkmcnt(0)" ::: "memory"); }
    }
};
constexpr int ATT_BUF_BYTES = 88064;
constexpr int ATT_FPRE_OFF = 90112, ATT_SELM_OFF = 94208, ATT_MISC_OFF = 96256;
#ifndef MLA_BG
#define MLA_BG 1
#endif
#ifndef MLA_SGB
#define MLA_SGB 1
#endif
#ifndef MLA_PRIO
#define MLA_PRIO 0
#endif
#ifndef MLA_TR
#define MLA_TR 3
#define MLA_VA 4
#endif
template <int VAR = 0> DI void mla_wg_unit(Frame& F, int hh, int qb, BgConv& bg) {
    constexpr int DQ = 96, NKS = DQ / 16, KCH = DQ / 8, KSTR = DQ + 8, VSTR = 136;
    constexpr int KBYTES = 128 * KSTR * 2, VBYTES = 64 * VSTR * 2, BUF = KBYTES + VBYTES, KPC = 128 * KCH / NTHREADS;
    static_assert(2 * BUF <= ATT_BUF_BYTES, "attention LDS map");
    static_assert(DQ * 2 == KCH * 16, "K rows are contiguous");
#define ML_BAR do { asm volatile("s_waitcnt lgkmcnt(0)" ::: "memory"); __builtin_amdgcn_s_barrier(); asm volatile("" ::: "memory"); } while (0)
    int tid_ = threadIdx.x; asm volatile("" : "+v"(tid_));
    const int tid = tid_, lane = tid & 63, wave = __builtin_amdgcn_readfirstlane(tid >> 6), r32 = lane & 31, hi = lane >> 5, qg = wave & 3, kh = wave >> 2;
    const int t = 128 * qb + 32 * qg + r32;
    const bf16_t* Kg = (const bf16_t*)(F.ws + WS_KA) + (size_t)hh * SEQ * DQ;
    const bf16_t* Vg = (const bf16_t*)(F.ws + WS_VAT) + (size_t)hh * 64 * SEQ;
    bf16x8 qf[NKS];
    { const bf16_t* Qp = (const bf16_t*)(F.ws + WS_QA) + ((size_t)hh * SEQ + t) * DQ + 8 * hi;
#pragma unroll
      for (int ks = 0; ks < NKS; ++ks) qf[ks] = *(const bf16x8*)(Qp + 16 * ks);
#pragma unroll
      for (int ks = 0; ks < NKS; ++ks) asm volatile("" :: "v"(qf[ks])); }
    float m = 0.f, lsum = 0.f;
    f32x16 o0, o1;
#pragma unroll
    for (int r = 0; r < 16; ++r) { o0[r] = 0.f; o1[r] = 0.f; }
    const int n = qb + 1;
    u32x4 sk[KPC], sv[2];
    const unsigned gk0 = (unsigned)((tid >> 2) * (DQ * 2) + (tid & 3) * 16), lk0 = (unsigned)((tid >> 2) * (KSTR * 2) + (tid & 3) * 16);
    const unsigned gv0 = (unsigned)((tid >> 4) * SEQ + 8 * (tid & 15)) * 2u, lv0 = (unsigned)(KBYTES + ((tid >> 4) * VSTR + 8 * (tid & 15)) * 2);
    static_assert(KPC == 3, "three K chunks per thread");
#define ML_LOADK(dst_, T_) do { const GAS unsigned char* kb_ = (const GAS unsigned char*)(Kg + (size_t)(128 * (T_)) * DQ); asm volatile("" : "+s"(kb_)); unsigned o_ = gk0; asm volatile("" : "+v"(o_)); \
            _Pragma("unroll") for (int j = 0; j < KPC; ++j) dst_[j] = *(const GAS u32x4*)(kb_ + o_ + 64 * j); } while (0)
#define ML_LOADV(T_) do { _Pragma("unroll") for (int j = 0; j < 2; ++j) { const GAS unsigned char* vb_ = (const GAS unsigned char*)(Vg + 128 * (T_) + (size_t)(32 * j) * SEQ); asm volatile("" : "+s"(vb_)); \
            unsigned o_ = gv0; asm volatile("" : "+v"(o_)); sv[j] = *(const GAS u32x4*)(vb_ + o_); } } while (0)
#define ML_STOREK(src_, b_) do { const unsigned a_ = (unsigned)(size_t)(F.lds + (b_) * BUF) + lk0; _Pragma("unroll") for (int j = 0; j < KPC; ++j) asm volatile("ds_write_b128 %0, %1 offset:%2" :: "v"(a_), "v"(src_[j]), "n"(64 * j) : "memory"); } while (0)
#define ML_STOREV(b_) do { const unsigned a_ = (unsigned)(size_t)(F.lds + (b_) * BUF) + lv0; _Pragma("unroll") for (int j = 0; j < 2; ++j) asm volatile("ds_write_b128 %0, %1 offset:%2" :: "v"(a_), "v"(sv[j]), "n"(32 * j * VSTR * 2) : "memory"); } while (0)
    { u32x4 sk1[KPC];
      ML_LOADK(sk, 0); ML_LOADV(0); if (n > 1) ML_LOADK(sk1, 1);
      ML_STOREK(sk, 0); ML_STOREV(0); if (n > 1) ML_STOREK(sk1, 1); }
    if (n > 2) ML_LOADK(sk, 2);
    if (n > 1) ML_LOADV(1);
    ML_BAR;
    auto qk = [&](const int b, f32x16& s0, f32x16& s1) __attribute__((always_inline)) {
        const LAS bf16_t* kp = (const LAS bf16_t*)(F.lds + b * BUF) + (64 * kh + swap23(r32)) * KSTR + 8 * hi;
        bf16x8 kf0[NKS], kf1[NKS];
#pragma unroll
        for (int ks = 0; ks < NKS; ++ks) { kf0[ks] = *(const LAS bf16x8*)(kp + 16 * ks); kf1[ks] = *(const LAS bf16x8*)(kp + 32 * KSTR + 16 * ks); }
        f32x16 zz;
#pragma unroll
        for (int r = 0; r < 16; ++r) zz[r] = 0.f;
        s0 = MFMA32(kf0[0], qf[0], zz); s1 = MFMA32(kf1[0], qf[0], zz);
#pragma unroll
        for (int ks = 1; ks < NKS; ++ks) { s0 = MFMA32(kf0[ks], qf[ks], s0); s1 = MFMA32(kf1[ks], qf[ks], s1); }
    };
    auto step = [&](const int i, f32x16& c0, f32x16& c1, f32x16& n0, f32x16& n1, auto hasnextc, auto lastc, auto bgc) __attribute__((always_inline)) {
        constexpr bool HASNEXT = decltype(hasnextc)::value, LAST = decltype(lastc)::value; constexpr int BGM = (BG_CONVERT && VAR == 0 && MLA_BG) ? decltype(bgc)::value : 0;
        if (i + 2 < n) ML_STOREK(sk, i & 1);
        if (i + 1 < n) ML_STOREV((i + 1) & 1);
        if (i + 3 < n) ML_LOADK(sk, (VAR == 5 ? 0 : i + 3));
        if (i + 2 < n) ML_LOADV((VAR == 5 ? 0 : i + 2));
        if constexpr (BGM == 1) bg.template request<true>(F, wave, lane);
        const LAS bf16_t* kp = (const LAS bf16_t*)(F.lds + ((i + 1) & 1) * BUF) + (64 * kh + swap23(r32)) * KSTR + 8 * hi;
        bf16x8 kf[2 * NKS];
        if constexpr (HASNEXT) { kf[0] = *(const LAS bf16x8*)(kp); kf[1] = *(const LAS bf16x8*)(kp + 32 * KSTR); kf[2] = *(const LAS bf16x8*)(kp + 16); }
        if constexpr (LAST) {
            const int d0 = t - (128 * qb + 64 * kh + 8 * hi);
#pragma unroll
            for (int r = 0; r < 16; ++r) { const int dd = d0 - (16 * (r >> 3) + (r & 7)); if (dd < 0) c0[r] = -INFINITY; if (dd - 32 < 0) c1[r] = -INFINITY; }
        }
        if (!__all(m == 0.f)) {
#pragma unroll
            for (int r = 0; r < 16; ++r) { c0[r] -= m; c1[r] -= m; }
        }
        float rm = fmaxf(c0[0], c1[0]);
#pragma unroll
        for (int r = 1; r < 16; ++r) rm = fmaxf(fmaxf(rm, c0[r]), c1[r]);
        rm = max_x32(rm);
        if (__any(rm > 8.0f)) {
            const float dl = fmaxf(rm, 0.f), alpha = __builtin_amdgcn_exp2f(-dl);
            m += dl; lsum *= alpha;
#pragma unroll
            for (int r = 0; r < 16; ++r) { c0[r] -= dl; c1[r] -= dl; o0[r] *= alpha; o1[r] *= alpha; }
        }
        if constexpr (HASNEXT) {
            kf[3] = *(const LAS bf16x8*)(kp + 32 * KSTR + 16);
#pragma unroll
            for (int ks = 2; ks < NKS; ++ks) { kf[2 * ks] = *(const LAS bf16x8*)(kp + 16 * ks); kf[2 * ks + 1] = *(const LAS bf16x8*)(kp + 32 * KSTR + 16 * ks); }
            f32x16 zz;
#pragma unroll
            for (int r = 0; r < 16; ++r) zz[r] = 0.f;
            n0 = MFMA32(kf[0], qf[0], zz); n1 = MFMA32(kf[1], qf[0], zz);
#pragma unroll
            for (int ks = 1; ks < NKS; ++ks) { n0 = MFMA32(kf[2 * ks], qf[ks], n0); n1 = MFMA32(kf[2 * ks + 1], qf[ks], n1); }
        }
        float psum = 0.f;
#pragma unroll
        for (int r = 0; r < 16; ++r) { c0[r] = __builtin_amdgcn_exp2f(c0[r]); psum += c0[r]; }
#pragma unroll
        for (int r = 0; r < 16; ++r) { c1[r] = __builtin_amdgcn_exp2f(c1[r]); psum += c1[r]; }
        lsum += psum;
        u32x4 w0, w1, w2, w3;
        w0.x = pk2(c0[0], c0[1]); w0.y = pk2(c0[2], c0[3]); w0.z = pk2(c0[4], c0[5]); w0.w = pk2(c0[6], c0[7]);
        w1.x = pk2(c0[8], c0[9]); w1.y = pk2(c0[10], c0[11]); w1.z = pk2(c0[12], c0[13]); w1.w = pk2(c0[14], c0[15]);
        w2.x = pk2(c1[0], c1[1]); w2.y = pk2(c1[2], c1[3]); w2.z = pk2(c1[4], c1[5]); w2.w = pk2(c1[6], c1[7]);
        w3.x = pk2(c1[8], c1[9]); w3.y = pk2(c1[10], c1[11]); w3.z = pk2(c1[12], c1[13]); w3.w = pk2(c1[14], c1[15]);
        const bf16x8 pf0 = __builtin_bit_cast(bf16x8, w0), pf1 = __builtin_bit_cast(bf16x8, w1), pf2 = __builtin_bit_cast(bf16x8, w2), pf3 = __builtin_bit_cast(bf16x8, w3);
        const LAS bf16_t* vp = (const LAS bf16_t*)(F.lds + (i & 1) * BUF + KBYTES) + r32 * VSTR + 64 * kh + 8 * hi;
        bf16x8 vf0[4], vf1[4];
        vf0[0] = *(const LAS bf16x8*)(vp); vf0[2] = *(const LAS bf16x8*)(vp + 32 * VSTR); vf0[1] = *(const LAS bf16x8*)(vp + 16); vf0[3] = *(const LAS bf16x8*)(vp + 32 * VSTR + 16);
        vf1[0] = *(const LAS bf16x8*)(vp + 32); vf1[2] = *(const LAS bf16x8*)(vp + 32 * VSTR + 32); vf1[1] = *(const LAS bf16x8*)(vp + 48); vf1[3] = *(const LAS bf16x8*)(vp + 32 * VSTR + 48);
        o0 = MFMA32(vf0[0], pf0, o0); o1 = MFMA32(vf0[2], pf0, o1);
        o0 = MFMA32(vf0[1], pf1, o0); o1 = MFMA32(vf0[3], pf1, o1);
        o0 = MFMA32(vf1[0], pf2, o0); o1 = MFMA32(vf1[2], pf2, o1);
        o0 = MFMA32(vf1[1], pf3, o0); o1 = MFMA32(vf1[3], pf3, o1);
#if MLA_SGB
        if constexpr (HASNEXT) {
#pragma unroll
            for (int k = 0; k < 12; ++k) { __builtin_amdgcn_sched_group_barrier(0x008, 1, 0); __builtin_amdgcn_sched_group_barrier(0x100, 1, 0);
                __builtin_amdgcn_sched_group_barrier(0x400, MLA_TR, 0); __builtin_amdgcn_sched_group_barrier(0x002, MLA_VA, 0); }
            __builtin_amdgcn_sched_group_barrier(0x400, 8, 0); __builtin_amdgcn_sched_group_barrier(0x002, 16, 0);
#pragma unroll
            for (int k = 0; k < 8; ++k) { __builtin_amdgcn_sched_group_barrier(0x008, 1, 0); __builtin_amdgcn_sched_group_barrier(0x100, 1, 0); }
        }
#endif
        if constexpr (BGM == 2) { asm volatile("s_waitcnt vmcnt(0)" ::: "memory"); bg.finish(F, wave, lane); }
        ML_BAR;
    };
    if (BG_CONVERT && VAR == 0 && MLA_BG) { if (bg.itp >= 0) bg.drain(F, wave, lane); }
#if MLA_PRIO
    if (kh == 1) __builtin_amdgcn_s_setprio(1);
#endif
    f32x16 sA0, sA1, sB0, sB1;
    qk(0, sA0, sA1);
    ML_BAR;
    {   const std::true_type Y{}; const std::false_type N{}; const std::integral_constant<int, 0> B0{}; const std::integral_constant<int, 1> B1{}; const std::integral_constant<int, 2> B2{};
        int i = 0;
        for (; i + 2 < n; i += 2) { step(i, sA0, sA1, sB0, sB1, Y, N, B1); step(i + 1, sB0, sB1, sA0, sA1, Y, N, B2); }
        if (n - i == 2) { step(i, sA0, sA1, sB0, sB1, Y, N, B1); step(i + 1, sB0, sB1, sA0, sA1, N, Y, B2); }
        else step(i, sA0, sA1, sB0, sB1, N, Y, B0);
    }
#if MLA_PRIO
    __builtin_amdgcn_s_setprio(0);
#endif
#undef ML_LOADK
#undef ML_LOADV
#undef ML_STOREK
#undef ML_STOREV
#undef ML_BAR
    const float ltot = sum_x32(lsum);
    LAS float* mg = (LAS float*)F.lds + qg * (34 * 64) + lane;
    if (kh == 1) {
        mg[0] = m; mg[64] = ltot;
#pragma unroll
        for (int r = 0; r < 16; ++r) { mg[(2 + r) * 64] = o0[r]; mg[(18 + r) * 64] = o1[r]; }
    }
    __syncthreads();
    if (kh == 0) {
        const float m1 = mg[0], l1 = mg[64];
        const float M = fmaxf(m, m1), a0 = __builtin_amdgcn_exp2f(m - M), a1 = __builtin_amdgcn_exp2f(m1 - M);
        const float inv = 1.0f / (ltot * a0 + l1 * a1), c0 = a0 * inv, c1 = a1 * inv;
#pragma unroll
        for (int r = 0; r < 16; ++r) { o0[r] = o0[r] * c0 + mg[(2 + r) * 64] * c1; o1[r] = o1[r] * c0 + mg[(18 + r) * 64] * c1; }
        if (VAR != 0) { asm volatile("" :: "v"(o0), "v"(o1)); }
        else {
        bf16_t* od = (bf16_t*)(F.ws + WS_O) + (size_t)t * DM + hh * 64 + 4 * hi;
#pragma unroll
        for (int g4 = 0; g4 < 4; ++g4) {
            u32x2 w; w.x = pk2(o0[4 * g4], o0[4 * g4 + 1]); w.y = pk2(o0[4 * g4 + 2], o0[4 * g4 + 3]); *(u32x2*)(od + 8 * g4) = w;
            u32x2 z; z.x = pk2(o1[4 * g4], o1[4 * g4 + 1]); z.y = pk2(o1[4 * g4 + 2], o1[4 * g4 + 3]); *(u32x2*)(od + 32 + 8 * g4) = z;
        }
        }
    }
    __syncthreads();
}
struct DilUnit { int hh, p, c, ib; };
DI DilUnit dil_decode(int uid) { DilUnit u; u.hh = uid / 384; const int rem = uid % 384; u.p = rem >> 7; const int blk = rem & 127, bpc = 128 >> (2 * u.p); u.c = blk / bpc; u.ib = blk % bpc; return u; }
struct DilPre { u32x4 sk[2], sv[2], sk2[2], sv2[2]; bf16x8 qf[4]; };
DI void dil_preload(Frame& F, const DilUnit& u, DilPre& P) {
    int tid_ = threadIdx.x; asm volatile("" : "+v"(tid_));
    const int tid = tid_, lane = tid & 63, wave = __builtin_amdgcn_readfirstlane(tid >> 6), r32 = lane & 31, hi = lane >> 5, qg = wave & 3;
    const int rs = 2 * u.p;
    const bf16_t* Kg = (const bf16_t*)(F.ws + WS_KD) + (size_t)u.hh * SEQ * 64;
    const bf16_t* Vg = (const bf16_t*)(F.ws + WS_PROJ) + PC_DV + 64 * u.hh;
#pragma unroll
    for (int i = 0; i < 2; ++i) { const int pp = tid + NTHREADS * i, key = pp >> 3, ch = pp & 7; const size_t tok = ((size_t)(128 * u.ib + key) << rs) + u.c;
        P.sk[i] = *(const u32x4*)(Kg + tok * 64 + 8 * ch); P.sv[i] = *(const u32x4*)(Vg + tok * NP + 8 * ch); }
    if (u.ib > 0) {
#pragma unroll
        for (int i = 0; i < 2; ++i) { const int pp = tid + NTHREADS * i, key = pp >> 3, ch = pp & 7; const size_t tok = ((size_t)(128 * (u.ib - 1) + key) << rs) + u.c;
            P.sk2[i] = *(const u32x4*)(Kg + tok * 64 + 8 * ch); P.sv2[i] = *(const u32x4*)(Vg + tok * NP + 8 * ch); }
    }
    const int t = ((128 * u.ib + 32 * qg + r32) << rs) + u.c;
    const bf16_t* Qp = (const bf16_t*)(F.ws + WS_QD) + ((size_t)u.hh * SEQ + t) * 64 + 8 * hi;
#pragma unroll
    for (int ks = 0; ks < 4; ++ks) P.qf[ks] = *(const bf16x8*)(Qp + 16 * ks);
}
DI void dil_wg_unit(Frame& F, const DilUnit& U, DilPre& P, bool has_next, const DilUnit& N) {
    constexpr int KSTR = 72, VSTR = 136, KBYTES = 128 * KSTR * 2, VBYTES = 64 * VSTR * 2, BUF = KBYTES + VBYTES;
    const int hh = U.hh, p = U.p, c = U.c, ib = U.ib;
    int tid_ = threadIdx.x; asm volatile("" : "+v"(tid_));
    const int tid = tid_, lane = tid & 63, wave = __builtin_amdgcn_readfirstlane(tid >> 6), r32 = lane & 31, hi = lane >> 5, qg = wave & 3, kh = wave >> 2;
    const int rs = 2 * p, r = 1 << rs;
    const int iq = 128 * ib + 32 * qg + r32, t = (iq << rs) + c;
    const bf16_t* Kg = (const bf16_t*)(F.ws + WS_KD) + (size_t)hh * SEQ * 64;
    const bf16_t* Vg = (const bf16_t*)(F.ws + WS_PROJ) + PC_DV + 64 * hh;
    bf16x8 qf[4];
#pragma unroll
    for (int ks = 0; ks < 4; ++ks) { qf[ks] = P.qf[ks]; asm volatile("" :: "v"(qf[ks])); }
    float m = 0.f, lsum = 0.f;
    f32x16 o0, o1;
#pragma unroll
    for (int q = 0; q < 16; ++q) { o0[q] = 0.f; o1[q] = 0.f; }
    const float slope2 = exp2f(-(float)(2 * hh + 1)) * LOG2E * (float)r;
    f32x16 cb;
#pragma unroll
    for (int q = 0; q < 16; ++q) cb[q] = slope2 * (float)(16 * (q >> 3) + (q & 7) + 8 * hi);
    u32x4 sk[2], sv[2];
#define DL_STORE(b_) do { LAS unsigned char* kb_ = F.lds + (b_) * BUF; _Pragma("unroll") for (int i = 0; i < 2; ++i) { const int pp = tid + NTHREADS * i, key = pp >> 3, ch = pp & 7; \
        *(LAS u32x4*)(kb_ + (key * KSTR + 8 * ch) * 2) = sk[i]; LAS bf16_t* vb_ = (LAS bf16_t*)(kb_ + KBYTES) + (8 * ch) * VSTR + key; \
        vb_[0 * VSTR] = (bf16_t)(sv[i].x & 0xffffu); vb_[1 * VSTR] = (bf16_t)(sv[i].x >> 16); vb_[2 * VSTR] = (bf16_t)(sv[i].y & 0xffffu); vb_[3 * VSTR] = (bf16_t)(sv[i].y >> 16); \
        vb_[4 * VSTR] = (bf16_t)(sv[i].z & 0xffffu); vb_[5 * VSTR] = (bf16_t)(sv[i].z >> 16); vb_[6 * VSTR] = (bf16_t)(sv[i].w & 0xffffu); vb_[7 * VSTR] = (bf16_t)(sv[i].w >> 16); } } while (0)
#pragma unroll
    for (int i = 0; i < 2; ++i) { sk[i] = P.sk[i]; sv[i] = P.sv[i]; }
    DL_STORE(0);
    if (ib > 0) {
#pragma unroll
        for (int i = 0; i < 2; ++i) { sk[i] = P.sk2[i]; sv[i] = P.sv2[i]; }
        DL_STORE(1);
    }
    __syncthreads();
    const int nt = ib > 0 ? 2 : 1;
    for (int ti = 0; ti < nt; ++ti) {
        const int T = ib - ti;
        if (ti == nt - 1 && has_next) dil_preload(F, N, P);
        const LAS bf16_t* Kb = (const LAS bf16_t*)(F.lds + ti * BUF);
        const LAS bf16_t* Vb = (const LAS bf16_t*)(F.lds + ti * BUF + KBYTES);
#pragma unroll
        for (int jj = 0; jj < 2; ++jj) {
            const int j = 1 - jj, sidx = 2 * kh + j;
            if (T == ib && sidx > qg) continue;
            if (T < ib && sidx < qg) continue;
            const LAS bf16_t* kp = Kb + (64 * kh + 32 * j + swap23(r32)) * KSTR + 8 * hi;
            const LAS bf16_t* vp = Vb + r32 * VSTR + 64 * kh + 32 * j + 8 * hi;
            bf16x8 kf[4], vf[4];
#pragma unroll
            for (int ks = 0; ks < 4; ++ks) kf[ks] = *(const LAS bf16x8*)(kp + 16 * ks);
            vf[0] = *(const LAS bf16x8*)(vp); vf[1] = *(const LAS bf16x8*)(vp + 16); vf[2] = *(const LAS bf16x8*)(vp + 32 * VSTR); vf[3] = *(const LAS bf16x8*)(vp + 32 * VSTR + 16);
            f32x16 s = MFMA32(kf[0], qf[0], cb);
#pragma unroll
            for (int ks = 1; ks < 4; ++ks) s = MFMA32(kf[ks], qf[ks], s);
            const int D = iq - (128 * T + 64 * kh + 32 * j);
            if (sidx == qg) {
                const int d0 = D - 8 * hi;
#pragma unroll
                for (int i = 0; i < 16; ++i) { const int dl = d0 - (16 * (i >> 3) + (i & 7)); if (dl < 0 || dl > 128) s[i] = -INFINITY; }
            }
            float mj = m + slope2 * (float)D;
            float rm = fmaxf(s[0], s[1]);
#pragma unroll
            for (int i = 2; i < 16; ++i) rm = fmaxf(rm, s[i]);
            rm = max_x32(rm) - mj;
            if (__any(rm > 8.0f)) {
                const float dl = fmaxf(rm, 0.f), alpha = __builtin_amdgcn_exp2f(-dl);
                m += dl; mj += dl; lsum *= alpha;
#pragma unroll
                for (int q = 0; q < 16; ++q) { o0[q] *= alpha; o1[q] *= alpha; }
            }
            float pr[16], psum = 0.f;
#pragma unroll
            for (int i = 0; i < 16; ++i) { pr[i] = __builtin_amdgcn_exp2f(s[i] - mj); psum += pr[i]; }
            lsum += psum;
            u32x4 w0, w1;
            w0.x = pk2(pr[0], pr[1]); w0.y = pk2(pr[2], pr[3]); w0.z = pk2(pr[4], pr[5]); w0.w = pk2(pr[6], pr[7]);
            w1.x = pk2(pr[8], pr[9]); w1.y = pk2(pr[10], pr[11]); w1.z = pk2(pr[12], pr[13]); w1.w = pk2(pr[14], pr[15]);
            const bf16x8 pf0 = __builtin_bit_cast(bf16x8, w0), pf1 = __builtin_bit_cast(bf16x8, w1);
            o0 = MFMA32(vf[0], pf0, o0); o0 = MFMA32(vf[1], pf1, o0);
            o1 = MFMA32(vf[2], pf0, o1); o1 = MFMA32(vf[3], pf1, o1);
        }
    }
    __syncthreads();
#undef DL_STORE
    const float ltot = sum_x32(lsum);
    LAS float* mg = (LAS float*)F.lds + qg * (34 * 64) + lane;
    if (kh == 1) {
        mg[0] = m; mg[64] = ltot;
#pragma unroll
        for (int q = 0; q < 16; ++q) { mg[(2 + q) * 64] = o0[q]; mg[(18 + q) * 64] = o1[q]; }
    }
    __syncthreads();
    if (kh == 0) {
        const float m1 = mg[0], l1 = mg[64];
        const float M = fmaxf(m, m1), a0 = __builtin_amdgcn_exp2f(m - M), a1 = __builtin_amdgcn_exp2f(m1 - M);
        const float L = ltot * a0 + l1 * a1, inv = 1.0f / L, c0 = a0 * inv, c1 = a1 * inv;
#pragma unroll
        for (int q = 0; q < 16; ++q) { o0[q] = o0[q] * c0 + mg[(2 + q) * 64] * c1; o1[q] = o1[q] * c0 + mg[(18 + q) * 64] * c1; }
        const size_t pidx = ((size_t)hh * SEQ + t) * 4 + p;
        if (hi == 0) { float* pm = (float*)(F.ws + WS_DM) + pidx * 2; pm[0] = M; pm[1] = L; }
        bf16_t* od = (bf16_t*)(F.ws + WS_DO) + pidx * 64 + 4 * hi;
#pragma unroll
        for (int g4 = 0; g4 < 4; ++g4) {
            u32x2 w; w.x = pk2(o0[4 * g4], o0[4 * g4 + 1]); w.y = pk2(o0[4 * g4 + 2], o0[4 * g4 + 3]); *(u32x2*)(od + 8 * g4) = w;
            u32x2 z; z.x = pk2(o1[4 * g4], o1[4 * g4 + 1]); z.y = pk2(o1[4 * g4 + 2], o1[4 * g4 + 3]); *(u32x2*)(od + 32 + 8 * g4) = z;
        }
    }
    __syncthreads();
}
DI void moba_select(Frame& F, const LAS float* kmean, int hh, int t, int ownb, int& o1, int& o2, int& o3) {
    const int lane = F.lane, r32 = lane & 31, hi = lane >> 5;
    float qv[64];
    { const bf16_t* qrow = (const bf16_t*)(F.ws + WS_QC) + ((size_t)hh * SEQ + t) * 64;
#pragma unroll
      for (int i = 0; i < 8; ++i) { const bf16x8 r = *(const bf16x8*)(qrow + 8 * i);
#pragma unroll
          for (int e = 0; e < 8; ++e) qv[8 * i + e] = bf2f((bf16_t)r[e]); } }
    float v1 = -INFINITY, v2 = -INFINITY, v3 = -INFINITY; int i1 = -1, i2 = -1, i3 = -1;
    for (int n = hi; n < ownb; n += 2) {
        const LAS f32x4* km = (const LAS f32x4*)(kmean + (hh * 64 + n) * 64);
        float g0 = 0.f, g1 = 0.f;
#pragma unroll
        for (int d4 = 0; d4 < 16; d4 += 2) { const f32x4 k0 = km[d4], k1 = km[d4 + 1];
            g0 += qv[4 * d4] * k0.x + qv[4 * d4 + 1] * k0.y + qv[4 * d4 + 2] * k0.z + qv[4 * d4 + 3] * k0.w;
            g1 += qv[4 * d4 + 4] * k1.x + qv[4 * d4 + 5] * k1.y + qv[4 * d4 + 6] * k1.z + qv[4 * d4 + 7] * k1.w; }
        const float g = g0 + g1;
        if (g > v1) { v3 = v2; i3 = i2; v2 = v1; i2 = i1; v1 = g; i1 = n; }
        else if (g > v2) { v3 = v2; i3 = i2; v2 = g; i2 = n; }
        else if (g > v3) { v3 = g; i3 = n; }
    }
    float pv[3]; int pi[3];
    pv[0] = __shfl_xor(v1, 32); pv[1] = __shfl_xor(v2, 32); pv[2] = __shfl_xor(v3, 32);
    pi[0] = __shfl_xor(i1, 32); pi[1] = __shfl_xor(i2, 32); pi[2] = __shfl_xor(i3, 32);
#pragma unroll
    for (int c = 0; c < 3; ++c) {
        const float g = pv[c]; const int n = pi[c];
        if (n >= 0) {
            if (g > v1 || (g == v1 && n < i1)) { v3 = v2; i3 = i2; v2 = v1; i2 = i1; v1 = g; i1 = n; }
            else if (g > v2 || (g == v2 && n < i2)) { v3 = v2; i3 = i2; v2 = g; i2 = n; }
            else if (g > v3 || (g == v3 && n < i3)) { v3 = g; i3 = n; }
        }
    }
    o1 = i1; o2 = i2; o3 = i3; (void)r32;
}
DI void moba_block_unit(Frame& F, int hh, int n, const int* list, int q0, int cnt, bool own) {
    constexpr int KSTR = 72, VSTR = 264, KBYTES = 256 * KSTR * 2;
    int tid_ = threadIdx.x; asm volatile("" : "+v"(tid_));
    const int tid = tid_, lane = tid & 63, wave = __builtin_amdgcn_readfirstlane(tid >> 6), r32 = lane & 31, hi = lane >> 5;
    const bf16_t* Kg = (const bf16_t*)(F.ws + WS_KC) + ((size_t)hh * SEQ + 256 * n) * 64;
    const bf16_t* Vg = (const bf16_t*)(F.ws + WS_VCT) + (size_t)hh * 64 * SEQ + 256 * n;
    LAS bf16_t* Kb = (LAS bf16_t*)F.lds; LAS bf16_t* Vb = (LAS bf16_t*)(F.lds + KBYTES);
    int t, slot = 3, e = 0; bool valid = true;
    if (!own) { const int idx = q0 + 32 * wave + r32; valid = idx < cnt; e = list[valid ? idx : q0]; }
    const bool wave_any = own || (q0 + 32 * wave < cnt);
    u32x4 sk[4], sv[4];
#pragma unroll
    for (int i = 0; i < 4; ++i) { const int p = tid + NTHREADS * i; sk[i] = *(const u32x4*)(Kg + (size_t)(p >> 3) * 64 + 8 * (p & 7)); sv[i] = *(const u32x4*)(Vg + (size_t)(p >> 5) * SEQ + 8 * (p & 31)); }
    if (own) t = 256 * n + 32 * wave + r32; else { t = e & 0xffff; slot = e >> 16; }
    bf16x8 qf[4];
    { const bf16_t* Qp = (const bf16_t*)(F.ws + WS_QC) + ((size_t)hh * SEQ + t) * 64 + 8 * hi;
#pragma unroll
      for (int ks = 0; ks < 4; ++ks) qf[ks] = *(const bf16x8*)(Qp + 16 * ks); }
#pragma unroll
    for (int i = 0; i < 4; ++i) { const int p = tid + NTHREADS * i; *(LAS u32x4*)(Kb + (p >> 3) * KSTR + 8 * (p & 7)) = sk[i]; *(LAS u32x4*)(Vb + (p >> 5) * VSTR + 8 * (p & 31)) = sv[i]; }
    __syncthreads();
    if (wave_any) {
        const float slope2 = exp2f(-(float)(2 * hh + 2)) * LOG2E;
        f32x16 cb;
#pragma unroll
        for (int r = 0; r < 16; ++r) cb[r] = slope2 * (float)(16 * (r >> 3) + (r & 7) + 8 * hi);
        const int jend = own ? wave : 7;
        float m = slope2 * (float)(32 * jend + 31), lsum = 0.f;
        f32x16 o0, o1;
#pragma unroll
        for (int r = 0; r < 16; ++r) { o0[r] = 0.f; o1[r] = 0.f; }
        for (int j = jend; j >= 0; --j) {
            const LAS bf16_t* kp = Kb + (32 * j + swap23(r32)) * KSTR + 8 * hi;
            const LAS bf16_t* vp = Vb + r32 * VSTR + 32 * j + 8 * hi;
            bf16x8 kf[4], vf[4];
#pragma unroll
            for (int ks = 0; ks < 4; ++ks) kf[ks] = *(const LAS bf16x8*)(kp + 16 * ks);
            vf[0] = *(const LAS bf16x8*)(vp); vf[1] = *(const LAS bf16x8*)(vp + 16); vf[2] = *(const LAS bf16x8*)(vp + 32 * VSTR); vf[3] = *(const LAS bf16x8*)(vp + 32 * VSTR + 16);
            f32x16 s = MFMA32(kf[0], qf[0], cb);
#pragma unroll
            for (int ks = 1; ks < 4; ++ks) s = MFMA32(kf[ks], qf[ks], s);
            if (own && j == wave) {
                const int d0 = t - (256 * n + 32 * j + 8 * hi);
#pragma unroll
                for (int i = 0; i < 16; ++i) { const int dl = d0 - (16 * (i >> 3) + (i & 7)); if (dl < 0) s[i] = -INFINITY; }
            }
            float mj = m - slope2 * (float)(32 * j);
            float rm = fmaxf(s[0], s[1]);
#pragma unroll
            for (int i = 2; i < 16; ++i) rm = fmaxf(rm, s[i]);
            rm = max_x32(rm) - mj;
            if (__any(rm > 8.0f)) {
                const float dl = fmaxf(rm, 0.f), alpha = __builtin_amdgcn_exp2f(-dl);
                m += dl; mj += dl; lsum *= alpha;
#pragma unroll
                for (int r = 0; r < 16; ++r) { o0[r] *= alpha; o1[r] *= alpha; }
            }
            float p[16], psum = 0.f;
#pragma unroll
            for (int i = 0; i < 16; ++i) { p[i] = __builtin_amdgcn_exp2f(s[i] - mj); psum += p[i]; }
            lsum += psum;
            u32x4 w0, w1;
            w0.x = pk2(p[0], p[1]); w0.y = pk2(p[2], p[3]); w0.z = pk2(p[4], p[5]); w0.w = pk2(p[6], p[7]);
            w1.x = pk2(p[8], p[9]); w1.y = pk2(p[10], p[11]); w1.z = pk2(p[12], p[13]); w1.w = pk2(p[14], p[15]);
            const bf16x8 pf0 = __builtin_bit_cast(bf16x8, w0), pf1 = __builtin_bit_cast(bf16x8, w1);
            o0 = MFMA32(vf[0], pf0, o0); o0 = MFMA32(vf[1], pf1, o0);
            o1 = MFMA32(vf[2], pf0, o1); o1 = MFMA32(vf[3], pf1, o1);
        }
        m -= slope2 * (float)(t - 256 * n);
        const float ltot = sum_x32(lsum), inv = 1.0f / ltot;
        if (valid) {
            const size_t pidx = ((size_t)hh * SEQ + t) * 4 + slot;
            if (hi == 0) { float* pm = (float*)(F.ws + WS_PM) + pidx * 2; pm[0] = m; pm[1] = ltot; }
            bf16_t* od = (bf16_t*)(F.ws + WS_PO) + pidx * 64 + 4 * hi;
#pragma unroll
            for (int g4 = 0; g4 < 4; ++g4) {
                u32x2 w; w.x = pk2(o0[4 * g4] * inv, o0[4 * g4 + 1] * inv); w.y = pk2(o0[4 * g4 + 2] * inv, o0[4 * g4 + 3] * inv); *(u32x2*)(od + 8 * g4) = w;
                u32x2 z; z.x = pk2(o1[4 * g4] * inv, o1[4 * g4 + 1] * inv); z.y = pk2(o1[4 * g4 + 2] * inv, o1[4 * g4 + 3] * inv); *(u32x2*)(od + 32 + 8 * g4) = z;
            }
        }
    }
    __syncthreads();
}
DI int grab_unit(unsigned* ctr, int lane) {
    int u = 0;
    if (lane == 0) u = (int)__hip_atomic_fetch_add(ctr, 1u, __ATOMIC_RELAXED, __HIP_MEMORY_SCOPE_AGENT);
    return __builtin_amdgcn_readfirstlane(u);
}
DI void phase_attention(Frame& F, int l, int rep) {
    const int tid = F.tid, lane = F.lane, wave = F.wave;
    LAS float* kmean = (LAS float*)F.lds;
    LAS float* fpre = (LAS float*)(F.lds + ATT_FPRE_OFF);
    LAS unsigned* cntl = (LAS unsigned*)(F.lds + ATT_SELM_OFF);
    LAS float* misc = (LAS float*)(F.lds + ATT_MISC_OFF);
    const float* ksum = (const float*)(F.ws + WS_KSUM);
    if (tid < 4) { const float* ft = (const float*)(F.ws + WS_FTILE) + tid * 256; float run = 0.f;
        for (int i = 0; i < 256; ++i) { fpre[tid * 256 + i] = run; run += ft[i]; } }
    if (wave == 1) {
        const float gq = wave_max(fabsf(F.in(I_FQG)[l * 64 + lane])), gk = wave_max(fabsf(F.in(I_FKG)[l * 64 + lane]));
        if (lane == 0) misc[0] = (40.0f + 2.0f * 8.0f * 1.03f * gq * gk) * LOG2E;
    }
    if (rep == 0) {
        for (int idx = tid; idx < 4 * 64 * 64; idx += NTHREADS) {
            const int h2 = idx >> 12, n = (idx >> 6) & 63, d = idx & 63;
            const float* kp = ksum + ((size_t)h2 * 256 + 4 * n) * 64 + d;
            kmean[idx] = ((kp[0] + kp[64]) + (kp[128] + kp[192])) * (1.0f / 256.0f);
        }
        unsigned* bcnt = F.ctl + CW_BCNT + 256 * l; int* blist = (int*)(F.ws + WS_BLIST);
        for (int tile = blockIdx.x; tile < SEQ / 64; tile += F.G) {
            if (tid < 256) cntl[tid] = 0u;
            __syncthreads();
            const int hh = wave >> 1, t = 64 * tile + 32 * (wave & 1) + (lane & 31);
            int sel[3]; moba_select(F, kmean, hh, t, t >> 8, sel[0], sel[1], sel[2]);
            unsigned rank[3] = {0u, 0u, 0u};
            if (lane < 32) {
#pragma unroll
                for (int j = 0; j < 3; ++j) if (sel[j] >= 0) rank[j] = __hip_atomic_fetch_add(cntl + hh * 64 + sel[j], 1u, __ATOMIC_RELAXED, __HIP_MEMORY_SCOPE_WORKGROUP);
            }
            __syncthreads();
            if (tid < 256) { const unsigned c = cntl[tid]; cntl[256 + tid] = c ? __hip_atomic_fetch_add(bcnt + tid, c, __ATOMIC_RELAXED, __HIP_MEMORY_SCOPE_AGENT) : 0u; }
            __syncthreads();
            if (lane < 32) {
#pragma unroll
                for (int j = 0; j < 3; ++j) if (sel[j] >= 0) blist[(size_t)(hh * 64 + sel[j]) * SEQ + cntl[256 + hh * 64 + sel[j]] + rank[j]] = t | (j << 16);
            }
            __syncthreads();
        }
    }
    __syncthreads();
#ifndef ATT_REP
#define ATT_REP 0
#endif
    BgConv bg; bg.init(blockIdx.x * NWAVES + wave, F.G * NWAVES, l); if (rep != 0 || !BG_CONVERT) bg.it = BG_ITEMS;
    for (int vc = blockIdx.x; vc < 256; vc += F.G) {
        const int hh = (vc & 7) >> 1, q = ((vc & 1) << 5) | (vc >> 3);
        for (int rr = 0; rr < 1 + ((ATT_REP >> 0) & 1); ++rr) { mla_wg_unit<0>(F, hh, 127 - q, bg); mla_wg_unit<0>(F, hh, q, bg); }
        if (BG_CONVERT) bg.drain(F, wave, lane);
#ifdef A_SHADOW
        mla_wg_unit<A_SHADOW>(F, hh, 127 - q, bg); mla_wg_unit<A_SHADOW>(F, hh, q, bg);
#endif
        for (int rr = 0; rr < 1 + ((ATT_REP >> 3) & 1); ++rr)
        {
            DilPre pre; DilUnit du = dil_decode(vc * 6); dil_preload(F, du, pre);
            for (int k = 0; k < 6; ++k) { const DilUnit dn = dil_decode(vc * 6 + (k < 5 ? k + 1 : k)); dil_wg_unit(F, du, pre, k < 5, dn); du = dn; }
        }
        for (int rr = 0; rr < 1 + ((ATT_REP >> 2) & 1); ++rr) moba_block_unit(F, hh, q, nullptr, 0, 0, true);
    }
    if (BG_CONVERT) { bg.drain(F, wave, lane); bg.rest(F, wave, lane); }
    __syncthreads();
    AttnShared A; A.kmean = kmean; A.fpre = fpre; A.fox_cut = misc[0];
    unsigned* qctr = F.ctl + CW_QUEUE + 64 * (l * 4) + 1024 * rep;
    for (;;) { const int u = grab_unit(qctr + 1 * 64, lane); if (u >= 2048) break; fox_unit(F, A, u & 3, 511 - (u >> 2)); }
}
DI void phase_moba_items(Frame& F, int l, int rep) {
    const int tid = F.tid;
    LAS int* istart = (LAS int*)(F.lds + ATT_SELM_OFF);
    LAS int* bc = (LAS int*)(F.lds + ATT_SELM_OFF + 2048);
    LAS int* cur = (LAS int*)(F.lds + ATT_SELM_OFF + 4096);
    const unsigned* bcnt = F.ctl + CW_BCNT + 256 * l;
    if (tid < 256) bc[tid] = (int)__hip_atomic_load(bcnt + tid, __ATOMIC_RELAXED, __HIP_MEMORY_SCOPE_AGENT);
    __syncthreads();
    if (tid == 0) { int run = 0; for (int i = 0; i < 256; ++i) { istart[i] = run; run += (bc[i] + 255) >> 8; } istart[256] = run; }
    __syncthreads();
    const int nitems = istart[256];
    unsigned* qctr = F.ctl + CW_MQ + 64 * l + 1024 * rep;
    const int* blist = (const int*)(F.ws + WS_BLIST);
    for (;;) {
        if (tid == 0) { const int it = (int)__hip_atomic_fetch_add(qctr, 1u, __ATOMIC_RELAXED, __HIP_MEMORY_SCOPE_AGENT);
            int b = -1, q0 = 0;
            if (it < nitems) { int lo = 0, hi = 255; while (lo < hi) { const int mid = (lo + hi + 1) >> 1; if (istart[mid] <= it) lo = mid; else hi = mid - 1; } b = lo; q0 = (it - istart[lo]) << 8; }
            cur[0] = b; cur[1] = q0; }
        __syncthreads();
        const int b = cur[0], q0 = cur[1];
        __syncthreads();
        if (b < 0) break;
        moba_block_unit(F, b >> 6, b & 63, blist + (size_t)b * SEQ, q0, bc[b], false);
    }
}
DI void phase_moba_combine(Frame& F) {
    const int lane = F.lane, sub = lane & 15;
    bf16_t* o = (bf16_t*)(F.ws + WS_O);
    const int gw = blockIdx.x * NWAVES + F.wave, NGW = F.G * NWAVES;
    for (int it0 = gw; it0 < 2 * SEQ; it0 += 2 * NGW) {
        f32x2_t pmv[2][4]; u32x2 pov[2][4]; int tt[2], hh2[2], wh[2], ns[2]; bool act[2];
#pragma unroll
        for (int q = 0; q < 2; ++q) {
            const int it = it0 + q * NGW; act[q] = it < 2 * SEQ; const int itc = act[q] ? it : it0;
            const int which = itc >= SEQ;
            const int pair = (itc - which * SEQ) * 4 + (lane >> 4), t = pair >> 2, hh = pair & 3;
            const float* pm = (const float*)(F.ws + (which ? WS_DM : WS_PM)); const bf16_t* po = (const bf16_t*)(F.ws + (which ? WS_DO : WS_PO));
            const size_t base = ((size_t)hh * SEQ + t) * 4;
            tt[q] = t; hh2[q] = hh; wh[q] = which; ns[q] = which ? 3 : ((t >> 8) < 3 ? (t >> 8) : 3);
#pragma unroll
            for (int j = 0; j < 4; ++j) { pmv[q][j] = *(const f32x2_t*)(pm + (base + j) * 2); pov[q][j] = *(const u32x2*)(po + (base + j) * 64 + 4 * sub); }
        }
#pragma unroll
        for (int q = 0; q < 2; ++q) {
            if (!act[q]) break;
            float mj[4], lj[4]; float M = -1e30f;
#pragma unroll
            for (int j = 0; j < 4; ++j) { const bool use = (j == 3) ? !wh[q] : (j < ns[q]); mj[j] = use ? pmv[q][j].x : -1e30f; lj[j] = use ? pmv[q][j].y : 0.f; M = fmaxf(M, mj[j]); }
            float acc[4] = {0.f, 0.f, 0.f, 0.f}, W = 0.f;
#pragma unroll
            for (int j = 0; j < 4; ++j) { const bool use = (j == 3) ? !wh[q] : (j < ns[q]);
                const float w = use ? lj[j] * __builtin_amdgcn_exp2f(mj[j] - M) : 0.f; W += w; const u32x2 v = pov[q][j];
                if (use) {
                acc[0] += w * bf2f((bf16_t)(v.x & 0xffffu)); acc[1] += w * bf2f((bf16_t)(v.x >> 16)); acc[2] += w * bf2f((bf16_t)(v.y & 0xffffu)); acc[3] += w * bf2f((bf16_t)(v.y >> 16)); } }
            const float inv = 1.0f / W;
            u32x2 r; r.x = pk2(acc[0] * inv, acc[1] * inv); r.y = pk2(acc[2] * inv, acc[3] * inv);
            *(u32x2*)(o + (size_t)tt[q] * DM + ((wh[q] ? 12 : 8) + hh2[q]) * 64 + 4 * sub) = r;
        }
    }
}

struct EpiGateRes {
    static constexpr bool PERM = false, AFTER_DRAIN = false;
    const float* xin; float* xout; const float* gate;
    DI void operator()(const pg8::f32x4 (&acc)[2][2][4][2], const pg8::Unit& u, int wr, int wc, int fr, int fq) const {
        const int row0 = u.pm * 256 + wr * 64 + fr, col0 = u.pn * 256 + wc * 32 + 4 * fq;
        pg8::f32x4 gv[2][2];
#pragma unroll
        for (int bj = 0; bj < 2; ++bj)
#pragma unroll
            for (int n = 0; n < 2; ++n) gv[bj][n] = *(const pg8::f32x4*)(gate + col0 + bj * 128 + n * 16);
        pg8::f32x4 xa[2][2], xb[2][2];
#define EGR_LOAD(x_, g_) do { const size_t o_ = (size_t)(row0 + ((g_) >> 2) * 128 + ((g_) & 3) * 16) * DM + col0; _Pragma("unroll") for (int bj = 0; bj < 2; ++bj) _Pragma("unroll") for (int n = 0; n < 2; ++n) x_[bj][n] = *(const pg8::f32x4*)(xin + o_ + bj * 128 + n * 16); } while (0)
#define EGR_STORE(x_, g_) do { const size_t o_ = (size_t)(row0 + ((g_) >> 2) * 128 + ((g_) & 3) * 16) * DM + col0; _Pragma("unroll") for (int bj = 0; bj < 2; ++bj) _Pragma("unroll") for (int n = 0; n < 2; ++n) \
            *(pg8::f32x4*)(xout + o_ + bj * 128 + n * 16) = x_[bj][n] + gv[bj][n] * acc[(g_) >> 2][bj][(g_) & 3][n]; } while (0)
        EGR_LOAD(xa, 0);
        EGR_LOAD(xb, 1); EGR_STORE(xa, 0);
        EGR_LOAD(xa, 2); EGR_STORE(xb, 1);
        EGR_LOAD(xb, 3); EGR_STORE(xa, 2);
        EGR_LOAD(xa, 4); EGR_STORE(xb, 3);
        EGR_LOAD(xb, 5); EGR_STORE(xa, 4);
        EGR_LOAD(xa, 6); EGR_STORE(xb, 5);
        EGR_LOAD(xb, 7); EGR_STORE(xa, 6);
        EGR_STORE(xb, 7);
#undef EGR_LOAD
#undef EGR_STORE
    }
};
#ifndef GROUPED_2D
#define GROUPED_2D 1
#endif
struct GroupedOrder {
    const LAS int* tile_e; int nMt, NT, G, c;
    const LAS int* tile0; const LAS int* ecnt; const int* inv;
    DI bool next(int i, pg8::Unit& u) const {
        int mt, nt;
        if (GROUPED_2D) {
            const int x = c & 7, j = i * (G >> 3) + (c >> 3);
            if (NT == 8) { mt = (j >> 1) * 2 + (x >> 2); nt = 2 * (x & 3) + (j & 1); }
            else         { mt = (j >> 1) * 4 + (x >> 1); nt = 2 * (x & 1) + (j & 1); }
            if (mt >= nMt) return false;
        } else {
            const long L = (long)i * G + c; if (L >= (long)nMt * NT) return false;
            mt = (int)(L / NT); nt = (int)(L % NT);
        }
        u.pm = mt; u.pn = tile_e[mt] * NT + nt; return true;
    }
    DI int arow(const pg8::Unit& u, int r) const { const int e = u.pn / NT, slot = (u.pm - tile0[e]) * 256 + r; return slot < ecnt[e] ? inv[e * SEQ + slot] : 0; }
    unsigned* ycnt; int role; unsigned* tmo;
    DI void done(const pg8::Unit& u) const {
        if (role == 1) { asm volatile("s_waitcnt vmcnt(0)" ::: "memory");
            if ((threadIdx.x & 63) == 0) __hip_atomic_fetch_add(ycnt + 64 * u.pm, 1u, __ATOMIC_RELAXED, __HIP_MEMORY_SCOPE_AGENT); }
    }
    DI void a_ready(const pg8::Unit& u) const {
        if (role == 2) {
            if (threadIdx.x < 64) {
                const unsigned long long t0 = __builtin_amdgcn_s_memrealtime(); unsigned polls = 0;
                while ((unsigned)__builtin_amdgcn_readfirstlane(__hip_atomic_load(ycnt + 64 * u.pm, __ATOMIC_RELAXED, __HIP_MEMORY_SCOPE_AGENT)) < 64u) {
                    if ((++polls & 255u) == 0u && __builtin_amdgcn_readfirstlane(__hip_atomic_load(tmo, __ATOMIC_RELAXED, __HIP_MEMORY_SCOPE_AGENT)) != 0u) break;
                    if (__builtin_amdgcn_s_memrealtime() - t0 > 2000000ull) { if (threadIdx.x == 0) __hip_atomic_store(tmo, 1u, __ATOMIC_RELAXED, __HIP_MEMORY_SCOPE_AGENT); break; }
                    __builtin_amdgcn_s_sleep(2); }
                __builtin_amdgcn_fence(__ATOMIC_ACQUIRE, "agent");
                asm volatile("s_waitcnt vmcnt(0)" ::: "memory");
            }
            asm volatile("" ::: "memory"); __builtin_amdgcn_s_barrier(); asm volatile("" ::: "memory");
        }
    }
};
template <bool WT> struct EpiSwigluT {
    static constexpr bool PERM = true, AFTER_DRAIN = false;
    bf16_t* Y; const float* b1;
    DI void operator()(const pg8::f32x4 (&acc)[2][2][4][2], const pg8::Unit& u, int wr, int wc, int fr, int fq) const {
        const int e = u.pn >> 3, nt = u.pn & 7;
        const int row0 = u.pm * 256 + wr * 64 + fr, col0 = nt * 128 + wc * 32 + 8 * fq;
        const float* bp = b1 + (size_t)e * 2048 + col0;
        const float sc = UP_FP8 ? WINV : 1.0f;
        pg8::f32x4 bgv[2], buv[2];
#pragma unroll
        for (int n = 0; n < 2; ++n) { bgv[n] = *(const pg8::f32x4*)(bp + 4 * n); buv[n] = *(const pg8::f32x4*)(bp + 1024 + 4 * n); }
#pragma unroll
        for (int ai = 0; ai < 2; ++ai)
#pragma unroll
            for (int m = 0; m < 4; ++m) {
                float y[8];
#pragma unroll
                for (int n = 0; n < 2; ++n) { const pg8::f32x4 gg = acc[ai][0][m][n] * sc + bgv[n], uu = acc[ai][1][m][n] * sc + buv[n];
#pragma unroll
                    for (int j = 0; j < 4; ++j) { const float g = fminf(gg[j], 7.0f), uc = fminf(fmaxf(uu[j], -7.0f), 7.0f);
                        y[4 * n + j] = (uc + 1.0f) * g * __builtin_amdgcn_rcpf(1.0f + __builtin_amdgcn_exp2f(-1.702f * LOG2E * g)); } }
                const size_t ro = (size_t)(row0 + ai * 128 + m * 16) * FEXP + col0;
                if (MOE_FP8) { GAS unsigned long long* y8 = (GAS unsigned long long*)((unsigned char*)Y + ro);
                    const unsigned long long v8 = ((unsigned long long)pk4_fp8(y[4], y[5], y[6], y[7]) << 32) | pk4_fp8(y[0], y[1], y[2], y[3]);
                    if (WT) __hip_atomic_store(y8, v8, __ATOMIC_RELAXED, __HIP_MEMORY_SCOPE_AGENT); else *y8 = v8; }
                else { const u32x4 w = pack8(y); GAS unsigned long long* yp = (GAS unsigned long long*)(Y + ro);
                    if (WT) { __hip_atomic_store(yp, ((unsigned long long)w.y << 32) | w.x, __ATOMIC_RELAXED, __HIP_MEMORY_SCOPE_AGENT); __hip_atomic_store(yp + 1, ((unsigned long long)w.w << 32) | w.z, __ATOMIC_RELAXED, __HIP_MEMORY_SCOPE_AGENT); }
                    else *(GAS u32x4*)yp = w; }
                asm volatile("" ::: "memory");
            }
    }
};
struct EpiDown {
    static constexpr bool PERM = true, AFTER_DRAIN = false;
    bf16_t* Y; const float* b2;
    DI void operator()(const pg8::f32x4 (&acc)[2][2][4][2], const pg8::Unit& u, int wr, int wc, int fr, int fq) const {
        const int e = u.pn >> 2, nt = u.pn & 3;
        const int row0 = u.pm * 256 + wr * 64 + fr, col0 = nt * 256 + wc * 32 + 8 * fq;
        const float* bp = b2 + (size_t)e * DM + col0;
        pg8::f32x4 bv[2][2];
#pragma unroll
        for (int bj = 0; bj < 2; ++bj)
#pragma unroll
            for (int n = 0; n < 2; ++n) bv[bj][n] = *(const pg8::f32x4*)(bp + bj * 128 + 4 * n);
#pragma unroll
        for (int ai = 0; ai < 2; ++ai)
#pragma unroll
            for (int m = 0; m < 4; ++m)
#pragma unroll
                for (int bj = 0; bj < 2; ++bj) {
                    const pg8::f32x4 v0 = acc[ai][bj][m][0] * (MOE_FP8 ? WINV : 1.0f) + bv[bj][0], v1 = acc[ai][bj][m][1] * (MOE_FP8 ? WINV : 1.0f) + bv[bj][1];
                    u32x4 w; w.x = pk2(v0[0], v0[1]); w.y = pk2(v0[2], v0[3]); w.z = pk2(v1[0], v1[1]); w.w = pk2(v1[2], v1[3]);
                    *(u32x4*)(Y + (size_t)(row0 + ai * 128 + m * 16) * DM + col0 + bj * 128) = w;
                }
    }
};

DI void phase_router(Frame& F, int l) {
    const int tid = F.tid, lane = F.lane, wave = F.wave;
    constexpr int WST = 1028;
    LAS float* wrt = (LAS float*)F.lds;
    LAS unsigned* cnt = (LAS unsigned*)(F.lds + 131584);
    LAS unsigned* basew = (LAS unsigned*)(F.lds + 131584 + 128);
    LAS int* info_e = (LAS int*)(F.lds + 131584 + 256);
    LAS float* info_g = (LAS float*)(F.lds + 131584 + 256 + 1024);
    const float* rw = F.in(I_RW) + (size_t)l * DM * NEXP;
    for (int idx = tid; idx < DM * NEXP; idx += NTHREADS) { const int c = idx >> 5, e = idx & 31; wrt[e * WST + c] = rw[idx]; }
    const float* mod = (const float*)(F.ws + WS_META + META_MOD) + l * 6144;
    const float* x1 = (const float*)(F.ws + WS_X1);
    bf16_t* h2 = (bf16_t*)(F.ws + WS_H);
    int* toki = (int*)(F.ws + WS_TOKI); float* tokg = (float*)(F.ws + WS_TOKI + 256 * 1024);
    unsigned* gcnt = F.ctl + CW_ECNT + 64 * l;
    for (int tile = blockIdx.x; tile < SEQ / 64; tile += F.G) {
        if (tid < 32) cnt[tid] = 0u;
        __syncthreads();
        LAS float* lg = (LAS float*)(F.lds + 131584 + 256 + 2048) + wave * 48;
#ifndef RROWS
#define RROWS 1
#endif
#pragma unroll 1
        for (int rr = 0; rr < 8; rr += RROWS) {
            f32x4 hv[RROWS][4];
#pragma unroll
            for (int q = 0; q < RROWS; ++q) {
                const int tok = tile * 64 + wave * 8 + rr + q;
                const f32x4* xr = (const f32x4*)(x1 + (size_t)tok * DM) + lane;
                f32x4 v[4]; float ss = 0.f;
#pragma unroll
                for (int j = 0; j < 4; ++j) { v[j] = xr[64 * j]; ss += (v[j].x * v[j].x + v[j].y * v[j].y) + (v[j].z * v[j].z + v[j].w * v[j].w); }
                ss = wave_sum(ss);
                const float rstd = 1.0f / sqrtf(ss * (1.0f / DM) + EPS);
#pragma unroll
                for (int j = 0; j < 4; ++j) { const int c = 4 * lane + 256 * j;
                    const f32x4 g4 = *(const f32x4*)(F.in(I_N2G) + l * DM + c), s4 = *(const f32x4*)(mod + 4 * DM + c), h4 = *(const f32x4*)(mod + 3 * DM + c);
                    hv[q][j] = (v[j] * rstd) * g4 * (s4 + 1.0f) + h4;
                    if (UP_FP8) *(unsigned*)((unsigned char*)(F.ws + WS_H8) + (size_t)tok * DM + c) = pk4_fp8(hv[q][j].x, hv[q][j].y, hv[q][j].z, hv[q][j].w);
                    else { u32x2 w; w.x = pk2(hv[q][j].x, hv[q][j].y); w.y = pk2(hv[q][j].z, hv[q][j].w); *(u32x2*)(h2 + (size_t)tok * DM + c) = w; } }
            }
            float pe[RROWS][32];
#pragma unroll
            for (int e = 0; e < 32; ++e) { float a[RROWS];
#pragma unroll
                for (int q = 0; q < RROWS; ++q) a[q] = 0.f;
#pragma unroll
                for (int j = 0; j < 4; ++j) { const f32x4 w4 = *(const LAS f32x4*)(wrt + e * WST + 4 * lane + 256 * j);
#pragma unroll
                    for (int q = 0; q < RROWS; ++q) a[q] += hv[q][j].x * w4.x + hv[q][j].y * w4.y + hv[q][j].z * w4.z + hv[q][j].w * w4.w; }
#pragma unroll
                for (int q = 0; q < RROWS; ++q) pe[q][e] = a[q]; if ((e & 1) == 1) asm volatile("" ::: "memory"); }
            const int my_e = ((lane >> 5) & 1) * 16 + ((lane >> 4) & 1) * 8 + ((lane >> 3) & 1) * 4 + ((lane >> 2) & 1) * 2 + ((lane >> 1) & 1);
#pragma unroll
            for (int q = 0; q < RROWS; ++q) {
                const int tl = wave * 8 + rr + q;
                { const bool up = (lane & 32) != 0;
#pragma unroll
                  for (int e = 0; e < 16; ++e) { const float send = up ? pe[q][e] : pe[q][e + 16], keep = up ? pe[q][e + 16] : pe[q][e]; pe[q][e] = keep + __shfl_xor(send, 32); } }
                { const bool up = (lane & 16) != 0;
#pragma unroll
                  for (int e = 0; e < 8; ++e) { const float send = up ? pe[q][e] : pe[q][e + 8], keep = up ? pe[q][e + 8] : pe[q][e]; pe[q][e] = keep + __shfl_xor(send, 16); } }
                { const bool up = (lane & 8) != 0;
#pragma unroll
                  for (int e = 0; e < 4; ++e) { const float send = up ? pe[q][e] : pe[q][e + 4], keep = up ? pe[q][e + 4] : pe[q][e]; pe[q][e] = keep + __shfl_xor(send, 8); } }
                { const bool up = (lane & 4) != 0;
#pragma unroll
                  for (int e = 0; e < 2; ++e) { const float send = up ? pe[q][e] : pe[q][e + 2], keep = up ? pe[q][e + 2] : pe[q][e]; pe[q][e] = keep + __shfl_xor(send, 4); } }
                { const bool up = (lane & 2) != 0; const float send = up ? pe[q][0] : pe[q][1], keep = up ? pe[q][1] : pe[q][0]; pe[q][0] = keep + __shfl_xor(send, 2); }
                pe[q][0] += __shfl_xor(pe[q][0], 1);
                const float val = pe[q][0] + F.in(I_RB)[l * NEXP + my_e];
                asm volatile("s_waitcnt lgkmcnt(0)" ::: "memory");
                if ((lane & 1) == 0) lg[my_e] = val;
                asm volatile("s_waitcnt lgkmcnt(0)" ::: "memory");
                const int ee = lane & 31; const float mine = lg[ee];
                int rank = 0;
#pragma unroll
                for (int j4 = 0; j4 < 8; ++j4) { const f32x4 t4 = *(const LAS f32x4*)(lg + 4 * j4);
                    rank += (t4.x > mine || (t4.x == mine && 4 * j4 + 0 < ee)) ? 1 : 0; rank += (t4.y > mine || (t4.y == mine && 4 * j4 + 1 < ee)) ? 1 : 0;
                    rank += (t4.z > mine || (t4.z == mine && 4 * j4 + 2 < ee)) ? 1 : 0; rank += (t4.w > mine || (t4.w == mine && 4 * j4 + 3 < ee)) ? 1 : 0; }
                if (lane < 32 && rank < 4) { lg[32 + rank] = mine; lg[36 + rank] = __int_as_float(ee); }
                asm volatile("s_waitcnt lgkmcnt(0)" ::: "memory");
                const f32x4 tv4 = *(const LAS f32x4*)(lg + 32), te4 = *(const LAS f32x4*)(lg + 36);
                const float e1 = __expf(tv4.y - tv4.x), e2 = __expf(tv4.z - tv4.x), e3 = __expf(tv4.w - tv4.x);
                const float rs = 1.0f / (1.0f + e1 + e2 + e3);
                if (lane < 4) {
                    const int sel = __float_as_int(lane == 0 ? te4.x : lane == 1 ? te4.y : lane == 2 ? te4.z : te4.w);
                    const float gg = (lane == 0 ? 1.0f : lane == 1 ? e1 : lane == 2 ? e2 : e3) * rs;
                    const unsigned slot = __hip_atomic_fetch_add(cnt + sel, 1u, __ATOMIC_RELAXED, __HIP_MEMORY_SCOPE_WORKGROUP);
                    info_e[tl * 4 + lane] = (sel << 20) | (int)slot; info_g[tl * 4 + lane] = gg;
                }
                asm volatile("s_waitcnt lgkmcnt(0)" ::: "memory");
            }
        }
        __syncthreads();
        if (tid < 32) basew[tid] = __hip_atomic_fetch_add(gcnt + tid, cnt[tid], __ATOMIC_RELAXED, __HIP_MEMORY_SCOPE_AGENT);
        __syncthreads();
        if (tid < 256) { const int ie = info_e[tid]; const int ee = ie >> 20, slot = ie & 0xfffff;
            const int fs = (int)(basew[ee] + (unsigned)slot);
            toki[(size_t)tile * 256 + tid] = (ee << 20) | fs; tokg[(size_t)tile * 256 + tid] = info_g[tid]; ((int*)(F.ws + WS_INV))[ee * SEQ + fs] = tile * 64 + (tid >> 2); }
        __syncthreads();
    }
}
DI void phase_gather8(Frame& F, int l) {
    const int tid = F.tid, lane = F.lane, wave = F.wave;
    LAS int* offs = (LAS int*)F.lds;
    if (tid == 0) { int run = 0; const unsigned* gcnt = F.ctl + CW_ECNT + 64 * l;
        for (int e = 0; e < NEXP; ++e) { const int c = (int)__hip_atomic_load(gcnt + e, __ATOMIC_RELAXED, __HIP_MEMORY_SCOPE_AGENT); offs[e] = run; run += ((c + 255) / 256) * 256; }
        offs[32] = run; }
    __syncthreads();
    const int* toki = (const int*)(F.ws + WS_TOKI);
    const unsigned char* h8 = (const unsigned char*)(F.ws + WS_H8); unsigned char* xs = (unsigned char*)(F.ws + WS_XS);
    const int gw = blockIdx.x * NWAVES + wave, NGW = F.G * NWAVES;
#pragma unroll 4
    for (int item = gw; item < SEQ * TOPK; item += NGW) {
        const int ie = toki[item], ee = ie >> 20, slot = ie & 0xfffff, tok = item >> 2;
        const size_t row = (size_t)offs[ee] + slot;
        *((u32x4*)(xs + row * DM) + lane) = *((const u32x4*)(h8 + (size_t)tok * DM) + lane);
    }
}
constexpr int ETAB_OFF = 131072;
DI void build_expert_tables(Frame& F, int l) {
    LAS int* tile_e = (LAS int*)(F.lds + ETAB_OFF); LAS int* tile0 = tile_e + 512; LAS int* ecnt = tile0 + 32;
    if (F.tid == 0) { int run = 0; const unsigned* gcnt = F.ctl + CW_ECNT + 64 * l;
        int* goff = (int*)(F.ws + WS_META + META_OFF) + l * 64; int* gtile = (int*)(F.ws + WS_META + META_TILE) + l * 512;
        for (int e = 0; e < NEXP; ++e) { const int c = (int)__hip_atomic_load(gcnt + e, __ATOMIC_RELAXED, __HIP_MEMORY_SCOPE_AGENT); ecnt[e] = c; tile0[e] = run >> 8;
            for (int i = 0; i < (c + 255) / 256; ++i) tile_e[(run >> 8) + i] = e;
            if (blockIdx.x == 0) { goff[e] = run; for (int i = 0; i < (c + 255) / 256; ++i) gtile[(run >> 8) + i] = e; }
            run += ((c + 255) / 256) * 256; }
        tile_e[511] = run >> 8; if (blockIdx.x == 0) { goff[32] = run; gtile[511] = run >> 8; } }
    __syncthreads();
}
DI void phase_combine(Frame& F, int l) {
    const int lane = F.lane;
    const float* mod = (const float*)(F.ws + WS_META + META_MOD) + l * 6144;
    const int* goff = (const int*)(F.ws + WS_META + META_OFF) + l * 64;
    const int* toki = (const int*)(F.ws + WS_TOKI); const float* tokg = (const float*)(F.ws + WS_TOKI + 256 * 1024);
    const float* x1 = (const float*)(F.ws + WS_X1); const bf16_t* y2 = (const bf16_t*)(F.ws + WS_Y2);
    float* xo = (l == NLAYER - 1) ? F.ap->out : (float*)(F.ws + WS_XC);
    const int gw = blockIdx.x * NWAVES + F.wave, NGW = F.G * NWAVES;
    for (int i0 = 0; gw + NGW * i0 < SEQ; i0 += 8) {
    int myrow = 0; float mygate = 0.f;
    if (lane < 32) { const int tok = gw + NGW * (i0 + (lane >> 2)); if (tok < SEQ) { const int ie = toki[tok * 4 + (lane & 3)]; mygate = tokg[tok * 4 + (lane & 3)]; myrow = goff[ie >> 20] + (ie & 0xfffff); } }
    for (int i = 0; i < 8; i += 2) {
        const int tokA = gw + NGW * (i0 + i); if (tokA >= SEQ) break;
        const int tokB0 = gw + NGW * (i0 + i + 1); const bool hasB = tokB0 < SEQ; const int tokB = hasB ? tokB0 : tokA;
        u32x2 ya[4][4], yb[4][4]; f32x4 xa[4], xb[4]; float ga[4], gb[4];
#pragma unroll
        for (int k = 0; k < 4; ++k) {
            const int rowA = __shfl(myrow, 4 * i + k), rowB = __shfl(myrow, hasB ? 4 * i + 4 + k : 4 * i + k); ga[k] = __shfl(mygate, 4 * i + k); gb[k] = __shfl(mygate, hasB ? 4 * i + 4 + k : 4 * i + k);
            const u32x2* pa = (const u32x2*)(y2 + (size_t)rowA * DM) + lane; const u32x2* pb = (const u32x2*)(y2 + (size_t)rowB * DM) + lane;
#pragma unroll
            for (int j = 0; j < 4; ++j) { ya[k][j] = pa[64 * j]; yb[k][j] = pb[64 * j]; }
        }
#pragma unroll
        for (int j = 0; j < 4; ++j) { const int c = 4 * lane + 256 * j; xa[j] = *(const f32x4*)(x1 + (size_t)tokA * DM + c); xb[j] = *(const f32x4*)(x1 + (size_t)tokB * DM + c); }
#pragma unroll
        for (int r = 0; r < 2; ++r) {
            if (r == 1 && !hasB) break;
            const int tok = r ? tokB : tokA;
            f32x4 v[4];
#pragma unroll
            for (int j = 0; j < 4; ++j) { const int c = 4 * lane + 256 * j;
                f32x4 acc = (f32x4){0.f, 0.f, 0.f, 0.f};
#pragma unroll
                for (int k = 0; k < 4; ++k) { const u32x2 w = r ? yb[k][j] : ya[k][j]; const float g = r ? gb[k] : ga[k];
                    acc.x += g * bf2f((bf16_t)(w.x & 0xffffu)); acc.y += g * bf2f((bf16_t)(w.x >> 16)); acc.z += g * bf2f((bf16_t)(w.y & 0xffffu)); acc.w += g * bf2f((bf16_t)(w.y >> 16)); }
                const f32x4 g2 = *(const f32x4*)(mod + 5 * DM + c);
                v[j] = (r ? xb[j] : xa[j]) + g2 * acc;
                *(f32x4*)(xo + (size_t)tok * DM + c) = v[j]; }
            if (l + 1 < NLAYER) { const float* mod1 = (const float*)(F.ws + WS_META + META_MOD) + (l + 1) * 6144;
                norm_mod_store(v, F.in(I_N1G) + (l + 1) * DM, mod1 + 1 * DM, mod1 + 0 * DM, (bf16_t*)(F.ws + WS_H) + (size_t)tok * DM, lane); }
        }
    }
    }
}

#ifndef PH_MASK
#define PH_MASK 0xFFFFF
#endif
#define PHON(k) (((PH_MASK) >> (k)) & 1)
#ifndef REP_MASK
#define REP_MASK 0
#endif
#define NREP(k) ((((REP_MASK) >> (k)) & 1) ? 2 : 1)
constexpr int N_PHASES = 2 + 11 * NLAYER;
__global__ void __launch_bounds__(NTHREADS, 2) mk_fwd(Args args) {
    extern __shared__ __attribute__((aligned(16))) unsigned char lds_raw[];
    Frame F;
    F.lds = (LAS unsigned char*)lds_raw; F.ws = args.ws; F.ctl = (unsigned*)(args.ws + WS_CTL);
    F.ap = (KArgP)__builtin_amdgcn_kernarg_segment_ptr();
    F.refresh(); F.G = gridDim.x;
    volatile LAS unsigned* MISC = (volatile LAS unsigned*)(F.lds + LDSCTL_OFF);
    for (int u = F.tid; u < (LDS_BYTES - LDSCTL_OFF) / 4; u += NTHREADS) MISC[u] = 0u;
    __syncthreads();
    const int lo = args.ph_lo, hi = args.ph_hi;
    XcdBarrier bar; bar.bar = F.ctl + CW_BAR; bar.x = 0; bar.st = MISC + 8;
    if (hi - lo > 1) bar = xcd_barrier_post(F.ctl + CW_BAR, MISC + 8);
#define IN(k) (lo <= (k) && (k) < hi)
#define SEAM(k) do { if (IN(k) && IN((k) + 1)) xcd_barrier(bar); } while (0)
    for (int rep = 0; rep < NREP(0); ++rep) if (PHON(0) && IN(0)) { if (rep) xcd_barrier(bar); F.refresh(); phase_prologue(F); }
    SEAM(0);
    for (int rep = 0; rep < NREP(1); ++rep) if (PHON(1) && IN(1)) { if (rep) xcd_barrier(bar); F.refresh(); phase_norm1_l0(F); }
    SEAM(1);
#ifdef EXTRA_BARS
    for (int xb = 0; xb < EXTRA_BARS; ++xb) xcd_barrier(bar);
#endif
    for (int l = 0; l < NLAYER; ++l) {
        const int pb = 2 + 11 * l;
        const float* mod = (const float*)(F.ws + WS_META + META_MOD) + l * 6144;
        for (int rep = 0; rep < NREP(2); ++rep) if (PHON(2) && IN(pb + 0)) { if (rep) xcd_barrier(bar);
            pg8::Gemm g{(const pg8::bf16_t*)(F.ws + WS_H), (const pg8::bf16_t*)(F.ws + WS_W1T) + (size_t)l * NP * DM, SEQ, NP, DM};
            pg8::StaticOrder S; S.init(SEQ, NP, F.G, (int)blockIdx.x);
            pg8::EpiBf16Plain E{(pg8::bf16_t*)(F.ws + WS_PROJ), NP};
            pg8::gemm_phase<pg8::EpiBf16Plain, pg8::StaticOrder>(F.lds, g, S, E, nullptr);
        }
        SEAM(pb + 0);
        for (int rep = 0; rep < NREP(3); ++rep) if (PHON(3) && IN(pb + 1)) { if (rep) xcd_barrier(bar); F.refresh(); phase_postproj(F, l); }
        SEAM(pb + 1);
        for (int rep = 0; rep < NREP(4); ++rep) if (PHON(4) && IN(pb + 2)) { if (rep) xcd_barrier(bar); F.refresh(); phase_attention(F, l, rep); }
        SEAM(pb + 2);
        for (int rep = 0; rep < NREP(5); ++rep) if (PHON(5) && IN(pb + 3)) { if (rep) xcd_barrier(bar); F.refresh(); phase_moba_items(F, l, rep); }
        SEAM(pb + 3);
        for (int rep = 0; rep < NREP(6); ++rep) if (PHON(6) && IN(pb + 4)) { if (rep) xcd_barrier(bar); F.refresh(); phase_moba_combine(F); }
        SEAM(pb + 4);
        for (int rep = 0; rep < NREP(7); ++rep) if (PHON(7) && IN(pb + 5)) { if (rep) xcd_barrier(bar);
            pg8::Gemm g{(const pg8::bf16_t*)(F.ws + WS_O), (const pg8::bf16_t*)(F.ws + WS_WOT) + (size_t)l * DM * DM, SEQ, DM, DM};
            pg8::StaticOrder S; S.init(SEQ, DM, F.G, (int)blockIdx.x);
            EpiGateRes E{(l == 0) ? F.in(I_X) : (const float*)(F.ws + WS_XC), (float*)(F.ws + WS_X1), mod + 2 * DM};
            pg8::gemm_phase<EpiGateRes, pg8::StaticOrder>(F.lds, g, S, E, nullptr);
        }
        SEAM(pb + 5);
        for (int rep = 0; rep < NREP(8); ++rep) if (PHON(8) && IN(pb + 6)) { if (rep) xcd_barrier(bar); F.refresh(); phase_router(F, l); }
        SEAM(pb + 6);
#ifndef GATHER8_PHASE
#define GATHER8_PHASE 0
#endif
        for (int rep = 0; rep < NREP(9); ++rep) if (UP_FP8 && GATHER8_PHASE && PHON(9) && IN(pb + 7)) { if (rep) xcd_barrier(bar); F.refresh(); phase_gather8(F, l); }
        if (UP_FP8 && GATHER8_PHASE) SEAM(pb + 7);
#ifndef FUSE_UPDOWN
#define FUSE_UPDOWN 0
#endif
        for (int rep = 0; rep < NREP(10); ++rep) if (PHON(10) && IN(pb + 8)) { if (rep) xcd_barrier(bar);
            F.refresh(); build_expert_tables(F, l);
            const LAS int* ltile = (const LAS int*)(F.lds + ETAB_OFF);
            unsigned* ycnt = F.ctl + CW_YCNT + 32768 * l + 16384 * rep;
            {
            pg8::Gemm g{(const pg8::bf16_t*)(F.ws + (UP_FP8 ? (GATHER8_PHASE ? WS_XS : WS_H8) : WS_H)), (const pg8::bf16_t*)(F.ws + WS_WE1 + (size_t)l * NEXP * 2048 * DM * (UP_FP8 ? 1 : 2)), (UP_FP8 && GATHER8_PHASE) ? MAXROWS : SEQ, NEXP * 2048, DM};
            GroupedOrder S{ltile, ltile[511], 8, F.G, (int)blockIdx.x, ltile + 512, ltile + 544, (const int*)(F.ws + WS_INV), ycnt, FUSE_UPDOWN ? 1 : 0, F.ctl};
            typedef EpiSwigluT<(FUSE_UPDOWN != 0)> EpiSwiglu; EpiSwiglu E{(bf16_t*)(F.ws + WS_Y1), F.in(I_EB1) + (size_t)l * NEXP * 2048};
            pg8::gemm_phase<EpiSwiglu, GroupedOrder, false, !(UP_FP8 && GATHER8_PHASE), UP_FP8 ? 1 : 2>(F.lds, g, S, E, nullptr);
            }
            if (FUSE_UPDOWN) {
            unsigned ldsb = (unsigned)(size_t)F.lds, tb = (unsigned)(size_t)ltile; unsigned long long yc = (unsigned long long)ycnt;
            asm volatile("" : "+s"(ldsb), "+s"(tb), "+s"(yc));
            LAS unsigned char* lds2 = (LAS unsigned char*)(size_t)ldsb; const LAS int* ltile2 = (const LAS int*)(size_t)tb; unsigned* ycnt2 = (unsigned*)yc;
            pg8::Gemm g{(const pg8::bf16_t*)(F.ws + WS_Y1), (const pg8::bf16_t*)(F.ws + WS_WE2 + (size_t)l * NEXP * DM * FEXP * (MOE_FP8 ? 1 : 2)), MAXROWS, NEXP * DM, FEXP};
            GroupedOrder S{ltile2, ltile2[511], 4, F.G, F.G - 1 - (int)blockIdx.x, ltile2 + 512, ltile2 + 544, nullptr, ycnt2, 2, F.ctl};
            EpiDown E{(bf16_t*)(F.ws + WS_Y2), F.in(I_EB2) + (size_t)l * NEXP * DM};
            pg8::gemm_phase<EpiDown, GroupedOrder, false, false, MOE_FP8 ? 1 : 2>(lds2, g, S, E, nullptr);
            }
        }
        SEAM(pb + 8);
        for (int rep = 0; rep < NREP(11); ++rep) if (!FUSE_UPDOWN && PHON(11) && IN(pb + 9)) { if (rep) xcd_barrier(bar);
            F.refresh(); build_expert_tables(F, l);
            const LAS int* ltile = (const LAS int*)(F.lds + ETAB_OFF);
            pg8::Gemm g{(const pg8::bf16_t*)(F.ws + WS_Y1), (const pg8::bf16_t*)(F.ws + WS_WE2 + (size_t)l * NEXP * DM * FEXP * (MOE_FP8 ? 1 : 2)), MAXROWS, NEXP * DM, FEXP};
            GroupedOrder S{ltile, ltile[511], 4, F.G, (int)blockIdx.x, ltile + 512, ltile + 544, nullptr, nullptr, 0, F.ctl};
            EpiDown E{(bf16_t*)(F.ws + WS_Y2), F.in(I_EB2) + (size_t)l * NEXP * DM};
            pg8::gemm_phase<EpiDown, GroupedOrder, false, false, MOE_FP8 ? 1 : 2>(F.lds, g, S, E, nullptr);
        }
        if (!FUSE_UPDOWN)
        SEAM(pb + 9);
        for (int rep = 0; rep < NREP(12); ++rep) if (PHON(12) && IN(pb + 10)) { if (rep) xcd_barrier(bar); F.refresh(); phase_combine(F, l); }
        SEAM(pb + 10);
    }
#undef IN
#undef SEAM
}

#ifndef MK_PER_PHASE
#define MK_PER_PHASE 0
#endif
extern "C" void kernel_launch(void* const* d_in, const int* in_sizes, int n_in, void* d_out, int out_size, void* d_ws, size_t ws_size, hipStream_t stream) {
    static int grid = 0;
    if (grid == 0) {
        if (n_in != 27 || out_size != SEQ * DM || ws_size < WS_END) { fprintf(stderr, "kernel_launch: unexpected shapes (n_in %d, out %d, ws %zu)\n", n_in, out_size, ws_size); grid = -1; return; }
        int dev = 0, cus = 0, per_cu = 0;
        if (hipGetDevice(&dev) != hipSuccess || hipDeviceGetAttribute(&cus, hipDeviceAttributeMultiprocessorCount, dev) != hipSuccess) { grid = -1; return; }
        if (hipFuncSetAttribute((const void*)mk_fwd, hipFuncAttributeMaxDynamicSharedMemorySize, LDS_BYTES) != hipSuccess) { fprintf(stderr, "kernel_launch: hipFuncSetAttribute failed\n"); grid = -1; return; }
        if (hipOccupancyMaxActiveBlocksPerMultiprocessor(&per_cu, (const void*)mk_fwd, NTHREADS, LDS_BYTES) != hipSuccess || per_cu < 1) fprintf(stderr, "kernel_launch: occupancy query reports %d\n", per_cu);
        (void)hipGetLastError();
        grid = cus - (cus % 8);
    }
    if (grid < 0) return;
    (void)in_sizes;
    if (hipMemsetAsync((char*)d_ws + WS_CTL, 0, CTL_ZERO_BYTES, stream) != hipSuccess) return;
    Args a{};
    for (int i = 0; i < 27; ++i) a.in[i] = (const float*)d_in[i];
    a.out = (float*)d_out; a.ws = (unsigned char*)d_ws;
#if MK_PER_PHASE
    for (int p = 0; p < N_PHASES; ++p) { a.ph_lo = p; a.ph_hi = p + 1; hipLaunchKernelGGL(mk_fwd, dim3(grid), dim3(NTHREADS), LDS_BYTES, stream, a); }
#else
    a.ph_lo = 0; a.ph_hi = N_PHASES;
    hipLaunchKernelGGL(mk_fwd, dim3(grid), dim3(NTHREADS), LDS_BYTES, stream, a);
#endif
}
```

```cpp
#include <hip/hip_runtime.h>
#include <stdint.h>
#include <math.h>
#include <cstdio>
#include <type_traits>

#define DI __device__ __forceinline__
#define LAS __attribute__((address_space(3)))
#define GAS __attribute__((address_space(1)))
namespace pg8 {
#define PG8_LAS __attribute__((address_space(3)))
typedef unsigned short bf16_t;
typedef short bf16x8 __attribute__((ext_vector_type(8)));
typedef float f32x4 __attribute__((ext_vector_type(4)));
typedef unsigned u32x4 __attribute__((ext_vector_type(4)));
constexpr int BM = 256, BK = 64, HALF = 128, HTB = HALF * BK * 2  , STAGE_BYTES = 8 * HTB, NXCD = 8, WGM = 8;

__host__ __device__ __forceinline__ int lds_byte(int r, int c) { const int st = (r >> 4) * 2 + (c >> 5), rr = r & 15, cc = c & 31, ob = rr * 64 + cc * 2; return st * 1024 + (ob ^ (((ob >> 9) & 1) << 5)); }
__host__ __device__ __forceinline__ void stage_rc(int b, int& R, int& C) { const int st = b / 1024, sb = b % 1024, swz = sb ^ (((sb >> 9) & 1) << 5); R = (st >> 1) * 16 + swz / 64; C = (st & 1) * 32 + (swz % 64) / 2; }
__host__ __device__ __forceinline__ int perm32(int rho) { const int n = rho >> 4, i = rho & 15; return 8 * (i >> 2) + 4 * n + (i & 3); }

struct Unit { int pm, pn; };
struct Gemm { const bf16_t* A; const bf16_t* Bt; int M, N, K; };

struct StaticOrder {
    int nM, nN, nwg, G, c;
    __host__ __device__ void init(int M, int N, int G_, int c_) { nM = M / BM; nN = N / BM; nwg = nM * nN; G = G_; c = c_; }
    __host__ __device__ bool next(int i, Unit& u) const {
        const long L = (long)i * G + c; if (L >= nwg) return false;
        int wgid = (int)L; { const int q = nwg / NXCD, r = nwg % NXCD, xcd = wgid % NXCD, off = wgid / NXCD; wgid = (xcd < r ? xcd * (q + 1) : r * (q + 1) + (xcd - r) * q) + off; }
        const int nig = WGM * nN, gid = wgid / nig, fm = gid * WGM, gsz = (nM - fm) < WGM ? (nM - fm) : WGM;
        u.pm = fm + ((wgid % nig) % gsz); u.pn = (wgid % nig) / gsz; return true;
    }
    __device__ __forceinline__ void a_ready(const Unit&) const {}
    __device__ __forceinline__ void done(const Unit&) const {}
};
__device__ __forceinline__ unsigned cvt_pk_bf16(float lo, float hi) { unsigned r; asm volatile("v_cvt_pk_bf16_f32 %0, %1, %2" : "=v"(r) : "v"(lo), "v"(hi)); return r; }
typedef float f32x2 __attribute__((ext_vector_type(2)));
struct EpiBf16Plain {
    static constexpr bool PERM = true, AFTER_DRAIN = false;
    bf16_t* O; int ldc;
    __device__ __forceinline__ void operator()(const f32x4 (&acc)[2][2][4][2], const Unit& u, int wr, int wc, int fr, int fq) const {
        const int row0 = u.pm * BM + wr * 64 + fr, col0 = u.pn * BM + wc * 32 + 8 * fq;
#pragma unroll
        for (int ai = 0; ai < 2; ++ai)
#pragma unroll
            for (int m = 0; m < 4; ++m) { bf16_t* rowp = O + (size_t)(row0 + ai * HALF + m * 16) * ldc + col0;
#pragma unroll
                for (int bj = 0; bj < 2; ++bj) { const f32x4 v0 = acc[ai][bj][m][0], v1 = acc[ai][bj][m][1];
                    u32x4 w; w.x = cvt_pk_bf16(v0[0], v0[1]); w.y = cvt_pk_bf16(v0[2], v0[3]); w.z = cvt_pk_bf16(v1[0], v1[1]); w.w = cvt_pk_bf16(v1[2], v1[3]);
                    *(u32x4*)(rowp + bj * HALF) = w; } }
    }
};
template <class Epi, class Sched, bool STAMP = false, bool GATHER = false, int ESZ = 2>
__device__ __forceinline__ void gemm_phase(PG8_LAS unsigned char* lds, const Gemm g, const Sched& S, const Epi& E, unsigned long long* stamps) {
    int tid_ = threadIdx.x; asm volatile("" : "+v"(tid_));
    const int tid = tid_, wid = __builtin_amdgcn_readfirstlane(tid >> 6), lane = tid & 63, wr = wid >> 2, wc = wid & 3, fr = lane & 15, fq = lane >> 4;
    const int K = g.K, Kb = K * ESZ  , nt = Kb / (BK * 2);
    int ts_lo = 0, ts_hi = 0, nts = 0; const unsigned long long rt_entry = STAMP ? (unsigned long long)wall_clock64() : 0ull;
#define PG8_STAMP() do { if (STAMP && wid == 0 && nts < 64) { const unsigned long long _c = (unsigned long long)clock64(); \
        ts_lo = (lane == nts) ? (int)(unsigned)_c : ts_lo; ts_hi = (lane == nts) ? (int)(unsigned)(_c >> 32) : ts_hi; ++nts; } } while (0)
    PG8_STAMP();
    unsigned voffA[2], voffB[2];
    int gaR[2]; unsigned gaC2[2];
#pragma unroll
    for (int i = 0; i < 2; ++i) { int R, C; stage_rc(tid * 16 + i * 8192, R, C); const int Rb = Epi::PERM ? ((R & ~31) + perm32(R & 31)) : R;
        voffA[i] = (unsigned)(R * Kb + C * 2); voffB[i] = (unsigned)(Rb * Kb + C * 2); gaR[i] = R; gaC2[i] = (unsigned)C * 2u; }
    unsigned gaCur[2][2], gaNxt[2][2];
#define PG8_GAFILL(dst, u_) do { _Pragma("unroll") for (int h_ = 0; h_ < 2; ++h_) _Pragma("unroll") for (int i_ = 0; i_ < 2; ++i_) dst[h_][i_] = (unsigned)S.arow(u_, h_ * HALF + gaR[i_]) * (unsigned)Kb + gaC2[i_]; } while (0)
#define PG8_STAGE_A(bufoff, kb_, h_, nx_) do { if constexpr (GATHER) { _Pragma("unroll") for (int _i = 0; _i < 2; ++_i) \
        __builtin_amdgcn_global_load_lds((const unsigned*)((const char*)g.A + (kb_) + ((nx_) ? gaNxt[h_][_i] : gaCur[h_][_i])), (PG8_LAS unsigned*)(lds + (bufoff) + ldsw + _i * 8192), 16, 0, 0); } \
        else { PG8_STAGE(bufoff, ((nx_) ? nA : cA) + (kb_) + (h_) * hstep, voffA); } } while (0)
    const size_t kstep = (size_t)(BK * 2);
    const size_t hstep = (size_t)HALF * Kb;
    const size_t tstep = 2 * hstep;
    const unsigned ldsw = (unsigned)wid * 1024u;
    constexpr int KOFF = (ESZ == 2) ? 1024 : 16;
    int mxscale = 0x7F7F7F7F; asm volatile("" : "+v"(mxscale));
    const int aoff = lds_byte(wr * 64 + fr, ESZ == 2 ? fq * 8 : fq * 16), boff = lds_byte(wc * 32 + fr, ESZ == 2 ? fq * 8 : fq * 16);
#define PG8_SA(b, h) (((b) * 2 + (h)) * HTB)
#define PG8_SB(b, h) ((4 + (b) * 2 + (h)) * HTB)
#define PG8_STAGE(bufoff, gbase, voff) do { _Pragma("unroll") for (int _i = 0; _i < 2; ++_i) \
        __builtin_amdgcn_global_load_lds((const unsigned*)((const char*)(gbase) + (voff)[_i]), (PG8_LAS unsigned*)(lds + (bufoff) + ldsw + _i * 8192), 16, 0, 0); } while (0)
#define PG8_LDA(dst, b, h) do { _Pragma("unroll") for (int m = 0; m < 4; ++m) _Pragma("unroll") for (int k = 0; k < 2; ++k) dst[m][k] = *(const PG8_LAS bf16x8*)(lds + PG8_SA(b, h) + aoff + m * 2048 + k * KOFF); } while (0)
#define PG8_LDB(dst, b, h) do { _Pragma("unroll") for (int n = 0; n < 2; ++n) _Pragma("unroll") for (int k = 0; k < 2; ++k) dst[n][k] = *(const PG8_LAS bf16x8*)(lds + PG8_SB(b, h) + boff + n * 2048 + k * KOFF); } while (0)
#define PG8_MMA(ai, bj, At, Bt) do { __builtin_amdgcn_s_setprio(1); _Pragma("unroll") for (int m = 0; m < 4; ++m) _Pragma("unroll") for (int n = 0; n < 2; ++n) { \
        if constexpr (ESZ == 2) { _Pragma("unroll") for (int k = 0; k < 2; ++k) acc[ai][bj][m][n] = __builtin_amdgcn_mfma_f32_16x16x32_bf16(Bt[n][k], At[m][k], acc[ai][bj][m][n], 0, 0, 0); } \
        else { typedef int i32x4_ __attribute__((ext_vector_type(4))); typedef int i32x8_ __attribute__((ext_vector_type(8))); \
            const i32x8_ b8_ = __builtin_shufflevector(__builtin_bit_cast(i32x4_, Bt[n][0]), __builtin_bit_cast(i32x4_, Bt[n][1]), 0, 1, 2, 3, 4, 5, 6, 7); \
            const i32x8_ a8_ = __builtin_shufflevector(__builtin_bit_cast(i32x4_, At[m][0]), __builtin_bit_cast(i32x4_, At[m][1]), 0, 1, 2, 3, 4, 5, 6, 7); \
            asm volatile("v_mfma_scale_f32_16x16x128_f8f6f4 %0, %1, %2, %0, %3, %3 op_sel_hi:[0,0,0]" : "+v"(acc[ai][bj][m][n]) : "v"(b8_), "v"(a8_), "v"(mxscale)); } } \
        __builtin_amdgcn_s_setprio(0); } while (0)
#define PG8_WAIT_V(n) asm volatile("s_waitcnt vmcnt(" #n ")" ::: "memory")
#define PG8_WAIT_L(n) asm volatile("s_waitcnt lgkmcnt(" #n ")" ::: "memory")
#define PG8_BAR __builtin_amdgcn_s_barrier()
#define PG8_SCHED __builtin_amdgcn_sched_barrier(0)
    Unit cur, nxt; int ui = 0;
    if (!S.next(0, cur)) return;
    f32x4 acc[2][2][4][2];
#pragma unroll
    for (int a = 0; a < 2; ++a)
#pragma unroll
        for (int b = 0; b < 2; ++b)
#pragma unroll
            for (int m = 0; m < 4; ++m)
#pragma unroll
                for (int n = 0; n < 2; ++n) acc[a][b][m][n] = (f32x4){0.f, 0.f, 0.f, 0.f};
    bf16x8 At[4][2], B0[2][2], B1[2][2];
    const char* cA = (const char*)g.A + (size_t)cur.pm * tstep; const char* cB = (const char*)g.Bt + (size_t)cur.pn * tstep;
    S.a_ready(cur);
    const char* nA = cA; if constexpr (GATHER) { PG8_GAFILL(gaCur, cur); _Pragma("unroll") for (int h_ = 0; h_ < 2; ++h_) _Pragma("unroll") for (int i_ = 0; i_ < 2; ++i_) gaNxt[h_][i_] = gaCur[h_][i_]; }
    PG8_STAGE(PG8_SB(0, 0), cB, voffB); PG8_STAGE_A(PG8_SA(0, 0), 0, 0, false); PG8_STAGE(PG8_SB(0, 1), cB + hstep, voffB); PG8_STAGE_A(PG8_SA(0, 1), 0, 1, false);
    if (wr == 1) PG8_BAR;
    PG8_WAIT_V(4); PG8_BAR;
    PG8_STAGE(PG8_SB(1, 0), cB + kstep, voffB); PG8_STAGE_A(PG8_SA(1, 0), kstep, 0, false); PG8_STAGE(PG8_SB(1, 1), cB + hstep + kstep, voffB);
    PG8_WAIT_V(6); PG8_BAR;
    PG8_STAMP();
    for (;;) {
        const bool has_next = S.next(ui + 1, nxt);
        nA = has_next ? (const char*)g.A + (size_t)nxt.pm * tstep : cA; const char* nB = has_next ? (const char*)g.Bt + (size_t)nxt.pn * tstep : cB;
        if constexpr (GATHER) { if (has_next && ui == 0) PG8_GAFILL(gaNxt, nxt); }
        for (int t = 0; t < nt; t += 2) {
            const bool last = (t == nt - 2);
            const size_t ka1 = (size_t)(t + 1) * kstep;
            const size_t ka2 = last ? 0 : (size_t)(t + 2) * kstep; const char* b2 = last ? nB : cB + (size_t)(t + 2) * kstep;
            const size_t ka3 = ka2 + kstep; const char* b3 = b2 + kstep;
            const bool nxa = last && has_next;
            if (last && has_next) S.a_ready(nxt);
            PG8_LDB(B0, 0, 0); PG8_SCHED; PG8_LDA(At, 0, 0); PG8_STAGE_A(PG8_SA(1, 1), ka1, 1, false);
            PG8_WAIT_L(8); PG8_BAR; PG8_WAIT_L(0); PG8_MMA(0, 0, At, B0); PG8_BAR; PG8_SCHED;
            PG8_LDB(B1, 0, 1); PG8_STAGE(PG8_SB(0, 0), b2, voffB);
            PG8_BAR; PG8_WAIT_L(0); PG8_MMA(0, 1, At, B1); PG8_BAR;
            PG8_LDA(At, 0, 1); PG8_STAGE_A(PG8_SA(0, 0), ka2, 0, nxa);
            PG8_BAR; PG8_WAIT_L(0); PG8_MMA(1, 0, At, B0); PG8_BAR; PG8_SCHED;
            PG8_STAGE(PG8_SB(0, 1), b2 + hstep, voffB);
            PG8_WAIT_V(6); PG8_BAR; PG8_MMA(1, 1, At, B1); PG8_BAR;
            PG8_LDB(B0, 1, 0); PG8_SCHED; PG8_LDA(At, 1, 0); PG8_STAGE_A(PG8_SA(0, 1), ka2, 1, nxa);
            PG8_WAIT_L(8); PG8_BAR; PG8_WAIT_L(0); PG8_MMA(0, 0, At, B0); PG8_BAR; PG8_SCHED;
            PG8_LDB(B1, 1, 1); PG8_STAGE(PG8_SB(1, 0), b3, voffB);
            PG8_BAR; PG8_WAIT_L(0); PG8_MMA(0, 1, At, B1); PG8_BAR;
            PG8_LDA(At, 1, 1); PG8_STAGE_A(PG8_SA(1, 0), ka3, 0, nxa);
            PG8_BAR; PG8_WAIT_L(0); PG8_MMA(1, 0, At, B0); PG8_BAR; PG8_SCHED;
            PG8_STAGE(PG8_SB(1, 1), b3 + hstep, voffB);
            PG8_WAIT_V(6); PG8_BAR; PG8_MMA(1, 1, At, B1); PG8_BAR;
        }
        PG8_STAMP();
        if constexpr (GATHER) { Unit n2_; if (has_next && S.next(ui + 2, n2_)) PG8_GAFILL(gaCur, n2_); }
        if constexpr (ESZ == 1) asm volatile("s_nop 15\n\ts_nop 15\n\ts_nop 7" ::: "memory");
        if constexpr (!Epi::AFTER_DRAIN) { E(acc, cur, wr, wc, fr, fq); S.done(cur); }
        PG8_STAMP();
        if (!has_next) break;
#pragma unroll
        for (int a = 0; a < 2; ++a)
#pragma unroll
            for (int b = 0; b < 2; ++b)
#pragma unroll
                for (int m = 0; m < 4; ++m)
#pragma unroll
                    for (int n = 0; n < 2; ++n) acc[a][b][m][n] = (f32x4){0.f, 0.f, 0.f, 0.f};
        cur = nxt; cA = nA; cB = nB; ++ui;
        if constexpr (GATHER) { _Pragma("unroll") for (int h_ = 0; h_ < 2; ++h_) _Pragma("unroll") for (int i_ = 0; i_ < 2; ++i_) { const unsigned t_ = gaCur[h_][i_]; gaCur[h_][i_] = gaNxt[h_][i_]; gaNxt[h_][i_] = t_; } }
    }
    PG8_WAIT_V(0);
    if (wr == 0) PG8_BAR;
    PG8_BAR;
    if constexpr (Epi::AFTER_DRAIN) { E.fused(acc, cur, wr, wc, fr, fq, lds, wid, lane); S.done(cur); }
    PG8_STAMP();
    if (STAMP && wid == 0) { stamps[lane] = lane < nts ? (((unsigned long long)(unsigned)ts_hi << 32) | (unsigned)ts_lo) : 0ull;
        if (lane == 62) stamps[62] = rt_entry; if (lane == 63) stamps[63] = (unsigned long long)wall_clock64(); }
#undef PG8_STAMP
#undef PG8_SA
#undef PG8_SB
#undef PG8_STAGE
#undef PG8_STAGE_A
#undef PG8_GAFILL
#undef PG8_LDA
#undef PG8_LDB
#undef PG8_MMA
#undef PG8_WAIT_V
#undef PG8_WAIT_L
#undef PG8_BAR
#undef PG8_SCHED
}
}

#define XB_TMO      128
#define XB_XCNT(j)  (256  + 64 * (j))
#define XB_XSUB(j)  (1280 + 64 * (j))
#define XB_XGEN(j)  (2304 + 64 * (j))
#define XB_TOP      3328
#define XB_TOPGEN   3392
#define XCD_BAR_WORDS 3456
#define XB_SPIN_CAP (1u << 24)
#define LAS __attribute__((address_space(3)))

__device__ __forceinline__ unsigned xb_ld(unsigned* p)              { return __hip_atomic_load(p, __ATOMIC_RELAXED, __HIP_MEMORY_SCOPE_AGENT); }
__device__ __forceinline__ unsigned xb_add(unsigned* p, unsigned v) { return __hip_atomic_fetch_add(p, v, __ATOMIC_RELAXED, __HIP_MEMORY_SCOPE_AGENT); }
__device__ __forceinline__ unsigned xb_xcc_id() { return (unsigned)__builtin_amdgcn_s_getreg((3 << 11) | 20) & 0xFu; }
#define XB_SPIN(cond, bar) do { unsigned _sp = 0; while (cond) { __builtin_amdgcn_s_sleep(1); \
    if ((++_sp & 255u) == 0u) { if (xb_ld(&(bar)[XB_TMO])) break; if (_sp > XB_SPIN_CAP) { atomicAdd(&(bar)[XB_TMO], 1u); break; } } } } while (0)

struct XcdBarrier {
    unsigned* bar; unsigned x;
    volatile LAS unsigned* st;
};

__device__ __forceinline__ XcdBarrier xcd_barrier_post(unsigned* bar, volatile LAS unsigned* st) {
    XcdBarrier b; b.bar = bar; b.x = xb_xcc_id(); b.st = st;
    if (threadIdx.x == 0) (void)xb_add(&bar[XB_XCNT(b.x)], 1u);
    return b;
}
__device__ __forceinline__ void xcd_barrier_complete(unsigned* bar, unsigned x, unsigned& nloc, unsigned& nx) {
    const unsigned G = gridDim.x * gridDim.y * gridDim.z;
    unsigned sum, cnt, mine, sp = 0u;
    for (;;) {
        sum = 0u; cnt = 0u; mine = 0u;
#pragma unroll
        for (unsigned j = 0; j < 16; ++j) { const unsigned c = xb_ld(&bar[XB_XCNT(j)]); sum += c; cnt += (c > 0u) ? 1u : 0u; mine = (j == x) ? c : mine; }
        if (sum == G) break;
        __builtin_amdgcn_s_sleep(1);
        if ((++sp & 255u) == 0u) { if (xb_ld(&bar[XB_TMO])) break; if (sp > XB_SPIN_CAP) { atomicAdd(&bar[XB_TMO], 1u); break; } }
    }
    nloc = mine > 0u ? mine : 1u; nx = cnt > 0u ? cnt : 1u;
}

__device__ __forceinline__ void xcd_barrier(const XcdBarrier& b) {
    asm volatile("s_waitcnt vmcnt(0)" ::: "memory");
    __syncthreads();
    if (threadIdx.x == 0) {
        unsigned* bar = b.bar;
        __builtin_amdgcn_s_waitcnt(0);
        unsigned nloc = b.st[0], nx = b.st[1];
        if (nloc == 0u) { xcd_barrier_complete(bar, b.x, nloc, nx); b.st[0] = nloc; b.st[1] = nx; }
        const unsigned old = xb_add(&bar[XB_XSUB(b.x)], 1u);
        const unsigned gen = old / nloc;
        if (old + 1u == (gen + 1u) * nloc) {
            __builtin_amdgcn_fence(__ATOMIC_RELEASE, "agent");
            asm volatile("s_waitcnt vmcnt(0)" ::: "memory");
            const unsigned og = xb_add(&bar[XB_TOP], 1u);
            const unsigned tg = og / nx;
            if (og + 1u == (tg + 1u) * nx) xb_add(&bar[XB_TOPGEN], 1u);
            else XB_SPIN(xb_ld(&bar[XB_TOPGEN]) == tg, bar);
            __builtin_amdgcn_fence(__ATOMIC_ACQUIRE, "agent");
            xb_add(&bar[XB_XGEN(b.x)], 1u);
            asm volatile("s_waitcnt vmcnt(0)" ::: "memory");
        } else {
            XB_SPIN(xb_ld(&bar[XB_XGEN(b.x)]) == gen, bar);
            __builtin_amdgcn_fence(__ATOMIC_ACQUIRE, "agent");
            asm volatile("s_waitcnt vmcnt(0)" ::: "memory");
        }
    }
    __syncthreads();
}

typedef unsigned short bf16_t;
typedef short bf16x8 __attribute__((ext_vector_type(8)));
typedef float f32x4 __attribute__((ext_vector_type(4)));
typedef float f32x16 __attribute__((ext_vector_type(16)));
typedef unsigned u32x4 __attribute__((ext_vector_type(4)));
typedef unsigned u32x2 __attribute__((ext_vector_type(2)));
typedef float f32x2_t __attribute__((ext_vector_type(2)));
typedef __bf16 bf16x2_t __attribute__((ext_vector_type(2)));

constexpr int SEQ = 16384, DM = 1024, NLAYER = 2;
constexpr int IN_COLS = 2724, NP = 2816;
constexpr int NEXP = 32, TOPK = 4, FEXP = 1024;
constexpr int MAXROWS = SEQ * TOPK + NEXP * 256;
constexpr int NWAVES = 8, NTHREADS = 512;
constexpr float EPS = 1e-6f;
constexpr float LOG2E = 1.4426950408889634f;
constexpr float QSCALE64 = 0.125f * LOG2E;
constexpr float QSCALE96 = 0.10206207261596577f * LOG2E;

constexpr int PC_CQ = 0, PC_CKV = 256, PC_KR = 384, PC_FLOG = 416, PC_FQ = 448, PC_FK = 704, PC_FV = 960, PC_MQ = 1216, PC_MK = 1472, PC_MV = 1728, PC_DQ = 1984, PC_DK = 2240, PC_DV = 2496;

constexpr size_t MiB = 1u << 20;
constexpr size_t WS_CTL = 0, CTL_ZERO_BYTES = 1 * MiB;
constexpr size_t WS_META = 1 * MiB;
constexpr size_t WS_W1T = 2 * MiB;
constexpr size_t WS_WOT = 14 * MiB;
constexpr size_t WS_WUQ = 18 * MiB;
constexpr size_t WS_WUKV = 19 * MiB;
constexpr size_t WS_WE1 = 32 * MiB;
constexpr size_t WS_WE2 = 288 * MiB;
constexpr size_t WS_H = 416 * MiB;
constexpr size_t WS_PROJ = 448 * MiB;
constexpr size_t WS_QA = 536 * MiB, WS_KA = 548 * MiB, WS_VAT = 560 * MiB;
constexpr size_t WS_QB = 568 * MiB, WS_KB = 576 * MiB, WS_VBT = 584 * MiB;
constexpr size_t WS_QC = 592 * MiB, WS_KC = 600 * MiB, WS_VCT = 608 * MiB;
constexpr size_t WS_QD = 616 * MiB, WS_KD = 624 * MiB, WS_VDT = 632 * MiB;
constexpr size_t WS_FLOC = 640 * MiB;
constexpr size_t WS_FTILE = 640 * MiB + 256 * 1024;
constexpr size_t WS_KSUM = 640 * MiB + 512 * 1024;
constexpr size_t WS_O = 642 * MiB;
constexpr size_t WS_X1 = 674 * MiB;
constexpr size_t WS_XC = 738 * MiB;
constexpr size_t WS_XS = 802 * MiB;
constexpr size_t WS_Y1 = 946 * MiB;
constexpr size_t WS_Y2 = 1090 * MiB;
constexpr size_t WS_TOKI = 1234 * MiB;
constexpr size_t WS_BLIST = 1236 * MiB;
constexpr size_t WS_PM = 1252 * MiB;
constexpr size_t WS_PO = 1254 * MiB;
constexpr size_t WS_DM = 1286 * MiB;
constexpr size_t WS_DO = 1288 * MiB;
constexpr size_t WS_INV = 1320 * MiB;
constexpr size_t WS_H8 = 1322 * MiB;
constexpr size_t WS_END = 1340 * MiB;
constexpr size_t META_MOD = 0;
constexpr size_t META_OFF = 64 * 1024;
constexpr size_t META_TILE = 68 * 1024;
constexpr int CW_BAR = 4096;
constexpr int CW_QUEUE = 8192;
constexpr int CW_ECNT = 12288;
constexpr int CW_BCNT = 16384;
constexpr int CW_MQ = 20480;
constexpr int CW_YCNT = 24576;

constexpr int GEN_BYTES = 139264;
constexpr int LDSCTL_OFF = GEN_BYTES;
constexpr int LDS_BYTES = GEN_BYTES + 1024;

DI float bf2f(bf16_t b) { return __uint_as_float(((unsigned)b) << 16); }
DI unsigned pk2(float lo, float hi) { f32x2_t v = {lo, hi}; bf16x2_t b = __builtin_convertvector(v, bf16x2_t); return __builtin_bit_cast(unsigned, b); }
DI bf16_t f2bf(float f) { return (bf16_t)(pk2(f, 0.f) & 0xffffu); }
DI float wave_sum(float v) {
#pragma unroll
    for (int o = 1; o < 64; o <<= 1) v += __shfl_xor(v, o);
    return v;
}
DI float wave_max(float v) {
#pragma unroll
    for (int o = 1; o < 64; o <<= 1) v = fmaxf(v, __shfl_xor(v, o));
    return v;
}
DI void unpack8(const bf16x8 r, float (&x)[8]) {
#pragma unroll
    for (int i = 0; i < 8; ++i) x[i] = bf2f((bf16_t)r[i]);
}
DI u32x4 pack8(const float (&y)[8]) { u32x4 w; w.x = pk2(y[0], y[1]); w.y = pk2(y[2], y[3]); w.z = pk2(y[4], y[5]); w.w = pk2(y[6], y[7]); return w; }
#ifndef UP_FP8
#define UP_FP8 1
#endif
#ifndef MOE_FP8
#define MOE_FP8 1
#endif
constexpr float WSCALE = 32.0f, WINV = 1.0f / 32.0f;
DI unsigned pk4_fp8(float a, float b, float c, float d) { int w = 0; w = __builtin_amdgcn_cvt_pk_fp8_f32(a, b, w, false); w = __builtin_amdgcn_cvt_pk_fp8_f32(c, d, w, true); return (unsigned)w; }
DI int crow(int r, int hi) { return (r & 3) + 8 * (r >> 2) + 4 * hi; }
DI float max_x32(float v) { const auto rr = __builtin_amdgcn_permlane32_swap(__float_as_uint(v), __float_as_uint(v), false, false); return fmaxf(__uint_as_float(rr[0]), __uint_as_float(rr[1])); }
DI float sum_x32(float v) { const auto rr = __builtin_amdgcn_permlane32_swap(__float_as_uint(v), __float_as_uint(v), false, false); return __uint_as_float(rr[0]) + __uint_as_float(rr[1]); }
#define MFMA32(a, b, c) __builtin_amdgcn_mfma_f32_32x32x16_bf16((a), (b), (c), 0, 0, 0)

struct Args { const float* in[27]; float* out; unsigned char* ws; int ph_lo, ph_hi; };
typedef const __attribute__((address_space(4))) Args* KArgP;
struct Frame {
    LAS unsigned char* lds;
    unsigned char* ws;
    unsigned* ctl;
    KArgP ap;
    int tid, lane, wave, G;
    DI const float* in(int i) const { return ap->in[i]; }
    DI void refresh() { int t = threadIdx.x; asm volatile("" : "+v"(t)); tid = t; lane = t & 63; wave = __builtin_amdgcn_readfirstlane(t >> 6); }
};
enum { I_X = 0, I_C, I_WMOD, I_BMOD, I_N1G, I_N2G, I_WIN, I_CQG, I_WUQ, I_CKVG, I_WUKV, I_MQG, I_MKG, I_FQG, I_FKG, I_FBF, I_MOQG, I_MOKG, I_DQG, I_DKG, I_WOUT, I_RW, I_RB, I_EW1, I_EB1, I_EW2, I_EB2 };

DI int map_win(int n) {
    if (n < 416) return n;
    if (n < 420) return 1184 + (n - 416);
    if (n < 448) return -1;
    if (n < 1216) return n - 32;
    if (n < 2752) return n - 28;
    return -1;
}
DI int map_w1(int n) { return ((n >> 7) & 1) * 1024 + (n >> 8) * 128 + (n & 127); }
template <int MAP> DI void transpose_item(const float* W, int K, int Nsrc, bf16_t* WT, int k0, int n0, LAS float* scr, int lane) {
    const int nn = n0 + (lane & 31);
    const int ns = (MAP == 0) ? nn : (MAP == 1 ? map_win(nn) : map_w1(nn));
    float v[32];
#pragma unroll
    for (int i = 0; i < 32; ++i) { const int kk = 2 * i + (lane >> 5); v[i] = (ns >= 0) ? W[(size_t)(k0 + kk) * Nsrc + ns] : 0.f; }
#pragma unroll
    for (int i = 0; i < 32; ++i) { const int kk = 2 * i + (lane >> 5); scr[kk * 33 + (lane & 31)] = v[i]; }
    asm volatile("s_waitcnt lgkmcnt(0)" ::: "memory");
    const int c = lane & 7;
#pragma unroll
    for (int j = 0; j < 4; ++j) { const int n = (lane >> 3) + 8 * j; const LAS float* s = scr + (8 * c) * 33 + n;
        u32x4 o; o.x = pk2(s[0 * 33], s[1 * 33]); o.y = pk2(s[2 * 33], s[3 * 33]); o.z = pk2(s[4 * 33], s[5 * 33]); o.w = pk2(s[6 * 33], s[7 * 33]);
        *(u32x4*)(WT + (size_t)(n0 + n) * K + k0 + 8 * c) = o; }
    asm volatile("s_waitcnt lgkmcnt(0)" ::: "memory");
}
DI void norm_mod_store(const f32x4 (&v)[4], const float* g, const float* sc, const float* sh, bf16_t* hrow, int lane) {
    float ss = 0.f;
#pragma unroll
    for (int j = 0; j < 4; ++j) ss += (v[j].x * v[j].x + v[j].y * v[j].y) + (v[j].z * v[j].z + v[j].w * v[j].w);
    ss = wave_sum(ss);
    const float rstd = 1.0f / sqrtf(ss * (1.0f / DM) + EPS);
#pragma unroll
    for (int j = 0; j < 4; ++j) {
        const int c = 4 * lane + 256 * j;
        const f32x4 g4 = *(const f32x4*)(g + c), s4 = *(const f32x4*)(sc + c), h4 = *(const f32x4*)(sh + c);
        const f32x4 y = (v[j] * rstd) * g4 * (s4 + 1.0f) + h4;
        u32x2 w; w.x = pk2(y.x, y.y); w.y = pk2(y.z, y.w);
        *(u32x2*)(hrow + c) = w;
    }
}
#ifndef BG_CONVERT
#define BG_CONVERT 1
#endif
DI void phase_prologue(Frame& F) {
    const int tid = F.tid, lane = F.lane, wave = F.wave;
    float* mod = (float*)(F.ws + WS_META + META_MOD);
    if (blockIdx.x < 192) {
        LAS float* scv = (LAS float*)F.lds;
        LAS float* part = (LAS float*)(F.lds + 4096);
        for (int i = tid; i < DM; i += NTHREADS) { const float cv = F.in(I_C)[i]; scv[i] = cv / (1.0f + __expf(-cv)); }
        __syncthreads();
        const int l = blockIdx.x / 96, col = (blockIdx.x % 96) * 64 + lane;
        const float* wm = F.in(I_WMOD) + (size_t)l * DM * 6144 + col;
        float acc = 0.f;
#pragma unroll 8
        for (int k = wave * 128; k < wave * 128 + 128; ++k) acc += scv[k] * wm[(size_t)k * 6144];
        part[wave * 64 + lane] = acc;
        __syncthreads();
        if (wave == 0) { float s = 0.f;
#pragma unroll
            for (int w = 0; w < 8; ++w) s += part[w * 64 + lane];
            mod[l * 6144 + col] = s + F.in(I_BMOD)[l * 6144 + col]; }
        __syncthreads();
    }
    {
        LAS float* scr = (LAS float*)(F.lds + 8192 + wave * 8704);
        const int gw = blockIdx.x * NWAVES + wave, NGW = F.G * NWAVES;
        constexpr int T_E1 = 32 * 16 * 64, T_E2 = 32 * 16 * 32, T_W1 = 16 * 88, T_WO = 16 * 32, T_UQ = 4 * 12, T_UKV = 2 * 16;
        constexpr int T_LAYER = T_E1 + T_E2 + T_W1 + T_WO + T_UQ + T_UKV;
        for (int it = gw; it < NLAYER * T_LAYER; it += NGW) {
            const int l = it / T_LAYER; int r = it % T_LAYER;
            if (BG_CONVERT && r < T_E1 + T_E2) continue;
            if (r < T_E1) { const int e = r / (16 * 64), q = r % (16 * 64), kb = q / 64, nb = q % 64;
                transpose_item<2>(F.in(I_EW1) + ((size_t)l * NEXP + e) * DM * 2048, DM, 2048, (bf16_t*)(F.ws + WS_WE1) + ((size_t)l * NEXP + e) * 2048 * DM, 64 * kb, 32 * nb, scr, lane); continue; }
            r -= T_E1;
            if (r < T_E2) { const int e = r / (16 * 32), q = r % (16 * 32), kb = q / 32, nb = q % 32;
                transpose_item<0>(F.in(I_EW2) + ((size_t)l * NEXP + e) * FEXP * DM, FEXP, DM, (bf16_t*)(F.ws + WS_WE2) + ((size_t)l * NEXP + e) * DM * FEXP, 64 * kb, 32 * nb, scr, lane); continue; }
            r -= T_E2;
            if (r < T_W1) { const int kb = r / 88, nb = r % 88;
                transpose_item<1>(F.in(I_WIN) + (size_t)l * DM * IN_COLS, DM, IN_COLS, (bf16_t*)(F.ws + WS_W1T) + (size_t)l * NP * DM, 64 * kb, 32 * nb, scr, lane); continue; }
            r -= T_W1;
            if (r < T_WO) { const int kb = r / 32, nb = r % 32;
                transpose_item<0>(F.in(I_WOUT) + (size_t)l * DM * DM, DM, DM, (bf16_t*)(F.ws + WS_WOT) + (size_t)l * DM * DM, 64 * kb, 32 * nb, scr, lane); continue; }
            r -= T_WO;
            if (r < T_UQ) { const int kb = r / 12, nb = r % 12;
                transpose_item<0>(F.in(I_WUQ) + (size_t)l * 256 * 384, 256, 384, (bf16_t*)(F.ws + WS_WUQ) + (size_t)l * 384 * 256, 64 * kb, 32 * nb, scr, lane); continue; }
            r -= T_UQ;
            { const int kb = r / 16, nb = r % 16;
                transpose_item<0>(F.in(I_WUKV) + (size_t)l * 128 * 512, 128, 512, (bf16_t*)(F.ws + WS_WUKV) + (size_t)l * 512 * 128, 64 * kb, 32 * nb, scr, lane); }
        }
    }
}
DI void phase_norm1_l0(Frame& F) {
    const float* mod = (const float*)(F.ws + WS_META + META_MOD);
    const int gw = blockIdx.x * NWAVES + F.wave, NGW = F.G * NWAVES;
    for (int m = gw; m < SEQ; m += 2 * NGW) {
        const int m2 = m + NGW;
        const f32x4* xr = (const f32x4*)(F.in(I_X) + (size_t)m * DM) + F.lane;
        const f32x4* xr2 = (const f32x4*)(F.in(I_X) + (size_t)(m2 < SEQ ? m2 : m) * DM) + F.lane;
        f32x4 v[4], w[4];
#pragma unroll
        for (int j = 0; j < 4; ++j) { v[j] = xr[64 * j]; w[j] = xr2[64 * j]; }
        norm_mod_store(v, F.in(I_N1G), mod + 1 * DM  , mod + 0 * DM  , (bf16_t*)(F.ws + WS_H) + (size_t)m * DM, F.lane);
        if (m2 < SEQ) norm_mod_store(w, F.in(I_N1G), mod + 1 * DM, mod + 0 * DM, (bf16_t*)(F.ws + WS_H) + (size_t)m2 * DM, F.lane);
    }
}

constexpr double rope_rev(int j) {
    return j == 0 ? 0.15915494309189535 : j == 1 ? 0.08949940160889101 : j == 2 ? 0.050329212104487035 : j == 3 ? 0.0283021958306234 : j == 4 ? 0.015915494309189534 :
           j == 5 ? 0.008949940160889102 : j == 6 ? 0.005032921210448704 : j == 7 ? 0.00283021958306234 : j == 8 ? 0.0015915494309189536 : j == 9 ? 0.0008949940160889102 :
           j == 10 ? 0.0005032921210448703 : j == 11 ? 0.00028302195830623395 : j == 12 ? 0.00015915494309189535 : j == 13 ? 8.949940160889102e-05 : j == 14 ? 5.0329212104487035e-05 : 2.8302195830623396e-05;
}
template <int JB> DI void rope_cs(int t, int hi, float& sn, float& cs) {
    const double c = hi ? rope_rev(JB + 4) : rope_rev(JB);
    const double rev = (double)t * c;
    const float fr = (float)(rev - __builtin_rint(rev));
    sn = __builtin_amdgcn_sinf(fr); cs = __builtin_amdgcn_cosf(fr);
}
DI void phase_postproj(Frame& F, int l) {
    const int tid0 = F.tid, wave = F.wave;
    const bf16_t* proj = (const bf16_t*)(F.ws + WS_PROJ);
    LAS bf16_t* KCl = (LAS bf16_t*)(F.lds);
    LAS bf16_t* AQ = (LAS bf16_t*)(F.lds + 32768);
    LAS bf16_t* AKV = (LAS bf16_t*)(F.lds + 32768 + 33792);
    LAS float* G6 = (LAS float*)(F.lds + 106496);
    LAS float* GCQ = G6 + 384; LAS float* GCKV = GCQ + 256; LAS float* GMQ = GCKV + 128; LAS float* GMK = GMQ + 96;
    for (int i = tid0; i < 960; i += NTHREADS) {
        float v;
        if (i < 384) { const int typ = i >> 6; v = F.in(typ == 0 ? I_FQG : typ == 1 ? I_FKG : typ == 2 ? I_MOQG : typ == 3 ? I_MOKG : typ == 4 ? I_DQG : I_DKG)[l * 64 + (i & 63)]; }
        else if (i < 640) v = F.in(I_CQG)[l * 256 + (i - 384)];
        else if (i < 768) v = F.in(I_CKVG)[l * 128 + (i - 640)];
        else if (i < 864) v = F.in(I_MQG)[l * 96 + (i - 768)];
        else v = F.in(I_MKG)[l * 96 + (i - 864)];
        G6[i] = v;
    }
    __syncthreads();
    for (int tile = blockIdx.x; tile < SEQ / 64; tile += F.G) {
        const int t0 = tile * 64;
        int tid_ = tid0; asm volatile("" : "+v"(tid_));
        const int tid = tid_, lane = tid & 63;
        const int sub = tid & 7, vslot = tid >> 3;
        bf16x8 rawA[24];
#define PP_LOADA(base_) do { _Pragma("unroll") for (int j = 0; j < 24; ++j) { const int it = (base_) + j, typ = it >> 2, hh = it & 3;       \
            const int cb = (typ == 0 ? PC_FQ : typ == 1 ? PC_FK : typ == 2 ? PC_MQ : typ == 3 ? PC_MK : typ == 4 ? PC_DQ : PC_DK) + 64 * hh; \
            rawA[j] = *(const bf16x8*)(proj + (size_t)(t0 + vslot) * NP + 8 * sub + cb); } } while (0)
        PP_LOADA(0);
        bf16x8 vr[2][8];
#pragma unroll
        for (int rnd = 0; rnd < 2; ++rnd) { const int pi = wave + 8 * rnd, mixer = pi >> 2, hh = pi & 3;
            const bf16_t* rp = proj + (size_t)(t0 + lane) * NP + ((pi < 12) ? (mixer == 0 ? PC_FV : mixer == 1 ? PC_MV : PC_DV) + 64 * hh : PC_FV);
#pragma unroll
            for (int i = 0; i < 8; ++i) vr[rnd][i] = *(const bf16x8*)(rp + 8 * i); }
        bf16x8 rawQ[4], rawKV[2];
#pragma unroll
        for (int it = 0; it < 4; ++it) { const int tok = it * 16 + wave * 2 + (lane >> 5); rawQ[it] = *(const bf16x8*)(proj + (size_t)(t0 + tok) * NP + PC_CQ + 8 * (lane & 31)); }
#pragma unroll
        for (int it = 0; it < 2; ++it) { const int tok = it * 32 + wave * 4 + (lane >> 4); rawKV[it] = *(const bf16x8*)(proj + (size_t)(t0 + tok) * NP + PC_CKV + 8 * (lane & 15)); }
        u32x2 krw[4];
        { const int tg = wave & 1, r32 = lane & 31, hi = lane >> 5, t = t0 + 32 * tg + r32;
#pragma unroll
          for (int g4 = 0; g4 < 4; ++g4) krw[g4] = *(const u32x2*)(proj + (size_t)t * NP + PC_KR + 8 * g4 + 4 * hi); }
        const float zraw = bf2f(proj[(size_t)(t0 + lane) * NP + PC_FLOG + (wave & 3)]), fbias = F.in(I_FBF)[l * 4 + (wave & 3)];
#pragma unroll
        for (int half = 0; half < 1; ++half) {
#pragma unroll
            for (int j = 0; j < 24; ++j) {
                const int it = j, tok = vslot, typ = it >> 2, hh = it & 3;
                float x[8]; unpack8(rawA[j], x);
                float ss = 0.f;
#pragma unroll
                for (int i = 0; i < 8; ++i) ss += x[i] * x[i];
                ss += __shfl_xor(ss, 1); ss += __shfl_xor(ss, 2); ss += __shfl_xor(ss, 4);
                const float rstd = 1.0f / sqrtf(ss * (1.0f / 64.0f) + EPS);
                const LAS float* gp = G6 + typ * 64 + 8 * sub;
                const float qs = ((typ & 1) == 0) ? QSCALE64 : 1.0f;
                const f32x4 g0 = *(const LAS f32x4*)gp, g1 = *(const LAS f32x4*)(gp + 4);
                float y[8];
#pragma unroll
                for (int i = 0; i < 4; ++i) { y[i] = x[i] * rstd * g0[i] * qs; y[4 + i] = x[4 + i] * rstd * g1[i] * qs; }
                const u32x4 w = pack8(y);
                const size_t dsto = (typ == 0 ? WS_QB : typ == 1 ? WS_KB : typ == 2 ? WS_QC : typ == 3 ? WS_KC : typ == 4 ? WS_QD : WS_KD);
                *(u32x4*)((bf16_t*)(F.ws + dsto) + ((size_t)hh * SEQ + t0 + tok) * 64 + 8 * sub) = w;
                if (typ == 3) *(LAS u32x4*)(KCl + (hh * 64 + tok) * 64 + 8 * sub) = w;
            }
        }
#undef PP_LOADA
        __syncthreads();
        if (wave < 4) { float s = 0.f;
            for (int tok = 0; tok < 64; ++tok) s += bf2f(KCl[(wave * 64 + tok) * 64 + lane]);
            ((float*)(F.ws + WS_KSUM))[((size_t)wave * 256 + tile) * 64 + lane] = s; }
        {
#pragma unroll
            for (int rnd = 0; rnd < 2; ++rnd) {
                const int pi = wave + 8 * rnd, mixer = pi >> 2, hh = pi & 3;
                LAS bf16_t* vt = (LAS bf16_t*)(F.lds + 32768 + wave * 9216);
                if (pi < 12) {
#pragma unroll
                    for (int i = 0; i < 8; ++i) {
#pragma unroll
                        for (int e = 0; e < 8; ++e) vt[(8 * i + e) * 72 + lane] = (bf16_t)vr[rnd][i][e]; }
                }
                __syncthreads();
                if (pi < 12) {
                    bf16_t* dst = (bf16_t*)(F.ws + (mixer == 0 ? WS_VBT : mixer == 1 ? WS_VCT : WS_VDT)) + (size_t)hh * 64 * SEQ;
#pragma unroll
                    for (int ps = 0; ps < 8; ++ps) { const int d = 8 * ps + (lane >> 3), c = lane & 7;
                        const u32x4 val = *(const LAS u32x4*)(vt + d * 72 + 8 * c);
                        *(u32x4*)(dst + (size_t)d * SEQ + t0 + 8 * c) = val; }
                }
                __syncthreads();
            }
        }
#pragma unroll
        for (int it = 0; it < 4; ++it) {
            const int tok = it * 16 + wave * 2 + (lane >> 5), sub32 = lane & 31;
            float x[8]; unpack8(rawQ[it], x);
            float ss = 0.f;
#pragma unroll
            for (int i = 0; i < 8; ++i) ss += x[i] * x[i];
            ss += __shfl_xor(ss, 1); ss += __shfl_xor(ss, 2); ss += __shfl_xor(ss, 4); ss += __shfl_xor(ss, 8); ss += __shfl_xor(ss, 16);
            const float rstd = 1.0f / sqrtf(ss * (1.0f / 256.0f) + EPS);
            const LAS float* gp = GCQ + 8 * sub32;
            const f32x4 g0 = *(const LAS f32x4*)gp, g1 = *(const LAS f32x4*)(gp + 4);
            float y[8];
#pragma unroll
            for (int i = 0; i < 4; ++i) { y[i] = x[i] * rstd * g0[i]; y[4 + i] = x[4 + i] * rstd * g1[i]; }
            *(LAS u32x4*)(AQ + tok * 264 + 8 * sub32) = pack8(y);
        }
#pragma unroll
        for (int it = 0; it < 2; ++it) {
            const int tok = it * 32 + wave * 4 + (lane >> 4), sub16 = lane & 15;
            float x[8]; unpack8(rawKV[it], x);
            float ss = 0.f;
#pragma unroll
            for (int i = 0; i < 8; ++i) ss += x[i] * x[i];
            ss += __shfl_xor(ss, 1); ss += __shfl_xor(ss, 2); ss += __shfl_xor(ss, 4); ss += __shfl_xor(ss, 8);
            const float rstd = 1.0f / sqrtf(ss * (1.0f / 128.0f) + EPS);
            const LAS float* gp = GCKV + 8 * sub16;
            const f32x4 g0 = *(const LAS f32x4*)gp, g1 = *(const LAS f32x4*)(gp + 4);
            float y[8];
#pragma unroll
            for (int i = 0; i < 4; ++i) { y[i] = x[i] * rstd * g0[i]; y[4 + i] = x[4 + i] * rstd * g1[i]; }
            *(LAS u32x4*)(AKV + tok * 136 + 8 * sub16) = pack8(y);
        }
        __syncthreads();
        {
            const int tg = wave & 1, hh = wave >> 1, r32 = lane & 31, hi = lane >> 5, t = t0 + 32 * tg + r32;
            {
                f32x16 acc[3];
#pragma unroll
                for (int i = 0; i < 3; ++i)
#pragma unroll
                    for (int r = 0; r < 16; ++r) acc[i][r] = 0.f;
                const bf16_t* wq = (const bf16_t*)(F.ws + WS_WUQ) + (size_t)l * 384 * 256 + (size_t)(96 * hh + r32) * 256 + 8 * hi;
                const LAS bf16_t* aq = AQ + (32 * tg + r32) * 264 + 8 * hi;
#pragma unroll 8
                for (int ks = 0; ks < 16; ++ks) {
                    const bf16x8 b = *(const LAS bf16x8*)(aq + 16 * ks);
#pragma unroll
                    for (int i = 0; i < 3; ++i) { const bf16x8 a = *(const bf16x8*)(wq + (size_t)i * 32 * 256 + 16 * ks); acc[i] = MFMA32(a, b, acc[i]); }
                }
                float ss = 0.f;
#pragma unroll
                for (int i = 0; i < 3; ++i)
#pragma unroll
                    for (int r = 0; r < 16; ++r) ss += acc[i][r] * acc[i][r];
                ss += __shfl_xor(ss, 32);
                const float rstd = 1.0f / sqrtf(ss * (1.0f / 96.0f) + EPS);
                const LAS float* gq = GMQ;
#pragma unroll
                for (int i = 0; i < 3; ++i)
#pragma unroll
                    for (int g4 = 0; g4 < 4; ++g4) { const f32x4 gv = *(const LAS f32x4*)(gq + 32 * i + 8 * g4 + 4 * hi);
#pragma unroll
                        for (int e = 0; e < 4; ++e) acc[i][4 * g4 + e] *= rstd * gv[e]; }
#define ROPE_Q(r) { float sn, cs; rope_cs<((r) & 3) + 8 * ((r) >> 2)>(t, hi, sn, cs); const float x1 = acc[2][r], x2 = acc[2][(r) + 8]; acc[2][r] = x1 * cs - x2 * sn; acc[2][(r) + 8] = x2 * cs + x1 * sn; }
                ROPE_Q(0) ROPE_Q(1) ROPE_Q(2) ROPE_Q(3) ROPE_Q(4) ROPE_Q(5) ROPE_Q(6) ROPE_Q(7)
#undef ROPE_Q
                bf16_t* qd = (bf16_t*)(F.ws + WS_QA) + ((size_t)hh * SEQ + t) * 96 + 4 * hi;
#pragma unroll
                for (int i = 0; i < 3; ++i)
#pragma unroll
                    for (int g4 = 0; g4 < 4; ++g4) { u32x2 w; w.x = pk2(acc[i][4 * g4] * QSCALE96, acc[i][4 * g4 + 1] * QSCALE96); w.y = pk2(acc[i][4 * g4 + 2] * QSCALE96, acc[i][4 * g4 + 3] * QSCALE96);
                        *(u32x2*)(qd + 32 * i + 8 * g4) = w; }
            }
            {
                f32x16 acc[4];
#pragma unroll
                for (int i = 0; i < 4; ++i)
#pragma unroll
                    for (int r = 0; r < 16; ++r) acc[i][r] = 0.f;
                const bf16_t* wkv = (const bf16_t*)(F.ws + WS_WUKV) + (size_t)l * 512 * 128 + (size_t)(128 * hh + r32) * 128 + 8 * hi;
                const LAS bf16_t* akv = AKV + (32 * tg + r32) * 136 + 8 * hi;
#pragma unroll 4
                for (int ks = 0; ks < 8; ++ks) {
                    const bf16x8 b = *(const LAS bf16x8*)(akv + 16 * ks);
#pragma unroll
                    for (int i = 0; i < 4; ++i) { const bf16x8 a = *(const bf16x8*)(wkv + (size_t)i * 32 * 128 + 16 * ks); acc[i] = MFMA32(a, b, acc[i]); }
                }
                float kr[16];
#pragma unroll
                for (int g4 = 0; g4 < 4; ++g4) { const u32x2 w = krw[g4];
                    kr[4 * g4 + 0] = bf2f((bf16_t)(w.x & 0xffffu)); kr[4 * g4 + 1] = bf2f((bf16_t)(w.x >> 16)); kr[4 * g4 + 2] = bf2f((bf16_t)(w.y & 0xffffu)); kr[4 * g4 + 3] = bf2f((bf16_t)(w.y >> 16)); }
                float ss = 0.f;
#pragma unroll
                for (int r = 0; r < 16; ++r) ss += acc[0][r] * acc[0][r] + acc[1][r] * acc[1][r] + kr[r] * kr[r];
                ss += __shfl_xor(ss, 32);
                const float rstd = 1.0f / sqrtf(ss * (1.0f / 96.0f) + EPS);
                const LAS float* gk = GMK;
                bf16_t* kd = (bf16_t*)(F.ws + WS_KA) + ((size_t)hh * SEQ + t) * 96 + 4 * hi;
#pragma unroll
                for (int i = 0; i < 2; ++i)
#pragma unroll
                    for (int g4 = 0; g4 < 4; ++g4) { const f32x4 gv = *(const LAS f32x4*)(gk + 32 * i + 8 * g4 + 4 * hi);
                        u32x2 w; w.x = pk2(acc[i][4 * g4] * rstd * gv[0], acc[i][4 * g4 + 1] * rstd * gv[1]); w.y = pk2(acc[i][4 * g4 + 2] * rstd * gv[2], acc[i][4 * g4 + 3] * rstd * gv[3]);
                        *(u32x2*)(kd + 32 * i + 8 * g4) = w; }
#pragma unroll
                for (int g4 = 0; g4 < 4; ++g4) { const f32x4 gv = *(const LAS f32x4*)(gk + 64 + 8 * g4 + 4 * hi);
#pragma unroll
                    for (int e = 0; e < 4; ++e) kr[4 * g4 + e] *= rstd * gv[e]; }
#define ROPE_K(r) { float sn, cs; rope_cs<((r) & 3) + 8 * ((r) >> 2)>(t, hi, sn, cs); const float x1 = kr[r], x2 = kr[(r) + 8]; kr[r] = x1 * cs - x2 * sn; kr[(r) + 8] = x2 * cs + x1 * sn; }
                ROPE_K(0) ROPE_K(1) ROPE_K(2) ROPE_K(3) ROPE_K(4) ROPE_K(5) ROPE_K(6) ROPE_K(7)
#undef ROPE_K
#pragma unroll
                for (int g4 = 0; g4 < 4; ++g4) { u32x2 w; w.x = pk2(kr[4 * g4], kr[4 * g4 + 1]); w.y = pk2(kr[4 * g4 + 2], kr[4 * g4 + 3]); *(u32x2*)(kd + 64 + 8 * g4) = w; }
                bf16_t* vd = (bf16_t*)(F.ws + WS_VAT) + (size_t)hh * 64 * SEQ + t;
#pragma unroll
                for (int i = 2; i < 4; ++i)
#pragma unroll
                    for (int r = 0; r < 16; ++r) vd[(size_t)(32 * (i - 2) + crow(r, hi)) * SEQ] = f2bf(acc[i][r]);
            }
        }
        if (wave < 4) {
            const int hh = wave;
            const float z = zraw + fbias;
            float sc = (fminf(z, 0.f) - log1pf(expf(-fabsf(z)))) * LOG2E;
#pragma unroll
            for (int d = 1; d < 64; d <<= 1) { const float o = __shfl_up(sc, d); if (lane >= d) sc += o; }
            ((float*)(F.ws + WS_FLOC))[(size_t)hh * SEQ + t0 + lane] = -sc;
            if (lane == 63) ((float*)(F.ws + WS_FTILE))[hh * 256 + tile] = sc;
        }
        __syncthreads();
    }
}

DI int swap23(int x) { return (x & ~12) | ((x & 4) << 1) | ((x & 8) >> 1); }
struct AttnShared { const LAS float* kmean; const LAS float* fpre; float fox_cut; };
DI void fox_unit(Frame& F, const AttnShared& A, int hh, int qt) {
    int tid_ = threadIdx.x; asm volatile("" : "+v"(tid_));
    const int lane = tid_ & 63, r32 = lane & 31, hi = lane >> 5, t = 32 * qt + r32;
    const float* nfloc = (const float*)(F.ws + WS_FLOC) + (size_t)hh * SEQ;
    const unsigned char* Kbase = (const unsigned char*)((const bf16_t*)(F.ws + WS_KB) + (size_t)hh * SEQ * 64);
    const unsigned char* Vbase = (const unsigned char*)((const bf16_t*)(F.ws + WS_VBT) + (size_t)hh * 64 * SEQ);
    const unsigned kofs = (unsigned)(swap23(r32) * 64 + 8 * hi) * 2u, vofs = (unsigned)(r32 * SEQ + 8 * hi) * 2u, cofs = 32u * (unsigned)hi;
    bf16x8 qf[4];
    { const bf16_t* Qp = (const bf16_t*)(F.ws + WS_QB) + ((size_t)hh * SEQ + t) * 64 + 8 * hi;
#pragma unroll
      for (int ks = 0; ks < 4; ++ks) qf[ks] = *(const bf16x8*)(Qp + 16 * ks); }
    const float Fq = A.fpre[hh * 256 + (t >> 6)] - nfloc[t];
    const float Ffirst = __builtin_bit_cast(float, __builtin_amdgcn_readfirstlane(__builtin_bit_cast(int, A.fpre[hh * 256 + ((32 * qt) >> 6)] - nfloc[32 * qt])));
    float m = 0.f, lsum = 0.f;
    f32x16 o0, o1;
#pragma unroll
    for (int r = 0; r < 16; ++r) { o0[r] = 0.f; o1[r] = 0.f; }
    bf16x8 kfA[4], vfA[4], kfB[4], vfB[4]; f32x16 cfA, cfB; float preA = 0.f, preB = 0.f;
#define FX_LOAD(kf, vf, cf, pre, kt_) do { \
        const GAS unsigned char* kb_ = (const GAS unsigned char*)(Kbase + (size_t)(kt_) * (32 * 64 * 2)); asm volatile("" : "+s"(kb_)); unsigned ko_ = kofs; asm volatile("" : "+v"(ko_)); \
        _Pragma("unroll") for (int ks = 0; ks < 4; ++ks) kf[ks] = *(const GAS bf16x8*)(kb_ + ko_ + 32 * ks); \
        const GAS unsigned char* v0_ = (const GAS unsigned char*)(Vbase + (size_t)(kt_) * 64); asm volatile("" : "+s"(v0_)); \
        const GAS unsigned char* v1_ = (const GAS unsigned char*)(Vbase + (size_t)(kt_) * 64 + (size_t)32 * SEQ * 2); asm volatile("" : "+s"(v1_)); unsigned vo_ = vofs; asm volatile("" : "+v"(vo_)); \
        vf[0] = *(const GAS bf16x8*)(v0_ + vo_); vf[1] = *(const GAS bf16x8*)(v0_ + vo_ + 32); vf[2] = *(const GAS bf16x8*)(v1_ + vo_); vf[3] = *(const GAS bf16x8*)(v1_ + vo_ + 32); \
        const GAS unsigned char* c_ = (const GAS unsigned char*)(nfloc + 32 * (kt_)); asm volatile("" : "+s"(c_)); unsigned co_ = cofs; asm volatile("" : "+v"(co_)); \
        { const f32x4 f0 = *(const GAS f32x4*)(c_ + co_), f1 = *(const GAS f32x4*)(c_ + co_ + 16), f2 = *(const GAS f32x4*)(c_ + co_ + 64), f3 = *(const GAS f32x4*)(c_ + co_ + 80); \
          _Pragma("unroll") for (int e = 0; e < 4; ++e) { cf[e] = f0[e]; cf[4 + e] = f1[e]; cf[8 + e] = f2[e]; cf[12 + e] = f3[e]; } } \
        pre = A.fpre[hh * 256 + ((kt_) >> 1)]; } while (0)
#define FX_NEXT(cf, pre, kt_) ({ int nk_ = (kt_) - 1; if (nk_ >= 0) { const float ff_ = __builtin_bit_cast(float, __builtin_amdgcn_readfirstlane(__builtin_bit_cast(int, pre - cf[0]))); \
        if (Ffirst - ff_ < -A.fox_cut) nk_ = -1; } nk_; })
    auto compute = [&](const bf16x8 (&kf)[4], const bf16x8 (&vf)[4], const f32x16& cf, const float pre, auto diagc) __attribute__((always_inline)) {
        f32x16 s = MFMA32(kf[0], qf[0], cf);
#pragma unroll
        for (int ks = 1; ks < 4; ++ks) s = MFMA32(kf[ks], qf[ks], s);
        if constexpr (decltype(diagc)::value) {
            const int d0 = r32 - 8 * hi;
#pragma unroll
            for (int i = 0; i < 16; ++i) if (d0 - (16 * (i >> 3) + (i & 7)) < 0) s[i] = -INFINITY;
        }
        float mj = m - (Fq - pre);
        float rm = fmaxf(s[0], s[1]);
#pragma unroll
        for (int i = 2; i < 16; ++i) rm = fmaxf(rm, s[i]);
        rm = max_x32(rm) - mj;
        if (__any(rm > 8.0f)) {
            const float dl = fmaxf(rm, 0.f), alpha = __builtin_amdgcn_exp2f(-dl);
            m += dl; mj += dl; lsum *= alpha;
#pragma unroll
            for (int r = 0; r < 16; ++r) { o0[r] *= alpha; o1[r] *= alpha; }
        }
        float p[16], psum = 0.f;
#pragma unroll
        for (int i = 0; i < 16; ++i) { p[i] = __builtin_amdgcn_exp2f(s[i] - mj); psum += p[i]; }
        lsum += psum;
        u32x4 w0, w1;
        w0.x = pk2(p[0], p[1]); w0.y = pk2(p[2], p[3]); w0.z = pk2(p[4], p[5]); w0.w = pk2(p[6], p[7]);
        w1.x = pk2(p[8], p[9]); w1.y = pk2(p[10], p[11]); w1.z = pk2(p[12], p[13]); w1.w = pk2(p[14], p[15]);
        const bf16x8 pf0 = __builtin_bit_cast(bf16x8, w0), pf1 = __builtin_bit_cast(bf16x8, w1);
        o0 = MFMA32(vf[0], pf0, o0); o0 = MFMA32(vf[1], pf1, o0);
        o1 = MFMA32(vf[2], pf0, o1); o1 = MFMA32(vf[3], pf1, o1);
    };
    int kt = qt;
    FX_LOAD(kfA, vfA, cfA, preA, kt);
    {   int nk = FX_NEXT(cfA, preA, kt);
        if (nk >= 0) FX_LOAD(kfB, vfB, cfB, preB, nk);
        compute(kfA, vfA, cfA, preA, std::true_type{});
        kt = nk; }
    while (kt >= 0) {
        int nk = FX_NEXT(cfB, preB, kt);
        if (nk >= 0) FX_LOAD(kfA, vfA, cfA, preA, nk);
        compute(kfB, vfB, cfB, preB, std::false_type{});
        kt = nk; if (kt < 0) break;
        nk = FX_NEXT(cfA, preA, kt);
        if (nk >= 0) FX_LOAD(kfB, vfB, cfB, preB, nk);
        compute(kfA, vfA, cfA, preA, std::false_type{});
        kt = nk;
    }
#undef FX_LOAD
#undef FX_NEXT
    const float ltot = sum_x32(lsum), inv = 1.0f / ltot;
    bf16_t* od = (bf16_t*)(F.ws + WS_O) + (size_t)t * DM + (4 + hh) * 64 + 4 * hi;
#pragma unroll
    for (int g4 = 0; g4 < 4; ++g4) {
        u32x2 w; w.x = pk2(o0[4 * g4] * inv, o0[4 * g4 + 1] * inv); w.y = pk2(o0[4 * g4 + 2] * inv, o0[4 * g4 + 3] * inv); *(u32x2*)(od + 8 * g4) = w;
        u32x2 z; z.x = pk2(o1[4 * g4] * inv, o1[4 * g4 + 1] * inv); z.y = pk2(o1[4 * g4 + 2] * inv, o1[4 * g4 + 3] * inv); *(u32x2*)(od + 32 + 8 * g4) = z;
    }
}

constexpr int BG_ITEMS = 32 * 32 * 64 + 32 * 32 * 32;
constexpr int ATT_BGSCR_OFF = 98816;
static_assert(UP_FP8 && MOE_FP8, "the background engine writes fp8");
struct BgConv {
    int it, stride, l, itp;
    DI void init(int gw, int ngw, int layer) { it = gw; stride = ngw; l = layer; itp = -1; }
    DI void finish(Frame& F, int wave, int lane) {
        const int id = itp; if (id < 0) return;
        unsigned char* dst; int K;
        if (id < 65536) { const int e = id >> 11, q = id & 2047, kb = q >> 6, nb = q & 63; dst = F.ws + WS_WE1 + (((size_t)l * NEXP + e) * 2048 * DM + (size_t)(32 * nb) * DM + 32 * kb); K = DM; }
        else { const int r = id - 65536, e = r >> 10, q = r & 1023, kb = q >> 5, nb = q & 31; dst = F.ws + WS_WE2 + (((size_t)l * NEXP + e) * DM * FEXP + (size_t)(32 * nb) * FEXP + 32 * kb); K = FEXP; }
        const LAS float* sp = (const LAS float*)(F.lds + ATT_BGSCR_OFF + wave * 4096) + (lane >> 5) * 512 + (lane & 31);
        float v[16];
#pragma unroll
        for (int i = 0; i < 16; ++i) v[i] = sp[32 * i];
        u32x4 o; o.x = pk4_fp8(v[0] * WSCALE, v[1] * WSCALE, v[2] * WSCALE, v[3] * WSCALE); o.y = pk4_fp8(v[4] * WSCALE, v[5] * WSCALE, v[6] * WSCALE, v[7] * WSCALE);
        o.z = pk4_fp8(v[8] * WSCALE, v[9] * WSCALE, v[10] * WSCALE, v[11] * WSCALE); o.w = pk4_fp8(v[12] * WSCALE, v[13] * WSCALE, v[14] * WSCALE, v[15] * WSCALE);
        *(u32x4*)(dst + (size_t)(lane & 31) * K + 16 * (lane >> 5)) = o;
        itp = -1;
    }
    template <bool UNCOND> DI void request(Frame& F, int wave, int lane) {
        if (it >= BG_ITEMS) {
            if (UNCOND) { const GAS unsigned char* rb = (const GAS unsigned char*)F.in(I_EW1); LAS unsigned char* scr = F.lds + ATT_BGSCR_OFF + wave * 4096;
#pragma unroll
                for (int i = 0; i < 4; ++i) { asm volatile("" : "+s"(rb)); __builtin_amdgcn_global_load_lds((const GAS unsigned*)rb, (LAS unsigned*)(scr + 1024 * i), 16, 0, 0); } }
            return;
        }
        const float* W; int Nsrc, k0, n0; bool m2;
        if (it < 65536) { const int e = it >> 11, q = it & 2047, kb = q >> 6, nb = q & 63; W = F.in(I_EW1) + ((size_t)l * NEXP + e) * DM * 2048; Nsrc = 2048; k0 = 32 * kb; n0 = 32 * nb; m2 = true; }
        else { const int r = it - 65536, e = r >> 10, q = r & 1023, kb = q >> 5, nb = q & 31; W = F.in(I_EW2) + ((size_t)l * NEXP + e) * FEXP * DM; Nsrc = DM; k0 = 32 * kb; n0 = 32 * nb; m2 = false; }
        const int ns = m2 ? map_w1(n0) : n0;
        const unsigned char* rowb = (const unsigned char*)(W + (size_t)k0 * Nsrc + ns);
        const unsigned boff = (unsigned)((lane >> 3) * Nsrc + 4 * (lane & 7)) * 4u;
        LAS unsigned char* scr = F.lds + ATT_BGSCR_OFF + wave * 4096;
#pragma unroll
        for (int i = 0; i < 4; ++i) { const GAS unsigned char* rb = (const GAS unsigned char*)(rowb + (size_t)(32 * i) * Nsrc); asm volatile("" : "+s"(rb));
            __builtin_amdgcn_global_load_lds((const GAS unsigned*)(rb + boff), (LAS unsigned*)(scr + 1024 * i), 16, 0, 0); }
        itp = it; it += stride;
    }
    DI void drain(Frame& F, int wave, int lane) { asm volatile("s_waitcnt vmcnt(0)" ::: "memory"); finish(F, wave, lane); }
    DI void rest(Frame& F, int wave, int lane) {
        while (it < BG_ITEMS) { request<false>(F, wave, lane); asm volatile("s_waitcnt vmcnt(0)" ::: "memory"); finish(F, wave, lane); asm volatile("s_waitcnt lgkmcnt(0)" ::: "memory"); }
    }
};
constexpr int ATT_BUF_BYTES = 88064;
constexpr int ATT_FPRE_OFF = 90112, ATT_SELM_OFF = 94208, ATT_MISC_OFF = 96256;
#ifndef MLA_BG
#define MLA_BG 1
#endif
#ifndef MLA_SGB
#define MLA_SGB 1
#endif
#ifndef MLA_PRIO
#define MLA_PRIO 0
#endif
#ifndef MLA_TR
#define MLA_TR 3
#define MLA_VA 4
#endif
template <int VAR = 0> DI void mla_wg_unit(Frame& F, int hh, int qb, BgConv& bg) {
    constexpr int DQ = 96, NKS = DQ / 16, KCH = DQ / 8, KSTR = DQ + 8, VSTR = 136;
    constexpr int KBYTES = 128 * KSTR * 2, VBYTES = 64 * VSTR * 2, BUF = KBYTES + VBYTES, KPC = 128 * KCH / NTHREADS;
    static_assert(2 * BUF <= ATT_BUF_BYTES, "attention LDS map");
    static_assert(DQ * 2 == KCH * 16, "K rows are contiguous");
#define ML_BAR do { asm volatile("s_waitcnt lgkmcnt(0)" ::: "memory"); __builtin_amdgcn_s_barrier(); asm volatile("" ::: "memory"); } while (0)
    int tid_ = threadIdx.x; asm volatile("" : "+v"(tid_));
    const int tid = tid_, lane = tid & 63, wave = __builtin_amdgcn_readfirstlane(tid >> 6), r32 = lane & 31, hi = lane >> 5, qg = wave & 3, kh = wave >> 2;
    const int t = 128 * qb + 32 * qg + r32;
    const bf16_t* Kg = (const bf16_t*)(F.ws + WS_KA) + (size_t)hh * SEQ * DQ;
    const bf16_t* Vg = (const bf16_t*)(F.ws + WS_VAT) + (size_t)hh * 64 * SEQ;
    bf16x8 qf[NKS];
    { const bf16_t* Qp = (const bf16_t*)(F.ws + WS_QA) + ((size_t)hh * SEQ + t) * DQ + 8 * hi;
#pragma unroll
      for (int ks = 0; ks < NKS; ++ks) qf[ks] = *(const bf16x8*)(Qp + 16 * ks);
#pragma unroll
      for (int ks = 0; ks < NKS; ++ks) asm volatile("" :: "v"(qf[ks])); }
    float m = 0.f, lsum = 0.f;
    f32x16 o0, o1;
#pragma unroll
    for (int r = 0; r < 16; ++r) { o0[r] = 0.f; o1[r] = 0.f; }
    const int n = qb + 1;
    u32x4 sk[KPC], sv[2];
    const unsigned gk0 = (unsigned)((tid >> 2) * (DQ * 2) + (tid & 3) * 16), lk0 = (unsigned)((tid >> 2) * (KSTR * 2) + (tid & 3) * 16);
    const unsigned gv0 = (unsigned)((tid >> 4) * SEQ + 8 * (tid & 15)) * 2u, lv0 = (unsigned)(KBYTES + ((tid >> 4) * VSTR + 8 * (tid & 15)) * 2);
    static_assert(KPC == 3, "three K chunks per thread");
#define ML_LOADK(dst_, T_) do { const GAS unsigned char* kb_ = (const GAS unsigned char*)(Kg + (size_t)(128 * (T_)) * DQ); asm volatile("" : "+s"(kb_)); unsigned o_ = gk0; asm volatile("" : "+v"(o_)); \
            _Pragma("unroll") for (int j = 0; j < KPC; ++j) dst_[j] = *(const GAS u32x4*)(kb_ + o_ + 64 * j); } while (0)
#define ML_LOADV(T_) do { _Pragma("unroll") for (int j = 0; j < 2; ++j) { const GAS unsigned char* vb_ = (const GAS unsigned char*)(Vg + 128 * (T_) + (size_t)(32 * j) * SEQ); asm volatile("" : "+s"(vb_)); \
            unsigned o_ = gv0; asm volatile("" : "+v"(o_)); sv[j] = *(const GAS u32x4*)(vb_ + o_); } } while (0)
#define ML_STOREK(src_, b_) do { const unsigned a_ = (unsigned)(size_t)(F.lds + (b_) * BUF) + lk0; _Pragma("unroll") for (int j = 0; j < KPC; ++j) asm volatile("ds_write_b128 %0, %1 offset:%2" :: "v"(a_), "v"(src_[j]), "n"(64 * j) : "memory"); } while (0)
#define ML_STOREV(b_) do { const unsigned a_ = (unsigned)(size_t)(F.lds + (b_) * BUF) + lv0; _Pragma("unroll") for (int j = 0; j < 2; ++j) asm volatile("ds_write_b128 %0, %1 offset:%2" :: "v"(a_), "v"(sv[j]), "n"(32 * j * VSTR * 2) : "memory"); } while (0)
    { u32x4 sk1[KPC];
      ML_LOADK(sk, 0); ML_LOADV(0); if (n > 1) ML_LOADK(sk1, 1);
      ML_STOREK(sk, 0); ML_STOREV(0); if (n > 1) ML_STOREK(sk1, 1); }
    if (n > 2) ML_LOADK(sk, 2);
    if (n > 1) ML_LOADV(1);
    ML_BAR;
    auto qk = [&](const int b, f32x16& s0, f32x16& s1) __attribute__((always_inline)) {
        const LAS bf16_t* kp = (const LAS bf16_t*)(F.lds + b * BUF) + (64 * kh + swap23(r32)) * KSTR + 8 * hi;
        bf16x8 kf0[NKS], kf1[NKS];
#pragma unroll
        for (int ks = 0; ks < NKS; ++ks) { kf0[ks] = *(const LAS bf16x8*)(kp + 16 * ks); kf1[ks] = *(const LAS bf16x8*)(kp + 32 * KSTR + 16 * ks); }
        f32x16 zz;
#pragma unroll
        for (int r = 0; r < 16; ++r) zz[r] = 0.f;
        s0 = MFMA32(kf0[0], qf[0], zz); s1 = MFMA32(kf1[0], qf[0], zz);
#pragma unroll
        for (int ks = 1; ks < NKS; ++ks) { s0 = MFMA32(kf0[ks], qf[ks], s0); s1 = MFMA32(kf1[ks], qf[ks], s1); }
    };
    auto step = [&](const int i, f32x16& c0, f32x16& c1, f32x16& n0, f32x16& n1, auto hasnextc, auto lastc, auto bgc) __attribute__((always_inline)) {
        constexpr bool HASNEXT = decltype(hasnextc)::value, LAST = decltype(lastc)::value; constexpr int BGM = (BG_CONVERT && VAR == 0 && MLA_BG) ? decltype(bgc)::value : 0;
        if (i + 2 < n) ML_STOREK(sk, i & 1);
        if (i + 1 < n) ML_STOREV((i + 1) & 1);
        if (i + 3 < n) ML_LOADK(sk, (VAR == 5 ? 0 : i + 3));
        if (i + 2 < n) ML_LOADV((VAR == 5 ? 0 : i + 2));
        if constexpr (BGM == 1) bg.template request<true>(F, wave, lane);
        const LAS bf16_t* kp = (const LAS bf16_t*)(F.lds + ((i + 1) & 1) * BUF) + (64 * kh + swap23(r32)) * KSTR + 8 * hi;
        bf16x8 kf[2 * NKS];
        if constexpr (HASNEXT) { kf[0] = *(const LAS bf16x8*)(kp); kf[1] = *(const LAS bf16x8*)(kp + 32 * KSTR); kf[2] = *(const LAS bf16x8*)(kp + 16); }
        if constexpr (LAST) {
            const int d0 = t - (128 * qb + 64 * kh + 8 * hi);
#pragma unroll
            for (int r = 0; r < 16; ++r) { const int dd = d0 - (16 * (r >> 3) + (r & 7)); if (dd < 0) c0[r] = -INFINITY; if (dd - 32 < 0) c1[r] = -INFINITY; }
        }
        if (!__all(m == 0.f)) {
#pragma unroll
            for (int r = 0; r < 16; ++r) { c0[r] -= m; c1[r] -= m; }
        }
        float rm = fmaxf(c0[0], c1[0]);
#pragma unroll
        for (int r = 1; r < 16; ++r) rm = fmaxf(fmaxf(rm, c0[r]), c1[r]);
        rm = max_x32(rm);
        if (__any(rm > 8.0f)) {
            const float dl = fmaxf(rm, 0.f), alpha = __builtin_amdgcn_exp2f(-dl);
            m += dl; lsum *= alpha;
#pragma unroll
            for (int r = 0; r < 16; ++r) { c0[r] -= dl; c1[r] -= dl; o0[r] *= alpha; o1[r] *= alpha; }
        }
        if constexpr (HASNEXT) {
            kf[3] = *(const LAS bf16x8*)(kp + 32 * KSTR + 16);
#pragma unroll
            for (int ks = 2; ks < NKS; ++ks) { kf[2 * ks] = *(const LAS bf16x8*)(kp + 16 * ks); kf[2 * ks + 1] = *(const LAS bf16x8*)(kp + 32 * KSTR + 16 * ks); }
            f32x16 zz;
#pragma unroll
            for (int r = 0; r < 16; ++r) zz[r] = 0.f;
            n0 = MFMA32(kf[0], qf[0], zz); n1 = MFMA32(kf[1], qf[0], zz);
#pragma unroll
            for (int ks = 1; ks < NKS; ++ks) { n0 = MFMA32(kf[2 * ks], qf[ks], n0); n1 = MFMA32(kf[2 * ks + 1], qf[ks], n1); }
        }
        float psum = 0.f;
#pragma unroll
        for (int r = 0; r < 16; ++r) { c0[r] = __builtin_amdgcn_exp2f(c0[r]); psum += c0[r]; }
#pragma unroll
        for (int r = 0; r < 16; ++r) { c1[r] = __builtin_amdgcn_exp2f(c1[r]); psum += c1[r]; }
        lsum += psum;
        u32x4 w0, w1, w2, w3;
        w0.x = pk2(c0[0], c0[1]); w0.y = pk2(c0[2], c0[3]); w0.z = pk2(c0[4], c0[5]); w0.w = pk2(c0[6], c0[7]);
        w1.x = pk2(c0[8], c0[9]); w1.y = pk2(c0[10], c0[11]); w1.z = pk2(c0[12], c0[13]); w1.w = pk2(c0[14], c0[15]);
        w2.x = pk2(c1[0], c1[1]); w2.y = pk2(c1[2], c1[3]); w2.z = pk2(c1[4], c1[5]); w2.w = pk2(c1[6], c1[7]);
        w3.x = pk2(c1[8], c1[9]); w3.y = pk2(c1[10], c1[11]); w3.z = pk2(c1[12], c1[13]); w3.w = pk2(c1[14], c1[15]);
        const bf16x8 pf0 = __builtin_bit_cast(bf16x8, w0), pf1 = __builtin_bit_cast(bf16x8, w1), pf2 = __builtin_bit_cast(bf16x8, w2), pf3 = __builtin_bit_cast(bf16x8, w3);
        const LAS bf16_t* vp = (const LAS bf16_t*)(F.lds + (i & 1) * BUF + KBYTES) + r32 * VSTR + 64 * kh + 8 * hi;
        bf16x8 vf0[4], vf1[4];
        vf0[0] = *(const LAS bf16x8*)(vp); vf0[2] = *(const LAS bf16x8*)(vp + 32 * VSTR); vf0[1] = *(const LAS bf16x8*)(vp + 16); vf0[3] = *(const LAS bf16x8*)(vp + 32 * VSTR + 16);
        vf1[0] = *(const LAS bf16x8*)(vp + 32); vf1[2] = *(const LAS bf16x8*)(vp + 32 * VSTR + 32); vf1[1] = *(const LAS bf16x8*)(vp + 48); vf1[3] = *(const LAS bf16x8*)(vp + 32 * VSTR + 48);
        o0 = MFMA32(vf0[0], pf0, o0); o1 = MFMA32(vf0[2], pf0, o1);
        o0 = MFMA32(vf0[1], pf1, o0); o1 = MFMA32(vf0[3], pf1, o1);
        o0 = MFMA32(vf1[0], pf2, o0); o1 = MFMA32(vf1[2], pf2, o1);
        o0 = MFMA32(vf1[1], pf3, o0); o1 = MFMA32(vf1[3], pf3, o1);
#if MLA_SGB
        if constexpr (HASNEXT) {
#pragma unroll
            for (int k = 0; k < 12; ++k) { __builtin_amdgcn_sched_group_barrier(0x008, 1, 0); __builtin_amdgcn_sched_group_barrier(0x100, 1, 0);
                __builtin_amdgcn_sched_group_barrier(0x400, MLA_TR, 0); __builtin_amdgcn_sched_group_barrier(0x002, MLA_VA, 0); }
            __builtin_amdgcn_sched_group_barrier(0x400, 8, 0); __builtin_amdgcn_sched_group_barrier(0x002, 16, 0);
#pragma unroll
            for (int k = 0; k < 8; ++k) { __builtin_amdgcn_sched_group_barrier(0x008, 1, 0); __builtin_amdgcn_sched_group_barrier(0x100, 1, 0); }
        }
#endif
        if constexpr (BGM == 2) { asm volatile("s_waitcnt vmcnt(0)" ::: "memory"); bg.finish(F, wave, lane); }
        ML_BAR;
    };
    if (BG_CONVERT && VAR == 0 && MLA_BG) { if (bg.itp >= 0) bg.drain(F, wave, lane); }
#if MLA_PRIO
    if (kh == 1) __builtin_amdgcn_s_setprio(1);
#endif
    f32x16 sA0, sA1, sB0, sB1;
    qk(0, sA0, sA1);
    ML_BAR;
    {   const std::true_type Y{}; const std::false_type N{}; const std::integral_constant<int, 0> B0{}; const std::integral_constant<int, 1> B1{}; const std::integral_constant<int, 2> B2{};
        int i = 0;
        for (; i + 2 < n; i += 2) { step(i, sA0, sA1, sB0, sB1, Y, N, B1); step(i + 1, sB0, sB1, sA0, sA1, Y, N, B2); }
        if (n - i == 2) { step(i, sA0, sA1, sB0, sB1, Y, N, B1); step(i + 1, sB0, sB1, sA0, sA1, N, Y, B2); }
        else step(i, sA0, sA1, sB0, sB1, N, Y, B0);
    }
#if MLA_PRIO
    __builtin_amdgcn_s_setprio(0);
#endif
#undef ML_LOADK
#undef ML_LOADV
#undef ML_STOREK
#undef ML_STOREV
#undef ML_BAR
    const float ltot = sum_x32(lsum);
    LAS float* mg = (LAS float*)F.lds + qg * (34 * 64) + lane;
    if (kh == 1) {
        mg[0] = m; mg[64] = ltot;
#pragma unroll
        for (int r = 0; r < 16; ++r) { mg[(2 + r) * 64] = o0[r]; mg[(18 + r) * 64] = o1[r]; }
    }
    __syncthreads();
    if (kh == 0) {
        const float m1 = mg[0], l1 = mg[64];
        const float M = fmaxf(m, m1), a0 = __builtin_amdgcn_exp2f(m - M), a1 = __builtin_amdgcn_exp2f(m1 - M);
        const float inv = 1.0f / (ltot * a0 + l1 * a1), c0 = a0 * inv, c1 = a1 * inv;
#pragma unroll
        for (int r = 0; r < 16; ++r) { o0[r] = o0[r] * c0 + mg[(2 + r) * 64] * c1; o1[r] = o1[r] * c0 + mg[(18 + r) * 64] * c1; }
        if (VAR != 0) { asm volatile("" :: "v"(o0), "v"(o1)); }
        else {
        bf16_t* od = (bf16_t*)(F.ws + WS_O) + (size_t)t * DM + hh * 64 + 4 * hi;
#pragma unroll
        for (int g4 = 0; g4 < 4; ++g4) {
            u32x2 w; w.x = pk2(o0[4 * g4], o0[4 * g4 + 1]); w.y = pk2(o0[4 * g4 + 2], o0[4 * g4 + 3]); *(u32x2*)(od + 8 * g4) = w;
            u32x2 z; z.x = pk2(o1[4 * g4], o1[4 * g4 + 1]); z.y = pk2(o1[4 * g4 + 2], o1[4 * g4 + 3]); *(u32x2*)(od + 32 + 8 * g4) = z;
        }
        }
    }
    __syncthreads();
}
struct DilUnit { int hh, p, c, ib; };
DI DilUnit dil_decode(int uid) { DilUnit u; u.hh = uid / 384; const int rem = uid % 384; u.p = rem >> 7; const int blk = rem & 127, bpc = 128 >> (2 * u.p); u.c = blk / bpc; u.ib = blk % bpc; return u; }
struct DilPre { u32x4 sk[2], sv[2], sk2[2], sv2[2]; bf16x8 qf[4]; };
DI void dil_preload(Frame& F, const DilUnit& u, DilPre& P) {
    int tid_ = threadIdx.x; asm volatile("" : "+v"(tid_));
    const int tid = tid_, lane = tid & 63, wave = __builtin_amdgcn_readfirstlane(tid >> 6), r32 = lane & 31, hi = lane >> 5, qg = wave & 3;
    const int rs = 2 * u.p;
    const bf16_t* Kg = (const bf16_t*)(F.ws + WS_KD) + (size_t)u.hh * SEQ * 64;
    const bf16_t* Vg = (const bf16_t*)(F.ws + WS_PROJ) + PC_DV + 64 * u.hh;
#pragma unroll
    for (int i = 0; i < 2; ++i) { const int pp = tid + NTHREADS * i, key = pp >> 3, ch = pp & 7; const size_t tok = ((size_t)(128 * u.ib + key) << rs) + u.c;
        P.sk[i] = *(const u32x4*)(Kg + tok * 64 + 8 * ch); P.sv[i] = *(const u32x4*)(Vg + tok * NP + 8 * ch); }
    if (u.ib > 0) {
#pragma unroll
        for (int i = 0; i < 2; ++i) { const int pp = tid + NTHREADS * i, key = pp >> 3, ch = pp & 7; const size_t tok = ((size_t)(128 * (u.ib - 1) + key) << rs) + u.c;
            P.sk2[i] = *(const u32x4*)(Kg + tok * 64 + 8 * ch); P.sv2[i] = *(const u32x4*)(Vg + tok * NP + 8 * ch); }
    }
    const int t = ((128 * u.ib + 32 * qg + r32) << rs) + u.c;
    const bf16_t* Qp = (const bf16_t*)(F.ws + WS_QD) + ((size_t)u.hh * SEQ + t) * 64 + 8 * hi;
#pragma unroll
    for (int ks = 0; ks < 4; ++ks) P.qf[ks] = *(const bf16x8*)(Qp + 16 * ks);
}
DI void dil_wg_unit(Frame& F, const DilUnit& U, DilPre& P, bool has_next, const DilUnit& N) {
    constexpr int KSTR = 72, VSTR = 136, KBYTES = 128 * KSTR * 2, VBYTES = 64 * VSTR * 2, BUF = KBYTES + VBYTES;
    const int hh = U.hh, p = U.p, c = U.c, ib = U.ib;
    int tid_ = threadIdx.x; asm volatile("" : "+v"(tid_));
    const int tid = tid_, lane = tid & 63, wave = __builtin_amdgcn_readfirstlane(tid >> 6), r32 = lane & 31, hi = lane >> 5, qg = wave & 3, kh = wave >> 2;
    const int rs = 2 * p, r = 1 << rs;
    const int iq = 128 * ib + 32 * qg + r32, t = (iq << rs) + c;
    const bf16_t* Kg = (const bf16_t*)(F.ws + WS_KD) + (size_t)hh * SEQ * 64;
    const bf16_t* Vg = (const bf16_t*)(F.ws + WS_PROJ) + PC_DV + 64 * hh;
    bf16x8 qf[4];
#pragma unroll
    for (int ks = 0; ks < 4; ++ks) { qf[ks] = P.qf[ks]; asm volatile("" :: "v"(qf[ks])); }
    float m = 0.f, lsum = 0.f;
    f32x16 o0, o1;
#pragma unroll
    for (int q = 0; q < 16; ++q) { o0[q] = 0.f; o1[q] = 0.f; }
    const float slope2 = exp2f(-(float)(2 * hh + 1)) * LOG2E * (float)r;
    f32x16 cb;
#pragma unroll
    for (int q = 0; q < 16; ++q) cb[q] = slope2 * (float)(16 * (q >> 3) + (q & 7) + 8 * hi);
    u32x4 sk[2], sv[2];
#define DL_STORE(b_) do { LAS unsigned char* kb_ = F.lds + (b_) * BUF; _Pragma("unroll") for (int i = 0; i < 2; ++i) { const int pp = tid + NTHREADS * i, key = pp >> 3, ch = pp & 7; \
        *(LAS u32x4*)(kb_ + (key * KSTR + 8 * ch) * 2) = sk[i]; LAS bf16_t* vb_ = (LAS bf16_t*)(kb_ + KBYTES) + (8 * ch) * VSTR + key; \
        vb_[0 * VSTR] = (bf16_t)(sv[i].x & 0xffffu); vb_[1 * VSTR] = (bf16_t)(sv[i].x >> 16); vb_[2 * VSTR] = (bf16_t)(sv[i].y & 0xffffu); vb_[3 * VSTR] = (bf16_t)(sv[i].y >> 16); \
        vb_[4 * VSTR] = (bf16_t)(sv[i].z & 0xffffu); vb_[5 * VSTR] = (bf16_t)(sv[i].z >> 16); vb_[6 * VSTR] = (bf16_t)(sv[i].w & 0xffffu); vb_[7 * VSTR] = (bf16_t)(sv[i].w >> 16); } } while (0)
#pragma unroll
    for (int i = 0; i < 2; ++i) { sk[i] = P.sk[i]; sv[i] = P.sv[i]; }
    DL_STORE(0);
    if (ib > 0) {
#pragma unroll
        for (int i = 0; i < 2; ++i) { sk[i] = P.sk2[i]; sv[i] = P.sv2[i]; }
        DL_STORE(1);
    }
    __syncthreads();
    const int nt = ib > 0 ? 2 : 1;
    for (int ti = 0; ti < nt; ++ti) {
        const int T = ib - ti;
        if (ti == nt - 1 && has_next) dil_preload(F, N, P);
        const LAS bf16_t* Kb = (const LAS bf16_t*)(F.lds + ti * BUF);
        const LAS bf16_t* Vb = (const LAS bf16_t*)(F.lds + ti * BUF + KBYTES);
#pragma unroll
        for (int jj = 0; jj < 2; ++jj) {
            const int j = 1 - jj, sidx = 2 * kh + j;
            if (T == ib && sidx > qg) continue;
            if (T < ib && sidx < qg) continue;
            const LAS bf16_t* kp = Kb + (64 * kh + 32 * j + swap23(r32)) * KSTR + 8 * hi;
            const LAS bf16_t* vp = Vb + r32 * VSTR + 64 * kh + 32 * j + 8 * hi;
            bf16x8 kf[4], vf[4];
#pragma unroll
            for (int ks = 0; ks < 4; ++ks) kf[ks] = *(const LAS bf16x8*)(kp + 16 * ks);
            vf[0] = *(const LAS bf16x8*)(vp); vf[1] = *(const LAS bf16x8*)(vp + 16); vf[2] = *(const LAS bf16x8*)(vp + 32 * VSTR); vf[3] = *(const LAS bf16x8*)(vp + 32 * VSTR + 16);
            f32x16 s = MFMA32(kf[0], qf[0], cb);
#pragma unroll
            for (int ks = 1; ks < 4; ++ks) s = MFMA32(kf[ks], qf[ks], s);
            const int D = iq - (128 * T + 64 * kh + 32 * j);
            if (sidx == qg) {
                const int d0 = D - 8 * hi;
#pragma unroll
                for (int i = 0; i < 16; ++i) { const int dl = d0 - (16 * (i >> 3) + (i & 7)); if (dl < 0 || dl > 128) s[i] = -INFINITY; }
            }
            float mj = m + slope2 * (float)D;
            float rm = fmaxf(s[0], s[1]);
#pragma unroll
            for (int i = 2; i < 16; ++i) rm = fmaxf(rm, s[i]);
            rm = max_x32(rm) - mj;
            if (__any(rm > 8.0f)) {
                const float dl = fmaxf(rm, 0.f), alpha = __builtin_amdgcn_exp2f(-dl);
                m += dl; mj += dl; lsum *= alpha;
#pragma unroll
                for (int q = 0; q < 16; ++q) { o0[q] *= alpha; o1[q] *= alpha; }
            }
            float pr[16], psum = 0.f;
#pragma unroll
            for (int i = 0; i < 16; ++i) { pr[i] = __builtin_amdgcn_exp2f(s[i] - mj); psum += pr[i]; }
            lsum += psum;
            u32x4 w0, w1;
            w0.x = pk2(pr[0], pr[1]); w0.y = pk2(pr[2], pr[3]); w0.z = pk2(pr[4], pr[5]); w0.w = pk2(pr[6], pr[7]);
            w1.x = pk2(pr[8], pr[9]); w1.y = pk2(pr[10], pr[11]); w1.z = pk2(pr[12], pr[13]); w1.w = pk2(pr[14], pr[15]);
            const bf16x8 pf0 = __builtin_bit_cast(bf16x8, w0), pf1 = __builtin_bit_cast(bf16x8, w1);
            o0 = MFMA32(vf[0], pf0, o0); o0 = MFMA32(vf[1], pf1, o0);
            o1 = MFMA32(vf[2], pf0, o1); o1 = MFMA32(vf[3], pf1, o1);
        }
    }
    __syncthreads();
#undef DL_STORE
    const float ltot = sum_x32(lsum);
    LAS float* mg = (LAS float*)F.lds + qg * (34 * 64) + lane;
    if (kh == 1) {
        mg[0] = m; mg[64] = ltot;
#pragma unroll
        for (int q = 0; q < 16; ++q) { mg[(2 + q) * 64] = o0[q]; mg[(18 + q) * 64] = o1[q]; }
    }
    __syncthreads();
    if (kh == 0) {
        const float m1 = mg[0], l1 = mg[64];
        const float M = fmaxf(m, m1), a0 = __builtin_amdgcn_exp2f(m - M), a1 = __builtin_amdgcn_exp2f(m1 - M);
        const float L = ltot * a0 + l1 * a1, inv = 1.0f / L, c0 = a0 * inv, c1 = a1 * inv;
#pragma unroll
        for (int q = 0; q < 16; ++q) { o0[q] = o0[q] * c0 + mg[(2 + q) * 64] * c1; o1[q] = o1[q] * c0 + mg[(18 + q) * 64] * c1; }
        const size_t pidx = ((size_t)hh * SEQ + t) * 4 + p;
        if (hi == 0) { float* pm = (float*)(F.ws + WS_DM) + pidx * 2; pm[0] = M; pm[1] = L; }
        bf16_t* od = (bf16_t*)(F.ws + WS_DO) + pidx * 64 + 4 * hi;
#pragma unroll
        for (int g4 = 0; g4 < 4; ++g4) {
            u32x2 w; w.x = pk2(o0[4 * g4], o0[4 * g4 + 1]); w.y = pk2(o0[4 * g4 + 2], o0[4 * g4 + 3]); *(u32x2*)(od + 8 * g4) = w;
            u32x2 z; z.x = pk2(o1[4 * g4], o1[4 * g4 + 1]); z.y = pk2(o1[4 * g4 + 2], o1[4 * g4 + 3]); *(u32x2*)(od + 32 + 8 * g4) = z;
        }
    }
    __syncthreads();
}
DI void moba_select(Frame& F, const LAS float* kmean, int hh, int t, int ownb, int& o1, int& o2, int& o3) {
    const int lane = F.lane, r32 = lane & 31, hi = lane >> 5;
    float qv[64];
    { const bf16_t* qrow = (const bf16_t*)(F.ws + WS_QC) + ((size_t)hh * SEQ + t) * 64;
#pragma unroll
      for (int i = 0; i < 8; ++i) { const bf16x8 r = *(const bf16x8*)(qrow + 8 * i);
#pragma unroll
          for (int e = 0; e < 8; ++e) qv[8 * i + e] = bf2f((bf16_t)r[e]); } }
    float v1 = -INFINITY, v2 = -INFINITY, v3 = -INFINITY; int i1 = -1, i2 = -1, i3 = -1;
    for (int n = hi; n < ownb; n += 2) {
        const LAS f32x4* km = (const LAS f32x4*)(kmean + (hh * 64 + n) * 64);
        float g0 = 0.f, g1 = 0.f;
#pragma unroll
        for (int d4 = 0; d4 < 16; d4 += 2) { const f32x4 k0 = km[d4], k1 = km[d4 + 1];
            g0 += qv[4 * d4] * k0.x + qv[4 * d4 + 1] * k0.y + qv[4 * d4 + 2] * k0.z + qv[4 * d4 + 3] * k0.w;
            g1 += qv[4 * d4 + 4] * k1.x + qv[4 * d4 + 5] * k1.y + qv[4 * d4 + 6] * k1.z + qv[4 * d4 + 7] * k1.w; }
        const float g = g0 + g1;
        if (g > v1) { v3 = v2; i3 = i2; v2 = v1; i2 = i1; v1 = g; i1 = n; }
        else if (g > v2) { v3 = v2; i3 = i2; v2 = g; i2 = n; }
        else if (g > v3) { v3 = g; i3 = n; }
    }
    float pv[3]; int pi[3];
    pv[0] = __shfl_xor(v1, 32); pv[1] = __shfl_xor(v2, 32); pv[2] = __shfl_xor(v3, 32);
    pi[0] = __shfl_xor(i1, 32); pi[1] = __shfl_xor(i2, 32); pi[2] = __shfl_xor(i3, 32);
#pragma unroll
    for (int c = 0; c < 3; ++c) {
        const float g = pv[c]; const int n = pi[c];
        if (n >= 0) {
            if (g > v1 || (g == v1 && n < i1)) { v3 = v2; i3 = i2; v2 = v1; i2 = i1; v1 = g; i1 = n; }
            else if (g > v2 || (g == v2 && n < i2)) { v3 = v2; i3 = i2; v2 = g; i2 = n; }
            else if (g > v3 || (g == v3 && n < i3)) { v3 = g; i3 = n; }
        }
    }
    o1 = i1; o2 = i2; o3 = i3; (void)r32;
}
DI void moba_block_unit(Frame& F, int hh, int n, const int* list, int q0, int cnt, bool own) {
    constexpr int KSTR = 72, VSTR = 264, KBYTES = 256 * KSTR * 2;
    int tid_ = threadIdx.x; asm volatile("" : "+v"(tid_));
    const int tid = tid_, lane = tid & 63, wave = __builtin_amdgcn_readfirstlane(tid >> 6), r32 = lane & 31, hi = lane >> 5;
    const bf16_t* Kg = (const bf16_t*)(F.ws + WS_KC) + ((size_t)hh * SEQ + 256 * n) * 64;
    const bf16_t* Vg = (const bf16_t*)(F.ws + WS_VCT) + (size_t)hh * 64 * SEQ + 256 * n;
    LAS bf16_t* Kb = (LAS bf16_t*)F.lds; LAS bf16_t* Vb = (LAS bf16_t*)(F.lds + KBYTES);
    int t, slot = 3, e = 0; bool valid = true;
    if (!own) { const int idx = q0 + 32 * wave + r32; valid = idx < cnt; e = list[valid ? idx : q0]; }
    const bool wave_any = own || (q0 + 32 * wave < cnt);
    u32x4 sk[4], sv[4];
#pragma unroll
    for (int i = 0; i < 4; ++i) { const int p = tid + NTHREADS * i; sk[i] = *(const u32x4*)(Kg + (size_t)(p >> 3) * 64 + 8 * (p & 7)); sv[i] = *(const u32x4*)(Vg + (size_t)(p >> 5) * SEQ + 8 * (p & 31)); }
    if (own) t = 256 * n + 32 * wave + r32; else { t = e & 0xffff; slot = e >> 16; }
    bf16x8 qf[4];
    { const bf16_t* Qp = (const bf16_t*)(F.ws + WS_QC) + ((size_t)hh * SEQ + t) * 64 + 8 * hi;
#pragma unroll
      for (int ks = 0; ks < 4; ++ks) qf[ks] = *(const bf16x8*)(Qp + 16 * ks); }
#pragma unroll
    for (int i = 0; i < 4; ++i) { const int p = tid + NTHREADS * i; *(LAS u32x4*)(Kb + (p >> 3) * KSTR + 8 * (p & 7)) = sk[i]; *(LAS u32x4*)(Vb + (p >> 5) * VSTR + 8 * (p & 31)) = sv[i]; }
    __syncthreads();
    if (wave_any) {
        const float slope2 = exp2f(-(float)(2 * hh + 2)) * LOG2E;
        f32x16 cb;
#pragma unroll
        for (int r = 0; r < 16; ++r) cb[r] = slope2 * (float)(16 * (r >> 3) + (r & 7) + 8 * hi);
        const int jend = own ? wave : 7;
        float m = slope2 * (float)(32 * jend + 31), lsum = 0.f;
        f32x16 o0, o1;
#pragma unroll
        for (int r = 0; r < 16; ++r) { o0[r] = 0.f; o1[r] = 0.f; }
        for (int j = jend; j >= 0; --j) {
            const LAS bf16_t* kp = Kb + (32 * j + swap23(r32)) * KSTR + 8 * hi;
            const LAS bf16_t* vp = Vb + r32 * VSTR + 32 * j + 8 * hi;
            bf16x8 kf[4], vf[4];
#pragma unroll
            for (int ks = 0; ks < 4; ++ks) kf[ks] = *(const LAS bf16x8*)(kp + 16 * ks);
            vf[0] = *(const LAS bf16x8*)(vp); vf[1] = *(const LAS bf16x8*)(vp + 16); vf[2] = *(const LAS bf16x8*)(vp + 32 * VSTR); vf[3] = *(const LAS bf16x8*)(vp + 32 * VSTR + 16);
            f32x16 s = MFMA32(kf[0], qf[0], cb);
#pragma unroll
            for (int ks = 1; ks < 4; ++ks) s = MFMA32(kf[ks], qf[ks], s);
            if (own && j == wave) {
                const int d0 = t - (256 * n + 32 * j + 8 * hi);
#pragma unroll
                for (int i = 0; i < 16; ++i) { const int dl = d0 - (16 * (i >> 3) + (i & 7)); if (dl < 0) s[i] = -INFINITY; }
            }
            float mj = m - slope2 * (float)(32 * j);
            float rm = fmaxf(s[0], s[1]);
#pragma unroll
            for (int i = 2; i < 16; ++i) rm = fmaxf(rm, s[i]);
            rm = max_x32(rm) - mj;
            if (__any(rm > 8.0f)) {
                const float dl = fmaxf(rm, 0.f), alpha = __builtin_amdgcn_exp2f(-dl);
                m += dl; mj += dl; lsum *= alpha;
#pragma unroll
                for (int r = 0; r < 16; ++r) { o0[r] *= alpha; o1[r] *= alpha; }
            }
            float p[16], psum = 0.f;
#pragma unroll
            for (int i = 0; i < 16; ++i) { p[i] = __builtin_amdgcn_exp2f(s[i] - mj); psum += p[i]; }
            lsum += psum;
            u32x4 w0, w1;
            w0.x = pk2(p[0], p[1]); w0.y = pk2(p[2], p[3]); w0.z = pk2(p[4], p[5]); w0.w = pk2(p[6], p[7]);
            w1.x = pk2(p[8], p[9]); w1.y = pk2(p[10], p[11]); w1.z = pk2(p[12], p[13]); w1.w = pk2(p[14], p[15]);
            const bf16x8 pf0 = __builtin_bit_cast(bf16x8, w0), pf1 = __builtin_bit_cast(bf16x8, w1);
            o0 = MFMA32(vf[0], pf0, o0); o0 = MFMA32(vf[1], pf1, o0);
            o1 = MFMA32(vf[2], pf0, o1); o1 = MFMA32(vf[3], pf1, o1);
        }
        m -= slope2 * (float)(t - 256 * n);
        const float ltot = sum_x32(lsum), inv = 1.0f / ltot;
        if (valid) {
            const size_t pidx = ((size_t)hh * SEQ + t) * 4 + slot;
            if (hi == 0) { float* pm = (float*)(F.ws + WS_PM) + pidx * 2; pm[0] = m; pm[1] = ltot; }
            bf16_t* od = (bf16_t*)(F.ws + WS_PO) + pidx * 64 + 4 * hi;
#pragma unroll
            for (int g4 = 0; g4 < 4; ++g4) {
                u32x2 w; w.x = pk2(o0[4 * g4] * inv, o0[4 * g4 + 1] * inv); w.y = pk2(o0[4 * g4 + 2] * inv, o0[4 * g4 + 3] * inv); *(u32x2*)(od + 8 * g4) = w;
                u32x2 z; z.x = pk2(o1[4 * g4] * inv, o1[4 * g4 + 1] * inv); z.y = pk2(o1[4 * g4 + 2] * inv, o1[4 * g4 + 3] * inv); *(u32x2*)(od + 32 + 8 * g4) = z;
            }
        }
    }
    __syncthreads();
}
DI int grab_unit(unsigned* ctr, int lane) {
    int u = 0;
    if (lane == 0) u = (int)__hip_atomic_fetch_add(ctr, 1u, __ATOMIC_RELAXED, __HIP_MEMORY_SCOPE_AGENT);
    return __builtin_amdgcn_readfirstlane(u);
}
DI void phase_attention(Frame& F, int l, int rep) {
    const int tid = F.tid, lane = F.lane, wave = F.wave;
    LAS float* kmean = (LAS float*)F.lds;
    LAS float* fpre = (LAS float*)(F.lds + ATT_FPRE_OFF);
    LAS unsigned* cntl = (LAS unsigned*)(F.lds + ATT_SELM_OFF);
    LAS float* misc = (LAS float*)(F.lds + ATT_MISC_OFF);
    const float* ksum = (const float*)(F.ws + WS_KSUM);
    if (tid < 4) { const float* ft = (const float*)(F.ws + WS_FTILE) + tid * 256; float run = 0.f;
        for (int i = 0; i < 256; ++i) { fpre[tid * 256 + i] = run; run += ft[i]; } }
    if (wave == 1) {
        const float gq = wave_max(fabsf(F.in(I_FQG)[l * 64 + lane])), gk = wave_max(fabsf(F.in(I_FKG)[l * 64 + lane]));
        if (lane == 0) misc[0] = (40.0f + 2.0f * 8.0f * 1.03f * gq * gk) * LOG2E;
    }
    if (rep == 0) {
        for (int idx = tid; idx < 4 * 64 * 64; idx += NTHREADS) {
            const int h2 = idx >> 12, n = (idx >> 6) & 63, d = idx & 63;
            const float* kp = ksum + ((size_t)h2 * 256 + 4 * n) * 64 + d;
            kmean[idx] = ((kp[0] + kp[64]) + (kp[128] + kp[192])) * (1.0f / 256.0f);
        }
        unsigned* bcnt = F.ctl + CW_BCNT + 256 * l; int* blist = (int*)(F.ws + WS_BLIST);
        for (int tile = blockIdx.x; tile < SEQ / 64; tile += F.G) {
            if (tid < 256) cntl[tid] = 0u;
            __syncthreads();
            const int hh = wave >> 1, t = 64 * tile + 32 * (wave & 1) + (lane & 31);
            int sel[3]; moba_select(F, kmean, hh, t, t >> 8, sel[0], sel[1], sel[2]);
            unsigned rank[3] = {0u, 0u, 0u};
            if (lane < 32) {
#pragma unroll
                for (int j = 0; j < 3; ++j) if (sel[j] >= 0) rank[j] = __hip_atomic_fetch_add(cntl + hh * 64 + sel[j], 1u, __ATOMIC_RELAXED, __HIP_MEMORY_SCOPE_WORKGROUP);
            }
            __syncthreads();
            if (tid < 256) { const unsigned c = cntl[tid]; cntl[256 + tid] = c ? __hip_atomic_fetch_add(bcnt + tid, c, __ATOMIC_RELAXED, __HIP_MEMORY_SCOPE_AGENT) : 0u; }
            __syncthreads();
            if (lane < 32) {
#pragma unroll
                for (int j = 0; j < 3; ++j) if (sel[j] >= 0) blist[(size_t)(hh * 64 + sel[j]) * SEQ + cntl[256 + hh * 64 + sel[j]] + rank[j]] = t | (j << 16);
            }
            __syncthreads();
        }
    }
    __syncthreads();
#ifndef ATT_REP
#define ATT_REP 0
#endif
    BgConv bg; bg.init(blockIdx.x * NWAVES + wave, F.G * NWAVES, l); if (rep != 0 || !BG_CONVERT) bg.it = BG_ITEMS;
    for (int vc = blockIdx.x; vc < 256; vc += F.G) {
        const int hh = (vc & 7) >> 1, q = ((vc & 1) << 5) | (vc >> 3);
        for (int rr = 0; rr < 1 + ((ATT_REP >> 0) & 1); ++rr) { mla_wg_unit<0>(F, hh, 127 - q, bg); mla_wg_unit<0>(F, hh, q, bg); }
        if (BG_CONVERT) bg.drain(F, wave, lane);
#ifdef A_SHADOW
        mla_wg_unit<A_SHADOW>(F, hh, 127 - q, bg); mla_wg_unit<A_SHADOW>(F, hh, q, bg);
#endif
        for (int rr = 0; rr < 1 + ((ATT_REP >> 3) & 1); ++rr)
        {
            DilPre pre; DilUnit du = dil_decode(vc * 6); dil_preload(F, du, pre);
            for (int k = 0; k < 6; ++k) { const DilUnit dn = dil_decode(vc * 6 + (k < 5 ? k + 1 : k)); dil_wg_unit(F, du, pre, k < 5, dn); du = dn; }
        }
        for (int rr = 0; rr < 1 + ((ATT_REP >> 2) & 1); ++rr) moba_block_unit(F, hh, q, nullptr, 0, 0, true);
    }
    if (BG_CONVERT) { bg.drain(F, wave, lane); bg.rest(F, wave, lane); }
    __syncthreads();
    AttnShared A; A.kmean = kmean; A.fpre = fpre; A.fox_cut = misc[0];
    unsigned* qctr = F.ctl + CW_QUEUE + 64 * (l * 4) + 1024 * rep;
    for (;;) { const int u = grab_unit(qctr + 1 * 64, lane); if (u >= 2048) break; fox_unit(F, A, u & 3, 511 - (u >> 2)); }
}
DI void phase_moba_items(Frame& F, int l, int rep) {
    const int tid = F.tid;
    LAS int* istart = (LAS int*)(F.lds + ATT_SELM_OFF);
    LAS int* bc = (LAS int*)(F.lds + ATT_SELM_OFF + 2048);
    LAS int* cur = (LAS int*)(F.lds + ATT_SELM_OFF + 4096);
    const unsigned* bcnt = F.ctl + CW_BCNT + 256 * l;
    if (tid < 256) bc[tid] = (int)__hip_atomic_load(bcnt + tid, __ATOMIC_RELAXED, __HIP_MEMORY_SCOPE_AGENT);
    __syncthreads();
    if (tid == 0) { int run = 0; for (int i = 0; i < 256; ++i) { istart[i] = run; run += (bc[i] + 255) >> 8; } istart[256] = run; }
    __syncthreads();
    const int nitems = istart[256];
    unsigned* qctr = F.ctl + CW_MQ + 64 * l + 1024 * rep;
    const int* blist = (const int*)(F.ws + WS_BLIST);
    for (;;) {
        if (tid == 0) { const int it = (int)__hip_atomic_fetch_add(qctr, 1u, __ATOMIC_RELAXED, __HIP_MEMORY_SCOPE_AGENT);
            int b = -1, q0 = 0;
            if (it < nitems) { int lo = 0, hi = 255; while (lo < hi) { const int mid = (lo + hi + 1) >> 1; if (istart[mid] <= it) lo = mid; else hi = mid - 1; } b = lo; q0 = (it - istart[lo]) << 8; }
            cur[0] = b; cur[1] = q0; }
        __syncthreads();
        const int b = cur[0], q0 = cur[1];
        __syncthreads();
        if (b < 0) break;
        moba_block_unit(F, b >> 6, b & 63, blist + (size_t)b * SEQ, q0, bc[b], false);
    }
}
DI void phase_moba_combine(Frame& F) {
    const int lane = F.lane, sub = lane & 15;
    bf16_t* o = (bf16_t*)(F.ws + WS_O);
    const int gw = blockIdx.x * NWAVES + F.wave, NGW = F.G * NWAVES;
    for (int it0 = gw; it0 < 2 * SEQ; it0 += 2 * NGW) {
        f32x2_t pmv[2][4]; u32x2 pov[2][4]; int tt[2], hh2[2], wh[2], ns[2]; bool act[2];
#pragma unroll
        for (int q = 0; q < 2; ++q) {
            const int it = it0 + q * NGW; act[q] = it < 2 * SEQ; const int itc = act[q] ? it : it0;
            const int which = itc >= SEQ;
            const int pair = (itc - which * SEQ) * 4 + (lane >> 4), t = pair >> 2, hh = pair & 3;
            const float* pm = (const float*)(F.ws + (which ? WS_DM : WS_PM)); const bf16_t* po = (const bf16_t*)(F.ws + (which ? WS_DO : WS_PO));
            const size_t base = ((size_t)hh * SEQ + t) * 4;
            tt[q] = t; hh2[q] = hh; wh[q] = which; ns[q] = which ? 3 : ((t >> 8) < 3 ? (t >> 8) : 3);
#pragma unroll
            for (int j = 0; j < 4; ++j) { pmv[q][j] = *(const f32x2_t*)(pm + (base + j) * 2); pov[q][j] = *(const u32x2*)(po + (base + j) * 64 + 4 * sub); }
        }
#pragma unroll
        for (int q = 0; q < 2; ++q) {
            if (!act[q]) break;
            float mj[4], lj[4]; float M = -1e30f;
#pragma unroll
            for (int j = 0; j < 4; ++j) { const bool use = (j == 3) ? !wh[q] : (j < ns[q]); mj[j] = use ? pmv[q][j].x : -1e30f; lj[j] = use ? pmv[q][j].y : 0.f; M = fmaxf(M, mj[j]); }
            float acc[4] = {0.f, 0.f, 0.f, 0.f}, W = 0.f;
#pragma unroll
            for (int j = 0; j < 4; ++j) { const bool use = (j == 3) ? !wh[q] : (j < ns[q]);
                const float w = use ? lj[j] * __builtin_amdgcn_exp2f(mj[j] - M) : 0.f; W += w; const u32x2 v = pov[q][j];
                if (use) {
                acc[0] += w * bf2f((bf16_t)(v.x & 0xffffu)); acc[1] += w * bf2f((bf16_t)(v.x >> 16)); acc[2] += w * bf2f((bf16_t)(v.y & 0xffffu)); acc[3] += w * bf2f((bf16_t)(v.y >> 16)); } }
            const float inv = 1.0f / W;
            u32x2 r; r.x = pk2(acc[0] * inv, acc[1] * inv); r.y = pk2(acc[2] * inv, acc[3] * inv);
            *(u32x2*)(o + (size_t)tt[q] * DM + ((wh[q] ? 12 : 8) + hh2[q]) * 64 + 4 * sub) = r;
        }
    }
}

struct EpiGateRes {
    static constexpr bool PERM = false, AFTER_DRAIN = false;
    const float* xin; float* xout; const float* gate;
    DI void operator()(const pg8::f32x4 (&acc)[2][2][4][2], const pg8::Unit& u, int wr, int wc, int fr, int fq) const {
        const int row0 = u.pm * 256 + wr * 64 + fr, col0 = u.pn * 256 + wc * 32 + 4 * fq;
        pg8::f32x4 gv[2][2];
#pragma unroll
        for (int bj = 0; bj < 2; ++bj)
#pragma unroll
            for (int n = 0; n < 2; ++n) gv[bj][n] = *(const pg8::f32x4*)(gate + col0 + bj * 128 + n * 16);
        pg8::f32x4 xa[2][2], xb[2][2];
#define EGR_LOAD(x_, g_) do { const size_t o_ = (size_t)(row0 + ((g_) >> 2) * 128 + ((g_) & 3) * 16) * DM + col0; _Pragma("unroll") for (int bj = 0; bj < 2; ++bj) _Pragma("unroll") for (int n = 0; n < 2; ++n) x_[bj][n] = *(const pg8::f32x4*)(xin + o_ + bj * 128 + n * 16); } while (0)
#define EGR_STORE(x_, g_) do { const size_t o_ = (size_t)(row0 + ((g_) >> 2) * 128 + ((g_) & 3) * 16) * DM + col0; _Pragma("unroll") for (int bj = 0; bj < 2; ++bj) _Pragma("unroll") for (int n = 0; n < 2; ++n) \
            *(pg8::f32x4*)(xout + o_ + bj * 128 + n * 16) = x_[bj][n] + gv[bj][n] * acc[(g_) >> 2][bj][(g_) & 3][n]; } while (0)
        EGR_LOAD(xa, 0);
        EGR_LOAD(xb, 1); EGR_STORE(xa, 0);
        EGR_LOAD(xa, 2); EGR_STORE(xb, 1);
        EGR_LOAD(xb, 3); EGR_STORE(xa, 2);
        EGR_LOAD(xa, 4); EGR_STORE(xb, 3);
        EGR_LOAD(xb, 5); EGR_STORE(xa, 4);
        EGR_LOAD(xa, 6); EGR_STORE(xb, 5);
        EGR_LOAD(xb, 7); EGR_STORE(xa, 6);
        EGR_STORE(xb, 7);
#undef EGR_LOAD
#undef EGR_STORE
    }
};
#ifndef GROUPED_2D
#define GROUPED_2D 1
#endif
struct GroupedOrder {
    const LAS int* tile_e; int nMt, NT, G, c;
    const LAS int* tile0; const LAS int* ecnt; const int* inv;
    DI bool next(int i, pg8::Unit& u) const {
        int mt, nt;
        if (GROUPED_2D) {
            const int x = c & 7, j = i * (G >> 3) + (c >> 3);
            if (NT == 8) { mt = (j >> 1) * 2 + (x >> 2); nt = 2 * (x & 3) + (j & 1); }
            else         { mt = (j >> 1) * 4 + (x >> 1); nt = 2 * (x & 1) + (j & 1); }
            if (mt >= nMt) return false;
        } else {
            const long L = (long)i * G + c; if (L >= (long)nMt * NT) return false;
            mt = (int)(L / NT); nt = (int)(L % NT);
        }
        u.pm = mt; u.pn = tile_e[mt] * NT + nt; return true;
    }
    DI int arow(const pg8::Unit& u, int r) const { const int e = u.pn / NT, slot = (u.pm - tile0[e]) * 256 + r; return slot < ecnt[e] ? inv[e * SEQ + slot] : 0; }
    unsigned* ycnt; int role; unsigned* tmo;
    DI void done(const pg8::Unit& u) const {
        if (role == 1) { asm volatile("s_waitcnt vmcnt(0)" ::: "memory");
            if ((threadIdx.x & 63) == 0) __hip_atomic_fetch_add(ycnt + 64 * u.pm, 1u, __ATOMIC_RELAXED, __HIP_MEMORY_SCOPE_AGENT); }
    }
    DI void a_ready(const pg8::Unit& u) const {
        if (role == 2) {
            if (threadIdx.x < 64) {
                const unsigned long long t0 = __builtin_amdgcn_s_memrealtime(); unsigned polls = 0;
                while ((unsigned)__builtin_amdgcn_readfirstlane(__hip_atomic_load(ycnt + 64 * u.pm, __ATOMIC_RELAXED, __HIP_MEMORY_SCOPE_AGENT)) < 64u) {
                    if ((++polls & 255u) == 0u && __builtin_amdgcn_readfirstlane(__hip_atomic_load(tmo, __ATOMIC_RELAXED, __HIP_MEMORY_SCOPE_AGENT)) != 0u) break;
                    if (__builtin_amdgcn_s_memrealtime() - t0 > 2000000ull) { if (threadIdx.x == 0) __hip_atomic_store(tmo, 1u, __ATOMIC_RELAXED, __HIP_MEMORY_SCOPE_AGENT); break; }
                    __builtin_amdgcn_s_sleep(2); }
                __builtin_amdgcn_fence(__ATOMIC_ACQUIRE, "agent");
                asm volatile("s_waitcnt vmcnt(0)" ::: "memory");
            }
            asm volatile("" ::: "memory"); __builtin_amdgcn_s_barrier(); asm volatile("" ::: "memory");
        }
    }
};
template <bool WT> struct EpiSwigluT {
    static constexpr bool PERM = true, AFTER_DRAIN = false;
    bf16_t* Y; const float* b1;
    DI void operator()(const pg8::f32x4 (&acc)[2][2][4][2], const pg8::Unit& u, int wr, int wc, int fr, int fq) const {
        const int e = u.pn >> 3, nt = u.pn & 7;
        const int row0 = u.pm * 256 + wr * 64 + fr, col0 = nt * 128 + wc * 32 + 8 * fq;
        const float* bp = b1 + (size_t)e * 2048 + col0;
        const float sc = UP_FP8 ? WINV : 1.0f;
        pg8::f32x4 bgv[2], buv[2];
#pragma unroll
        for (int n = 0; n < 2; ++n) { bgv[n] = *(const pg8::f32x4*)(bp + 4 * n); buv[n] = *(const pg8::f32x4*)(bp + 1024 + 4 * n); }
#pragma unroll
        for (int ai = 0; ai < 2; ++ai)
#pragma unroll
            for (int m = 0; m < 4; ++m) {
                float y[8];
#pragma unroll
                for (int n = 0; n < 2; ++n) { const pg8::f32x4 gg = acc[ai][0][m][n] * sc + bgv[n], uu = acc[ai][1][m][n] * sc + buv[n];
#pragma unroll
                    for (int j = 0; j < 4; ++j) { const float g = fminf(gg[j], 7.0f), uc = fminf(fmaxf(uu[j], -7.0f), 7.0f);
                        y[4 * n + j] = (uc + 1.0f) * g * __builtin_amdgcn_rcpf(1.0f + __builtin_amdgcn_exp2f(-1.702f * LOG2E * g)); } }
                const size_t ro = (size_t)(row0 + ai * 128 + m * 16) * FEXP + col0;
                if (MOE_FP8) { GAS unsigned long long* y8 = (GAS unsigned long long*)((unsigned char*)Y + ro);
                    const unsigned long long v8 = ((unsigned long long)pk4_fp8(y[4], y[5], y[6], y[7]) << 32) | pk4_fp8(y[0], y[1], y[2], y[3]);
                    if (WT) __hip_atomic_store(y8, v8, __ATOMIC_RELAXED, __HIP_MEMORY_SCOPE_AGENT); else *y8 = v8; }
                else { const u32x4 w = pack8(y); GAS unsigned long long* yp = (GAS unsigned long long*)(Y + ro);
                    if (WT) { __hip_atomic_store(yp, ((unsigned long long)w.y << 32) | w.x, __ATOMIC_RELAXED, __HIP_MEMORY_SCOPE_AGENT); __hip_atomic_store(yp + 1, ((unsigned long long)w.w << 32) | w.z, __ATOMIC_RELAXED, __HIP_MEMORY_SCOPE_AGENT); }
                    else *(GAS u32x4*)yp = w; }
                asm volatile("" ::: "memory");
            }
    }
};
struct EpiDown {
    static constexpr bool PERM = true, AFTER_DRAIN = false;
    bf16_t* Y; const float* b2;
    DI void operator()(const pg8::f32x4 (&acc)[2][2][4][2], const pg8::Unit& u, int wr, int wc, int fr, int fq) const {
        const int e = u.pn >> 2, nt = u.pn & 3;
        const int row0 = u.pm * 256 + wr * 64 + fr, col0 = nt * 256 + wc * 32 + 8 * fq;
        const float* bp = b2 + (size_t)e * DM + col0;
        pg8::f32x4 bv[2][2];
#pragma unroll
        for (int bj = 0; bj < 2; ++bj)
#pragma unroll
            for (int n = 0; n < 2; ++n) bv[bj][n] = *(const pg8::f32x4*)(bp + bj * 128 + 4 * n);
#pragma unroll
        for (int ai = 0; ai < 2; ++ai)
#pragma unroll
            for (int m = 0; m < 4; ++m)
#pragma unroll
                for (int bj = 0; bj < 2; ++bj) {
                    const pg8::f32x4 v0 = acc[ai][bj][m][0] * (MOE_FP8 ? WINV : 1.0f) + bv[bj][0], v1 = acc[ai][bj][m][1] * (MOE_FP8 ? WINV : 1.0f) + bv[bj][1];
                    u32x4 w; w.x = pk2(v0[0], v0[1]); w.y = pk2(v0[2], v0[3]); w.z = pk2(v1[0], v1[1]); w.w = pk2(v1[2], v1[3]);
                    *(u32x4*)(Y + (size_t)(row0 + ai * 128 + m * 16) * DM + col0 + bj * 128) = w;
                }
    }
};

DI void phase_router(Frame& F, int l) {
    const int tid = F.tid, lane = F.lane, wave = F.wave;
    constexpr int WST = 1028;
    LAS float* wrt = (LAS float*)F.lds;
    LAS unsigned* cnt = (LAS unsigned*)(F.lds + 131584);
    LAS unsigned* basew = (LAS unsigned*)(F.lds + 131584 + 128);
    LAS int* info_e = (LAS int*)(F.lds + 131584 + 256);
    LAS float* info_g = (LAS float*)(F.lds + 131584 + 256 + 1024);
    const float* rw = F.in(I_RW) + (size_t)l * DM * NEXP;
    for (int idx = tid; idx < DM * NEXP; idx += NTHREADS) { const int c = idx >> 5, e = idx & 31; wrt[e * WST + c] = rw[idx]; }
    const float* mod = (const float*)(F.ws + WS_META + META_MOD) + l * 6144;
    const float* x1 = (const float*)(F.ws + WS_X1);
    bf16_t* h2 = (bf16_t*)(F.ws + WS_H);
    int* toki = (int*)(F.ws + WS_TOKI); float* tokg = (float*)(F.ws + WS_TOKI + 256 * 1024);
    unsigned* gcnt = F.ctl + CW_ECNT + 64 * l;
    for (int tile = blockIdx.x; tile < SEQ / 64; tile += F.G) {
        if (tid < 32) cnt[tid] = 0u;
        __syncthreads();
        LAS float* lg = (LAS float*)(F.lds + 131584 + 256 + 2048) + wave * 48;
#ifndef RROWS
#define RROWS 1
#endif
#pragma unroll 1
        for (int rr = 0; rr < 8; rr += RROWS) {
            f32x4 hv[RROWS][4];
#pragma unroll
            for (int q = 0; q < RROWS; ++q) {
                const int tok = tile * 64 + wave * 8 + rr + q;
                const f32x4* xr = (const f32x4*)(x1 + (size_t)tok * DM) + lane;
                f32x4 v[4]; float ss = 0.f;
#pragma unroll
                for (int j = 0; j < 4; ++j) { v[j] = xr[64 * j]; ss += (v[j].x * v[j].x + v[j].y * v[j].y) + (v[j].z * v[j].z + v[j].w * v[j].w); }
                ss = wave_sum(ss);
                const float rstd = 1.0f / sqrtf(ss * (1.0f / DM) + EPS);
#pragma unroll
                for (int j = 0; j < 4; ++j) { const int c = 4 * lane + 256 * j;
                    const f32x4 g4 = *(const f32x4*)(F.in(I_N2G) + l * DM + c), s4 = *(const f32x4*)(mod + 4 * DM + c), h4 = *(const f32x4*)(mod + 3 * DM + c);
                    hv[q][j] = (v[j] * rstd) * g4 * (s4 + 1.0f) + h4;
                    if (UP_FP8) *(unsigned*)((unsigned char*)(F.ws + WS_H8) + (size_t)tok * DM + c) = pk4_fp8(hv[q][j].x, hv[q][j].y, hv[q][j].z, hv[q][j].w);
                    else { u32x2 w; w.x = pk2(hv[q][j].x, hv[q][j].y); w.y = pk2(hv[q][j].z, hv[q][j].w); *(u32x2*)(h2 + (size_t)tok * DM + c) = w; } }
            }
            float pe[RROWS][32];
#pragma unroll
            for (int e = 0; e < 32; ++e) { float a[RROWS];
#pragma unroll
                for (int q = 0; q < RROWS; ++q) a[q] = 0.f;
#pragma unroll
                for (int j = 0; j < 4; ++j) { const f32x4 w4 = *(const LAS f32x4*)(wrt + e * WST + 4 * lane + 256 * j);
#pragma unroll
                    for (int q = 0; q < RROWS; ++q) a[q] += hv[q][j].x * w4.x + hv[q][j].y * w4.y + hv[q][j].z * w4.z + hv[q][j].w * w4.w; }
#pragma unroll
                for (int q = 0; q < RROWS; ++q) pe[q][e] = a[q]; if ((e & 1) == 1) asm volatile("" ::: "memory"); }
            const int my_e = ((lane >> 5) & 1) * 16 + ((lane >> 4) & 1) * 8 + ((lane >> 3) & 1) * 4 + ((lane >> 2) & 1) * 2 + ((lane >> 1) & 1);
#pragma unroll
            for (int q = 0; q < RROWS; ++q) {
                const int tl = wave * 8 + rr + q;
                { const bool up = (lane & 32) != 0;
#pragma unroll
                  for (int e = 0; e < 16; ++e) { const float send = up ? pe[q][e] : pe[q][e + 16], keep = up ? pe[q][e + 16] : pe[q][e]; pe[q][e] = keep + __shfl_xor(send, 32); } }
                { const bool up = (lane & 16) != 0;
#pragma unroll
                  for (int e = 0; e < 8; ++e) { const float send = up ? pe[q][e] : pe[q][e + 8], keep = up ? pe[q][e + 8] : pe[q][e]; pe[q][e] = keep + __shfl_xor(send, 16); } }
                { const bool up = (lane & 8) != 0;
#pragma unroll
                  for (int e = 0; e < 4; ++e) { const float send = up ? pe[q][e] : pe[q][e + 4], keep = up ? pe[q][e + 4] : pe[q][e]; pe[q][e] = keep + __shfl_xor(send, 8); } }
                { const bool up = (lane & 4) != 0;
#pragma unroll
                  for (int e = 0; e < 2; ++e) { const float send = up ? pe[q][e] : pe[q][e + 2], keep = up ? pe[q][e + 2] : pe[q][e]; pe[q][e] = keep + __shfl_xor(send, 4); } }
                { const bool up = (lane & 2) != 0; const float send = up ? pe[q][0] : pe[q][1], keep = up ? pe[q][1] : pe[q][0]; pe[q][0] = keep + __shfl_xor(send, 2); }
                pe[q][0] += __shfl_xor(pe[q][0], 1);
                const float val = pe[q][0] + F.in(I_RB)[l * NEXP + my_e];
                asm volatile("s_waitcnt lgkmcnt(0)" ::: "memory");
                if ((lane & 1) == 0) lg[my_e] = val;
                asm volatile("s_waitcnt lgkmcnt(0)" ::: "memory");
                const int ee = lane & 31; const float mine = lg[ee];
                int rank = 0;
#pragma unroll
                for (int j4 = 0; j4 < 8; ++j4) { const f32x4 t4 = *(const LAS f32x4*)(lg + 4 * j4);
                    rank += (t4.x > mine || (t4.x == mine && 4 * j4 + 0 < ee)) ? 1 : 0; rank += (t4.y > mine || (t4.y == mine && 4 * j4 + 1 < ee)) ? 1 : 0;
                    rank += (t4.z > mine || (t4.z == mine && 4 * j4 + 2 < ee)) ? 1 : 0; rank += (t4.w > mine || (t4.w == mine && 4 * j4 + 3 < ee)) ? 1 : 0; }
                if (lane < 32 && rank < 4) { lg[32 + rank] = mine; lg[36 + rank] = __int_as_float(ee); }
                asm volatile("s_waitcnt lgkmcnt(0)" ::: "memory");
                const f32x4 tv4 = *(const LAS f32x4*)(lg + 32), te4 = *(const LAS f32x4*)(lg + 36);
                const float e1 = __expf(tv4.y - tv4.x), e2 = __expf(tv4.z - tv4.x), e3 = __expf(tv4.w - tv4.x);
                const float rs = 1.0f / (1.0f + e1 + e2 + e3);
                if (lane < 4) {
                    const int sel = __float_as_int(lane == 0 ? te4.x : lane == 1 ? te4.y : lane == 2 ? te4.z : te4.w);
                    const float gg = (lane == 0 ? 1.0f : lane == 1 ? e1 : lane == 2 ? e2 : e3) * rs;
                    const unsigned slot = __hip_atomic_fetch_add(cnt + sel, 1u, __ATOMIC_RELAXED, __HIP_MEMORY_SCOPE_WORKGROUP);
                    info_e[tl * 4 + lane] = (sel << 20) | (int)slot; info_g[tl * 4 + lane] = gg;
                }
                asm volatile("s_waitcnt lgkmcnt(0)" ::: "memory");
            }
        }
        __syncthreads();
        if (tid < 32) basew[tid] = __hip_atomic_fetch_add(gcnt + tid, cnt[tid], __ATOMIC_RELAXED, __HIP_MEMORY_SCOPE_AGENT);
        __syncthreads();
        if (tid < 256) { const int ie = info_e[tid]; const int ee = ie >> 20, slot = ie & 0xfffff;
            const int fs = (int)(basew[ee] + (unsigned)slot);
            toki[(size_t)tile * 256 + tid] = (ee << 20) | fs; tokg[(size_t)tile * 256 + tid] = info_g[tid]; ((int*)(F.ws + WS_INV))[ee * SEQ + fs] = tile * 64 + (tid >> 2); }
        __syncthreads();
    }
}
DI void phase_gather8(Frame& F, int l) {
    const int tid = F.tid, lane = F.lane, wave = F.wave;
    LAS int* offs = (LAS int*)F.lds;
    if (tid == 0) { int run = 0; const unsigned* gcnt = F.ctl + CW_ECNT + 64 * l;
        for (int e = 0; e < NEXP; ++e) { const int c = (int)__hip_atomic_load(gcnt + e, __ATOMIC_RELAXED, __HIP_MEMORY_SCOPE_AGENT); offs[e] = run; run += ((c + 255) / 256) * 256; }
        offs[32] = run; }
    __syncthreads();
    const int* toki = (const int*)(F.ws + WS_TOKI);
    const unsigned char* h8 = (const unsigned char*)(F.ws + WS_H8); unsigned char* xs = (unsigned char*)(F.ws + WS_XS);
    const int gw = blockIdx.x * NWAVES + wave, NGW = F.G * NWAVES;
#pragma unroll 4
    for (int item = gw; item < SEQ * TOPK; item += NGW) {
        const int ie = toki[item], ee = ie >> 20, slot = ie & 0xfffff, tok = item >> 2;
        const size_t row = (size_t)offs[ee] + slot;
        *((u32x4*)(xs + row * DM) + lane) = *((const u32x4*)(h8 + (size_t)tok * DM) + lane);
    }
}
constexpr int ETAB_OFF = 131072;
DI void build_expert_tables(Frame& F, int l) {
    LAS int* tile_e = (LAS int*)(F.lds + ETAB_OFF); LAS int* tile0 = tile_e + 512; LAS int* ecnt = tile0 + 32;
    if (F.tid == 0) { int run = 0; const unsigned* gcnt = F.ctl + CW_ECNT + 64 * l;
        int* goff = (int*)(F.ws + WS_META + META_OFF) + l * 64; int* gtile = (int*)(F.ws + WS_META + META_TILE) + l * 512;
        for (int e = 0; e < NEXP; ++e) { const int c = (int)__hip_atomic_load(gcnt + e, __ATOMIC_RELAXED, __HIP_MEMORY_SCOPE_AGENT); ecnt[e] = c; tile0[e] = run >> 8;
            for (int i = 0; i < (c + 255) / 256; ++i) tile_e[(run >> 8) + i] = e;
            if (blockIdx.x == 0) { goff[e] = run; for (int i = 0; i < (c + 255) / 256; ++i) gtile[(run >> 8) + i] = e; }
            run += ((c + 255) / 256) * 256; }
        tile_e[511] = run >> 8; if (blockIdx.x == 0) { goff[32] = run; gtile[511] = run >> 8; } }
    __syncthreads();
}
DI void phase_combine(Frame& F, int l) {
    const int lane = F.lane;
    const float* mod = (const float*)(F.ws + WS_META + META_MOD) + l * 6144;
    const int* goff = (const int*)(F.ws + WS_META + META_OFF) + l * 64;
    const int* toki = (const int*)(F.ws + WS_TOKI); const float* tokg = (const float*)(F.ws + WS_TOKI + 256 * 1024);
    const float* x1 = (const float*)(F.ws + WS_X1); const bf16_t* y2 = (const bf16_t*)(F.ws + WS_Y2);
    float* xo = (l == NLAYER - 1) ? F.ap->out : (float*)(F.ws + WS_XC);
    const int gw = blockIdx.x * NWAVES + F.wave, NGW = F.G * NWAVES;
    for (int i0 = 0; gw + NGW * i0 < SEQ; i0 += 8) {
    int myrow = 0; float mygate = 0.f;
    if (lane < 32) { const int tok = gw + NGW * (i0 + (lane >> 2)); if (tok < SEQ) { const int ie = toki[tok * 4 + (lane & 3)]; mygate = tokg[tok * 4 + (lane & 3)]; myrow = goff[ie >> 20] + (ie & 0xfffff); } }
    for (int i = 0; i < 8; i += 2) {
        const int tokA = gw + NGW * (i0 + i); if (tokA >= SEQ) break;
        const int tokB0 = gw + NGW * (i0 + i + 1); const bool hasB = tokB0 < SEQ; const int tokB = hasB ? tokB0 : tokA;
        u32x2 ya[4][4], yb[4][4]; f32x4 xa[4], xb[4]; float ga[4], gb[4];
#pragma unroll
        for (int k = 0; k < 4; ++k) {
            const int rowA = __shfl(myrow, 4 * i + k), rowB = __shfl(myrow, hasB ? 4 * i + 4 + k : 4 * i + k); ga[k] = __shfl(mygate, 4 * i + k); gb[k] = __shfl(mygate, hasB ? 4 * i + 4 + k : 4 * i + k);
            const u32x2* pa = (const u32x2*)(y2 + (size_t)rowA * DM) + lane; const u32x2* pb = (const u32x2*)(y2 + (size_t)rowB * DM) + lane;
#pragma unroll
            for (int j = 0; j < 4; ++j) { ya[k][j] = pa[64 * j]; yb[k][j] = pb[64 * j]; }
        }
#pragma unroll
        for (int j = 0; j < 4; ++j) { const int c = 4 * lane + 256 * j; xa[j] = *(const f32x4*)(x1 + (size_t)tokA * DM + c); xb[j] = *(const f32x4*)(x1 + (size_t)tokB * DM + c); }
#pragma unroll
        for (int r = 0; r < 2; ++r) {
            if (r == 1 && !hasB) break;
            const int tok = r ? tokB : tokA;
            f32x4 v[4];
#pragma unroll
            for (int j = 0; j < 4; ++j) { const int c = 4 * lane + 256 * j;
                f32x4 acc = (f32x4){0.f, 0.f, 0.f, 0.f};
#pragma unroll
                for (int k = 0; k < 4; ++k) { const u32x2 w = r ? yb[k][j] : ya[k][j]; const float g = r ? gb[k] : ga[k];
                    acc.x += g * bf2f((bf16_t)(w.x & 0xffffu)); acc.y += g * bf2f((bf16_t)(w.x >> 16)); acc.z += g * bf2f((bf16_t)(w.y & 0xffffu)); acc.w += g * bf2f((bf16_t)(w.y >> 16)); }
                const f32x4 g2 = *(const f32x4*)(mod + 5 * DM + c);
                v[j] = (r ? xb[j] : xa[j]) + g2 * acc;
                *(f32x4*)(xo + (size_t)tok * DM + c) = v[j]; }
            if (l + 1 < NLAYER) { const float* mod1 = (const float*)(F.ws + WS_META + META_MOD) + (l + 1) * 6144;
                norm_mod_store(v, F.in(I_N1G) + (l + 1) * DM, mod1 + 1 * DM, mod1 + 0 * DM, (bf16_t*)(F.ws + WS_H) + (size_t)tok * DM, lane); }
        }
    }
    }
}

#ifndef PH_MASK
#define PH_MASK 0xFFFFF
#endif
#define PHON(k) (((PH_MASK) >> (k)) & 1)
#ifndef REP_MASK
#define REP_MASK 0
#endif
#define NREP(k) ((((REP_MASK) >> (k)) & 1) ? 2 : 1)
constexpr int N_PHASES = 2 + 11 * NLAYER;
__global__ void __launch_bounds__(NTHREADS, 2) mk_fwd(Args args) {
    extern __shared__ __attribute__((aligned(16))) unsigned char lds_raw[];
    Frame F;
    F.lds = (LAS unsigned char*)lds_raw; F.ws = args.ws; F.ctl = (unsigned*)(args.ws + WS_CTL);
    F.ap = (KArgP)__builtin_amdgcn_kernarg_segment_ptr();
    F.refresh(); F.G = gridDim.x;
    volatile LAS unsigned* MISC = (volatile LAS unsigned*)(F.lds + LDSCTL_OFF);
    for (int u = F.tid; u < (LDS_BYTES - LDSCTL_OFF) / 4; u += NTHREADS) MISC[u] = 0u;
    __syncthreads();
    const int lo = args.ph_lo, hi = args.ph_hi;
    XcdBarrier bar; bar.bar = F.ctl + CW_BAR; bar.x = 0; bar.st = MISC + 8;
    if (hi - lo > 1) bar = xcd_barrier_post(F.ctl + CW_BAR, MISC + 8);
#define IN(k) (lo <= (k) && (k) < hi)
#define SEAM(k) do { if (IN(k) && IN((k) + 1)) xcd_barrier(bar); } while (0)
    for (int rep = 0; rep < NREP(0); ++rep) if (PHON(0) && IN(0)) { if (rep) xcd_barrier(bar); F.refresh(); phase_prologue(F); }
    SEAM(0);
    for (int rep = 0; rep < NREP(1); ++rep) if (PHON(1) && IN(1)) { if (rep) xcd_barrier(bar); F.refresh(); phase_norm1_l0(F); }
    SEAM(1);
#ifdef EXTRA_BARS
    for (int xb = 0; xb < EXTRA_BARS; ++xb) xcd_barrier(bar);
#endif
    for (int l = 0; l < NLAYER; ++l) {
        const int pb = 2 + 11 * l;
        const float* mod = (const float*)(F.ws + WS_META + META_MOD) + l * 6144;
        for (int rep = 0; rep < NREP(2); ++rep) if (PHON(2) && IN(pb + 0)) { if (rep) xcd_barrier(bar);
            pg8::Gemm g{(const pg8::bf16_t*)(F.ws + WS_H), (const pg8::bf16_t*)(F.ws + WS_W1T) + (size_t)l * NP * DM, SEQ, NP, DM};
            pg8::StaticOrder S; S.init(SEQ, NP, F.G, (int)blockIdx.x);
            pg8::EpiBf16Plain E{(pg8::bf16_t*)(F.ws + WS_PROJ), NP};
            pg8::gemm_phase<pg8::EpiBf16Plain, pg8::StaticOrder>(F.lds, g, S, E, nullptr);
        }
        SEAM(pb + 0);
        for (int rep = 0; rep < NREP(3); ++rep) if (PHON(3) && IN(pb + 1)) { if (rep) xcd_barrier(bar); F.refresh(); phase_postproj(F, l); }
        SEAM(pb + 1);
        for (int rep = 0; rep < NREP(4); ++rep) if (PHON(4) && IN(pb + 2)) { if (rep) xcd_barrier(bar); F.refresh(); phase_attention(F, l, rep); }
        SEAM(pb + 2);
        for (int rep = 0; rep < NREP(5); ++rep) if (PHON(5) && IN(pb + 3)) { if (rep) xcd_barrier(bar); F.refresh(); phase_moba_items(F, l, rep); }
        SEAM(pb + 3);
        for (int rep = 0; rep < NREP(6); ++rep) if (PHON(6) && IN(pb + 4)) { if (rep) xcd_barrier(bar); F.refresh(); phase_moba_combine(F); }
        SEAM(pb + 4);
        for (int rep = 0; rep < NREP(7); ++rep) if (PHON(7) && IN(pb + 5)) { if (rep) xcd_barrier(bar);
            pg8::Gemm g{(const pg8::bf16_t*)(F.ws + WS_O), (const pg8::bf16_t*)(F.ws + WS_WOT) + (size_t)l * DM * DM, SEQ, DM, DM};
            pg8::StaticOrder S; S.init(SEQ, DM, F.G, (int)blockIdx.x);
            EpiGateRes E{(l == 0) ? F.in(I_X) : (const float*)(F.ws + WS_XC), (float*)(F.ws + WS_X1), mod + 2 * DM};
            pg8::gemm_phase<EpiGateRes, pg8::StaticOrder>(F.lds, g, S, E, nullptr);
        }
        SEAM(pb + 5);
        for (int rep = 0; rep < NREP(8); ++rep) if (PHON(8) && IN(pb + 6)) { if (rep) xcd_barrier(bar); F.refresh(); phase_router(F, l); }
        SEAM(pb + 6);
#ifndef GATHER8_PHASE
#define GATHER8_PHASE 0
#endif
        for (int rep = 0; rep < NREP(9); ++rep) if (UP_FP8 && GATHER8_PHASE && PHON(9) && IN(pb + 7)) { if (rep) xcd_barrier(bar); F.refresh(); phase_gather8(F, l); }
        if (UP_FP8 && GATHER8_PHASE) SEAM(pb + 7);
#ifndef FUSE_UPDOWN
#define FUSE_UPDOWN 0
#endif
        for (int rep = 0; rep < NREP(10); ++rep) if (PHON(10) && IN(pb + 8)) { if (rep) xcd_barrier(bar);
            F.refresh(); build_expert_tables(F, l);
            const LAS int* ltile = (const LAS int*)(F.lds + ETAB_OFF);
            unsigned* ycnt = F.ctl + CW_YCNT + 32768 * l + 16384 * rep;
            {
            pg8::Gemm g{(const pg8::bf16_t*)(F.ws + (UP_FP8 ? (GATHER8_PHASE ? WS_XS : WS_H8) : WS_H)), (const pg8::bf16_t*)(F.ws + WS_WE1 + (size_t)l * NEXP * 2048 * DM * (UP_FP8 ? 1 : 2)), (UP_FP8 && GATHER8_PHASE) ? MAXROWS : SEQ, NEXP * 2048, DM};
            GroupedOrder S{ltile, ltile[511], 8, F.G, (int)blockIdx.x, ltile + 512, ltile + 544, (const int*)(F.ws + WS_INV), ycnt, FUSE_UPDOWN ? 1 : 0, F.ctl};
            typedef EpiSwigluT<(FUSE_UPDOWN != 0)> EpiSwiglu; EpiSwiglu E{(bf16_t*)(F.ws + WS_Y1), F.in(I_EB1) + (size_t)l * NEXP * 2048};
            pg8::gemm_phase<EpiSwiglu, GroupedOrder, false, !(UP_FP8 && GATHER8_PHASE), UP_FP8 ? 1 : 2>(F.lds, g, S, E, nullptr);
            }
            if (FUSE_UPDOWN) {
            unsigned ldsb = (unsigned)(size_t)F.lds, tb = (unsigned)(size_t)ltile; unsigned long long yc = (unsigned long long)ycnt;
            asm volatile("" : "+s"(ldsb), "+s"(tb), "+s"(yc));
            LAS unsigned char* lds2 = (LAS unsigned char*)(size_t)ldsb; const LAS int* ltile2 = (const LAS int*)(size_t)tb; unsigned* ycnt2 = (unsigned*)yc;
            pg8::Gemm g{(const pg8::bf16_t*)(F.ws + WS_Y1), (const pg8::bf16_t*)(F.ws + WS_WE2 + (size_t)l * NEXP * DM * FEXP * (MOE_FP8 ? 1 : 2)), MAXROWS, NEXP * DM, FEXP};
            GroupedOrder S{ltile2, ltile2[511], 4, F.G, F.G - 1 - (int)blockIdx.x, ltile2 + 512, ltile2 + 544, nullptr, ycnt2, 2, F.ctl};
            EpiDown E{(bf16_t*)(F.ws + WS_Y2), F.in(I_EB2) + (size_t)l * NEXP * DM};
            pg8::gemm_phase<EpiDown, GroupedOrder, false, false, MOE_FP8 ? 1 : 2>(lds2, g, S, E, nullptr);
            }
        }
        SEAM(pb + 8);
        for (int rep = 0; rep < NREP(11); ++rep) if (!FUSE_UPDOWN && PHON(11) && IN(pb + 9)) { if (rep) xcd_barrier(bar);
            F.refresh(); build_expert_tables(F, l);
            const LAS int* ltile = (const LAS int*)(F.lds + ETAB_OFF);
            pg8::Gemm g{(const pg8::bf16_t*)(F.ws + WS_Y1), (const pg8::bf16_t*)(F.ws + WS_WE2 + (size_t)l * NEXP * DM * FEXP * (MOE_FP8 ? 1 : 2)), MAXROWS, NEXP * DM, FEXP};
            GroupedOrder S{ltile, ltile[511], 4, F.G, (int)blockIdx.x, ltile + 512, ltile + 544, nullptr, nullptr, 0, F.ctl};
            EpiDown E{(bf16_t*)(F.ws + WS_Y2), F.in(I_EB2) + (size_t)l * NEXP * DM};
            pg8::gemm_phase<EpiDown, GroupedOrder, false, false, MOE_FP8 ? 1 : 2>(F.lds, g, S, E, nullptr);
        }
        if (!FUSE_UPDOWN)
        SEAM(pb + 9);
        for (int rep = 0; rep < NREP(12); ++rep) if (PHON(12) && IN(pb + 10)) { if (rep) xcd_barrier(bar); F.refresh(); phase_combine(F, l); }
        SEAM(pb + 10);
    }
#undef IN
#undef SEAM
}

#ifndef MK_PER_PHASE
#define MK_PER_PHASE 0
#endif
extern "C" void kernel_launch(void* const* d_in, const int* in_sizes, int n_in, void* d_out, int out_size, void* d_ws, size_t ws_size, hipStream_t stream) {
    static int grid = 0;
    if (grid == 0) {
        if (n_in != 27 || out_size != SEQ * DM || ws_size < WS_END) { fprintf(stderr, "kernel_launch: unexpected shapes (n_in %d, out %d, ws %zu)\n", n_in, out_size, ws_size); grid = -1; return; }
        int dev = 0, cus = 0, per_cu = 0;
        if (hipGetDevice(&dev) != hipSuccess || hipDeviceGetAttribute(&cus, hipDeviceAttributeMultiprocessorCount, dev) != hipSuccess) { grid = -1; return; }
        if (hipFuncSetAttribute((const void*)mk_fwd, hipFuncAttributeMaxDynamicSharedMemorySize, LDS_BYTES) != hipSuccess) { fprintf(stderr, "kernel_launch: hipFuncSetAttribute failed\n"); grid = -1; return; }
        if (hipOccupancyMaxActiveBlocksPerMultiprocessor(&per_cu, (const void*)mk_fwd, NTHREADS, LDS_BYTES) != hipSuccess || per_cu < 1) fprintf(stderr, "kernel_launch: occupancy query reports %d\n", per_cu);
        (void)hipGetLastError();
        grid = cus - (cus % 8);
    }
    if (grid < 0) return;
    (void)in_sizes;
    if (hipMemsetAsync((char*)d_ws + WS_CTL, 0, CTL_ZERO_BYTES, stream) != hipSuccess) return;
    Args a{};
    for (int i = 0; i < 27; ++i) a.in[i] = (const float*)d_in[i];
    a.out = (float*)d_out; a.ws = (unsigned char*)d_ws;
#if MK_PER_PHASE
    for (int p = 0; p < N_PHASES; ++p) { a.ph_lo = p; a.ph_hi = p + 1; hipLaunchKernelGGL(mk_fwd, dim3(grid), dim3(NTHREADS), LDS_BYTES, stream, a); }
#else
    a.ph_lo = 0; a.ph_hi = N_PHASES;
    hipLaunchKernelGGL(mk_fwd, dim3(grid), dim3(NTHREADS), LDS_BYTES, stream, a);
#endif
}
```

```cpp
#include <hip/hip_runtime.h>
#include <stdint.h>
#include <math.h>
#include <cstdio>
#include <type_traits>

#define DI __device__ __forceinline__
#define LAS __attribute__((address_space(3)))
#define GAS __attribute__((address_space(1)))
namespace pg8 {
#define PG8_LAS __attribute__((address_space(3)))
typedef unsigned short bf16_t;
typedef short bf16x8 __attribute__((ext_vector_type(8)));
typedef float f32x4 __attribute__((ext_vector_type(4)));
typedef unsigned u32x4 __attribute__((ext_vector_type(4)));
constexpr int BM = 256, BK = 64, HALF = 128, HTB = HALF * BK * 2  , STAGE_BYTES = 8 * HTB, NXCD = 8, WGM = 8;

__host__ __device__ __forceinline__ int lds_byte(int r, int c) { const int st = (r >> 4) * 2 + (c >> 5), rr = r & 15, cc = c & 31, ob = rr * 64 + cc * 2; return st * 1024 + (ob ^ (((ob >> 9) & 1) << 5)); }
__host__ __device__ __forceinline__ void stage_rc(int b, int& R, int& C) { const int st = b / 1024, sb = b % 1024, swz = sb ^ (((sb >> 9) & 1) << 5); R = (st >> 1) * 16 + swz / 64; C = (st & 1) * 32 + (swz % 64) / 2; }
__host__ __device__ __forceinline__ int perm32(int rho) { const int n = rho >> 4, i = rho & 15; return 8 * (i >> 2) + 4 * n + (i & 3); }

struct Unit { int pm, pn; };
struct Gemm { const bf16_t* A; const bf16_t* Bt; int M, N, K; };

struct StaticOrder {
    int nM, nN, nwg, G, c;
    __host__ __device__ void init(int M, int N, int G_, int c_) { nM = M / BM; nN = N / BM; nwg = nM * nN; G = G_; c = c_; }
    __host__ __device__ bool next(int i, Unit& u) const {
        const long L = (long)i * G + c; if (L >= nwg) return false;
        int wgid = (int)L; { const int q = nwg / NXCD, r = nwg % NXCD, xcd = wgid % NXCD, off = wgid / NXCD; wgid = (xcd < r ? xcd * (q + 1) : r * (q + 1) + (xcd - r) * q) + off; }
        const int nig = WGM * nN, gid = wgid / nig, fm = gid * WGM, gsz = (nM - fm) < WGM ? (nM - fm) : WGM;
        u.pm = fm + ((wgid % nig) % gsz); u.pn = (wgid % nig) / gsz; return true;
    }
    __device__ __forceinline__ void a_ready(const Unit&) const {}
    __device__ __forceinline__ void done(const Unit&) const {}
};
__device__ __forceinline__ unsigned cvt_pk_bf16(float lo, float hi) { unsigned r; asm volatile("v_cvt_pk_bf16_f32 %0, %1, %2" : "=v"(r) : "v"(lo), "v"(hi)); return r; }
typedef float f32x2 __attribute__((ext_vector_type(2)));
struct EpiBf16Plain {
    static constexpr bool PERM = true, AFTER_DRAIN = false;
    bf16_t* O; int ldc;
    __device__ __forceinline__ void operator()(const f32x4 (&acc)[2][2][4][2], const Unit& u, int wr, int wc, int fr, int fq) const {
        const int row0 = u.pm * BM + wr * 64 + fr, col0 = u.pn * BM + wc * 32 + 8 * fq;
#pragma unroll
        for (int ai = 0; ai < 2; ++ai)
#pragma unroll
            for (int m = 0; m < 4; ++m) { bf16_t* rowp = O + (size_t)(row0 + ai * HALF + m * 16) * ldc + col0;
#pragma unroll
                for (int bj = 0; bj < 2; ++bj) { const f32x4 v0 = acc[ai][bj][m][0], v1 = acc[ai][bj][m][1];
                    u32x4 w; w.x = cvt_pk_bf16(v0[0], v0[1]); w.y = cvt_pk_bf16(v0[2], v0[3]); w.z = cvt_pk_bf16(v1[0], v1[1]); w.w = cvt_pk_bf16(v1[2], v1[3]);
                    *(u32x4*)(rowp + bj * HALF) = w; } }
    }
};
template <class Epi, class Sched, bool STAMP = false, bool GATHER = false, int ESZ = 2>
__device__ __forceinline__ void gemm_phase(PG8_LAS unsigned char* lds, const Gemm g, const Sched& S, const Epi& E, unsigned long long* stamps) {
    int tid_ = threadIdx.x; asm volatile("" : "+v"(tid_));
    const int tid = tid_, wid = __builtin_amdgcn_readfirstlane(tid >> 6), lane = tid & 63, wr = wid >> 2, wc = wid & 3, fr = lane & 15, fq = lane >> 4;
    const int K = g.K, Kb = K * ESZ  , nt = Kb / (BK * 2);
    int ts_lo = 0, ts_hi = 0, nts = 0; const unsigned long long rt_entry = STAMP ? (unsigned long long)wall_clock64() : 0ull;
#define PG8_STAMP() do { if (STAMP && wid == 0 && nts < 64) { const unsigned long long _c = (unsigned long long)clock64(); \
        ts_lo = (lane == nts) ? (int)(unsigned)_c : ts_lo; ts_hi = (lane == nts) ? (int)(unsigned)(_c >> 32) : ts_hi; ++nts; } } while (0)
    PG8_STAMP();
    unsigned voffA[2], voffB[2];
    int gaR[2]; unsigned gaC2[2];
#pragma unroll
    for (int i = 0; i < 2; ++i) { int R, C; stage_rc(tid * 16 + i * 8192, R, C); const int Rb = Epi::PERM ? ((R & ~31) + perm32(R & 31)) : R;
        voffA[i] = (unsigned)(R * Kb + C * 2); voffB[i] = (unsigned)(Rb * Kb + C * 2); gaR[i] = R; gaC2[i] = (unsigned)C * 2u; }
    unsigned gaCur[2][2], gaNxt[2][2];
#define PG8_GAFILL(dst, u_) do { _Pragma("unroll") for (int h_ = 0; h_ < 2; ++h_) _Pragma("unroll") for (int i_ = 0; i_ < 2; ++i_) dst[h_][i_] = (unsigned)S.arow(u_, h_ * HALF + gaR[i_]) * (unsigned)Kb + gaC2[i_]; } while (0)
#define PG8_STAGE_A(bufoff, kb_, h_, nx_) do { if constexpr (GATHER) { _Pragma("unroll") for (int _i = 0; _i < 2; ++_i) \
        __builtin_amdgcn_global_load_lds((const unsigned*)((const char*)g.A + (kb_) + ((nx_) ? gaNxt[h_][_i] : gaCur[h_][_i])), (PG8_LAS unsigned*)(lds + (bufoff) + ldsw + _i * 8192), 16, 0, 0); } \
        else { PG8_STAGE(bufoff, ((nx_) ? nA : cA) + (kb_) + (h_) * hstep, voffA); } } while (0)
    const size_t kstep = (size_t)(BK * 2);
    const size_t hstep = (size_t)HALF * Kb;
    const size_t tstep = 2 * hstep;
    const unsigned ldsw = (unsigned)wid * 1024u;
    constexpr int KOFF = (ESZ == 2) ? 1024 : 16;
    int mxscale = 0x7F7F7F7F; asm volatile("" : "+v"(mxscale));
    const int aoff = lds_byte(wr * 64 + fr, ESZ == 2 ? fq * 8 : fq * 16), boff = lds_byte(wc * 32 + fr, ESZ == 2 ? fq * 8 : fq * 16);
#define PG8_SA(b, h) (((b) * 2 + (h)) * HTB)
#define PG8_SB(b, h) ((4 + (b) * 2 + (h)) * HTB)
#define PG8_STAGE(bufoff, gbase, voff) do { _Pragma("unroll") for (int _i = 0; _i < 2; ++_i) \
        __builtin_amdgcn_global_load_lds((const unsigned*)((const char*)(gbase) + (voff)[_i]), (PG8_LAS unsigned*)(lds + (bufoff) + ldsw + _i * 8192), 16, 0, 0); } while (0)
#define PG8_LDA(dst, b, h) do { _Pragma("unroll") for (int m = 0; m < 4; ++m) _Pragma("unroll") for (int k = 0; k < 2; ++k) dst[m][k] = *(const PG8_LAS bf16x8*)(lds + PG8_SA(b, h) + aoff + m * 2048 + k * KOFF); } while (0)
#define PG8_LDB(dst, b, h) do { _Pragma("unroll") for (int n = 0; n < 2; ++n) _Pragma("unroll") for (int k = 0; k < 2; ++k) dst[n][k] = *(const PG8_LAS bf16x8*)(lds + PG8_SB(b, h) + boff + n * 2048 + k * KOFF); } while (0)
#define PG8_MMA(ai, bj, At, Bt) do { __builtin_amdgcn_s_setprio(1); _Pragma("unroll") for (int m = 0; m < 4; ++m) _Pragma("unroll") for (int n = 0; n < 2; ++n) { \
        if constexpr (ESZ == 2) { _Pragma("unroll") for (int k = 0; k < 2; ++k) acc[ai][bj][m][n] = __builtin_amdgcn_mfma_f32_16x16x32_bf16(Bt[n][k], At[m][k], acc[ai][bj][m][n], 0, 0, 0); } \
        else { typedef int i32x4_ __attribute__((ext_vector_type(4))); typedef int i32x8_ __attribute__((ext_vector_type(8))); \
            const i32x8_ b8_ = __builtin_shufflevector(__builtin_bit_cast(i32x4_, Bt[n][0]), __builtin_bit_cast(i32x4_, Bt[n][1]), 0, 1, 2, 3, 4, 5, 6, 7); \
            const i32x8_ a8_ = __builtin_shufflevector(__builtin_bit_cast(i32x4_, At[m][0]), __builtin_bit_cast(i32x4_, At[m][1]), 0, 1, 2, 3, 4, 5, 6, 7); \
            asm volatile("v_mfma_scale_f32_16x16x128_f8f6f4 %0, %1, %2, %0, %3, %3 op_sel_hi:[0,0,0]" : "+v"(acc[ai][bj][m][n]) : "v"(b8_), "v"(a8_), "v"(mxscale)); } } \
        __builtin_amdgcn_s_setprio(0); } while (0)
#define PG8_WAIT_V(n) asm volatile("s_waitcnt vmcnt(" #n ")" ::: "memory")
#define PG8_WAIT_L(n) asm volatile("s_waitcnt lgkmcnt(" #n ")" ::: "memory")
#define PG8_BAR __builtin_amdgcn_s_barrier()
#define PG8_SCHED __builtin_amdgcn_sched_barrier(0)
    Unit cur, nxt; int ui = 0;
    if (!S.next(0, cur)) return;
    f32x4 acc[2][2][4][2];
#pragma unroll
    for (int a = 0; a < 2; ++a)
#pragma unroll
        for (int b = 0; b < 2; ++b)
#pragma unroll
            for (int m = 0; m < 4; ++m)
#pragma unroll
                for (int n = 0; n < 2; ++n) acc[a][b][m][n] = (f32x4){0.f, 0.f, 0.f, 0.f};
    bf16x8 At[4][2], B0[2][2], B1[2][2];
    const char* cA = (const char*)g.A + (size_t)cur.pm * tstep; const char* cB = (const char*)g.Bt + (size_t)cur.pn * tstep;
    S.a_ready(cur);
    const char* nA = cA; if constexpr (GATHER) { PG8_GAFILL(gaCur, cur); _Pragma("unroll") for (int h_ = 0; h_ < 2; ++h_) _Pragma("unroll") for (int i_ = 0; i_ < 2; ++i_) gaNxt[h_][i_] = gaCur[h_][i_]; }
    PG8_STAGE(PG8_SB(0, 0), cB, voffB); PG8_STAGE_A(PG8_SA(0, 0), 0, 0, false); PG8_STAGE(PG8_SB(0, 1), cB + hstep, voffB); PG8_STAGE_A(PG8_SA(0, 1), 0, 1, false);
    if (wr == 1) PG8_BAR;
    PG8_WAIT_V(4); PG8_BAR;
    PG8_STAGE(PG8_SB(1, 0), cB + kstep, voffB); PG8_STAGE_A(PG8_SA(1, 0), kstep, 0, false); PG8_STAGE(PG8_SB(1, 1), cB + hstep + kstep, voffB);
    PG8_WAIT_V(6); PG8_BAR;
    PG8_STAMP();
    for (;;) {
        const bool has_next = S.next(ui + 1, nxt);
        nA = has_next ? (const char*)g.A + (size_t)nxt.pm * tstep : cA; const char* nB = has_next ? (const char*)g.Bt + (size_t)nxt.pn * tstep : cB;
        if constexpr (GATHER) { if (has_next && ui == 0) PG8_GAFILL(gaNxt, nxt); }
        for (int t = 0; t < nt; t += 2) {
            const bool last = (t == nt - 2);
            const size_t ka1 = (size_t)(t + 1) * kstep;
            const size_t ka2 = last ? 0 : (size_t)(t + 2) * kstep; const char* b2 = last ? nB : cB + (size_t)(t + 2) * kstep;
            const size_t ka3 = ka2 + kstep; const char* b3 = b2 + kstep;
            const bool nxa = last && has_next;
            if (last && has_next) S.a_ready(nxt);
            PG8_LDB(B0, 0, 0); PG8_SCHED; PG8_LDA(At, 0, 0); PG8_STAGE_A(PG8_SA(1, 1), ka1, 1, false);
            PG8_WAIT_L(8); PG8_BAR; PG8_WAIT_L(0); PG8_MMA(0, 0, At, B0); PG8_BAR; PG8_SCHED;
            PG8_LDB(B1, 0, 1); PG8_STAGE(PG8_SB(0, 0), b2, voffB);
            PG8_BAR; PG8_WAIT_L(0); PG8_MMA(0, 1, At, B1); PG8_BAR;
            PG8_LDA(At, 0, 1); PG8_STAGE_A(PG8_SA(0, 0), ka2, 0, nxa);
            PG8_BAR; PG8_WAIT_L(0); PG8_MMA(1, 0, At, B0); PG8_BAR; PG8_SCHED;
            PG8_STAGE(PG8_SB(0, 1), b2 + hstep, voffB);
            PG8_WAIT_V(6); PG8_BAR; PG8_MMA(1, 1, At, B1); PG8_BAR;
            PG8_LDB(B0, 1, 0); PG8_SCHED; PG8_LDA(At, 1, 0); PG8_STAGE_A(PG8_SA(0, 1), ka2, 1, nxa);
            PG8_WAIT_L(8); PG8_BAR; PG8_WAIT_L(0); PG8_MMA(0, 0, At, B0); PG8_BAR; PG8_SCHED;
            PG8_LDB(B1, 1, 1); PG8_STAGE(PG8_SB(1, 0), b3, voffB);
            PG8_BAR; PG8_WAIT_L(0); PG8_MMA(0, 1, At, B1); PG8_BAR;
            PG8_LDA(At, 1, 1); PG8_STAGE_A(PG8_SA(1, 0), ka3, 0, nxa);
            PG8_BAR; PG8_WAIT_L(0); PG8_MMA(1, 0, At, B0); PG8_BAR; PG8_SCHED;
            PG8_STAGE(PG8_SB(1, 1), b3 + hstep, voffB);
            PG8_WAIT_V(6); PG8_BAR; PG8_MMA(1, 1, At, B1); PG8_BAR;
        }
        PG8_STAMP();
        if constexpr (GATHER) { Unit n2_; if (has_next && S.next(ui + 2, n2_)) PG8_GAFILL(gaCur, n2_); }
        if constexpr (ESZ == 1) asm volatile("s_nop 15\n\ts_nop 15\n\ts_nop 7" ::: "memory");
        if constexpr (!Epi::AFTER_DRAIN) { E(acc, cur, wr, wc, fr, fq); S.done(cur); }
        PG8_STAMP();
        if (!has_next) break;
#pragma unroll
        for (int a = 0; a < 2; ++a)
#pragma unroll
            for (int b = 0; b < 2; ++b)
#pragma unroll
                for (int m = 0; m < 4; ++m)
#pragma unroll
                    for (int n = 0; n < 2; ++n) acc[a][b][m][n] = (f32x4){0.f, 0.f, 0.f, 0.f};
        cur = nxt; cA = nA; cB = nB; ++ui;
        if constexpr (GATHER) { _Pragma("unroll") for (int h_ = 0; h_ < 2; ++h_) _Pragma("unroll") for (int i_ = 0; i_ < 2; ++i_) { const unsigned t_ = gaCur[h_][i_]; gaCur[h_][i_] = gaNxt[h_][i_]; gaNxt[h_][i_] = t_; } }
    }
    PG8_WAIT_V(0);
    if (wr == 0) PG8_BAR;
    PG8_BAR;
    if constexpr (Epi::AFTER_DRAIN) { E.fused(acc, cur, wr, wc, fr, fq, lds, wid, lane); S.done(cur); }
    PG8_STAMP();
    if (STAMP && wid == 0) { stamps[lane] = lane < nts ? (((unsigned long long)(unsigned)ts_hi << 32) | (unsigned)ts_lo) : 0ull;
        if (lane == 62) stamps[62] = rt_entry; if (lane == 63) stamps[63] = (unsigned long long)wall_clock64(); }
#undef PG8_STAMP
#undef PG8_SA
#undef PG8_SB
#undef PG8_STAGE
#undef PG8_STAGE_A
#undef PG8_GAFILL
#undef PG8_LDA
#undef PG8_LDB
#undef PG8_MMA
#undef PG8_WAIT_V
#undef PG8_WAIT_L
#undef PG8_BAR
#undef PG8_SCHED
}
}

#define XB_TMO      128
#define XB_XCNT(j)  (256  + 64 * (j))
#define XB_XSUB(j)  (1280 + 64 * (j))
#define XB_XGEN(j)  (2304 + 64 * (j))
#define XB_TOP      3328
#define XB_TOPGEN   3392
#define XCD_BAR_WORDS 3456
#define XB_SPIN_CAP (1u << 24)
#define LAS __attribute__((address_space(3)))

__device__ __forceinline__ unsigned xb_ld(unsigned* p)              { return __hip_atomic_load(p, __ATOMIC_RELAXED, __HIP_MEMORY_SCOPE_AGENT); }
__device__ __forceinline__ unsigned xb_add(unsigned* p, unsigned v) { return __hip_atomic_fetch_add(p, v, __ATOMIC_RELAXED, __HIP_MEMORY_SCOPE_AGENT); }
__device__ __forceinline__ unsigned xb_xcc_id() { return (unsigned)__builtin_amdgcn_s_getreg((3 << 11) | 20) & 0xFu; }
#define XB_SPIN(cond, bar) do { unsigned _sp = 0; while (cond) { __builtin_amdgcn_s_sleep(1); \
    if ((++_sp & 255u) == 0u) { if (xb_ld(&(bar)[XB_TMO])) break; if (_sp > XB_SPIN_CAP) { atomicAdd(&(bar)[XB_TMO], 1u); break; } } } } while (0)

struct XcdBarrier {
    unsigned* bar; unsigned x;
    volatile LAS unsigned* st;
};

__device__ __forceinline__ XcdBarrier xcd_barrier_post(unsigned* bar, volatile LAS unsigned* st) {
    XcdBarrier b; b.bar = bar; b.x = xb_xcc_id(); b.st = st;
    if (threadIdx.x == 0) (void)xb_add(&bar[XB_XCNT(b.x)], 1u);
    return b;
}
__device__ __forceinline__ void xcd_barrier_complete(unsigned* bar, unsigned x, unsigned& nloc, unsigned& nx) {
    const unsigned G = gridDim.x * gridDim.y * gridDim.z;
    unsigned sum, cnt, mine, sp = 0u;
    for (;;) {
        sum = 0u; cnt = 0u; mine = 0u;
#pragma unroll
        for (unsigned j = 0; j < 16; ++j) { const unsigned c = xb_ld(&bar[XB_XCNT(j)]); sum += c; cnt += (c > 0u) ? 1u : 0u; mine = (j == x) ? c : mine; }
        if (sum == G) break;
        __builtin_amdgcn_s_sleep(1);
        if ((++sp & 255u) == 0u) { if (xb_ld(&bar[XB_TMO])) break; if (sp > XB_SPIN_CAP) { atomicAdd(&bar[XB_TMO], 1u); break; } }
    }
    nloc = mine > 0u ? mine : 1u; nx = cnt > 0u ? cnt : 1u;
}

__device__ __forceinline__ void xcd_barrier(const XcdBarrier& b) {
    asm volatile("s_waitcnt vmcnt(0)" ::: "memory");
    __syncthreads();
    if (threadIdx.x == 0) {
        unsigned* bar = b.bar;
        __builtin_amdgcn_s_waitcnt(0);
        unsigned nloc = b.st[0], nx = b.st[1];
        if (nloc == 0u) { xcd_barrier_complete(bar, b.x, nloc, nx); b.st[0] = nloc; b.st[1] = nx; }
        const unsigned old = xb_add(&bar[XB_XSUB(b.x)], 1u);
        const unsigned gen = old / nloc;
        if (old + 1u == (gen + 1u) * nloc) {
            __builtin_amdgcn_fence(__ATOMIC_RELEASE, "agent");
            asm volatile("s_waitcnt vmcnt(0)" ::: "memory");
            const unsigned og = xb_add(&bar[XB_TOP], 1u);
            const unsigned tg = og / nx;
            if (og + 1u == (tg + 1u) * nx) xb_add(&bar[XB_TOPGEN], 1u);
            else XB_SPIN(xb_ld(&bar[XB_TOPGEN]) == tg, bar);
            __builtin_amdgcn_fence(__ATOMIC_ACQUIRE, "agent");
            xb_add(&bar[XB_XGEN(b.x)], 1u);
            asm volatile("s_waitcnt vmcnt(0)" ::: "memory");
        } else {
            XB_SPIN(xb_ld(&bar[XB_XGEN(b.x)]) == gen, bar);
            __builtin_amdgcn_fence(__ATOMIC_ACQUIRE, "agent");
            asm volatile("s_waitcnt vmcnt(0)" ::: "memory");
        }
    }
    __syncthreads();
}

typedef unsigned short bf16_t;
typedef short bf16x8 __attribute__((ext_vector_type(8)));
typedef float f32x4 __attribute__((ext_vector_type(4)));
typedef float f32x16 __attribute__((ext_vector_type(16)));
typedef unsigned u32x4 __attribute__((ext_vector_type(4)));
typedef unsigned u32x2 __attribute__((ext_vector_type(2)));
typedef float f32x2_t __attribute__((ext_vector_type(2)));
typedef __bf16 bf16x2_t __attribute__((ext_vector_type(2)));

constexpr int SEQ = 16384, DM = 1024, NLAYER = 2;
constexpr int IN_COLS = 2724, NP = 2816;
constexpr int NEXP = 32, TOPK = 4, FEXP = 1024;
constexpr int MAXROWS = SEQ * TOPK + NEXP * 256;
constexpr int NWAVES = 8, NTHREADS = 512;
constexpr float EPS = 1e-6f;
constexpr float LOG2E = 1.4426950408889634f;
constexpr float QSCALE64 = 0.125f * LOG2E;
constexpr float QSCALE96 = 0.10206207261596577f * LOG2E;

constexpr int PC_CQ = 0, PC_CKV = 256, PC_KR = 384, PC_FLOG = 416, PC_FQ = 448, PC_FK = 704, PC_FV = 960, PC_MQ = 1216, PC_MK = 1472, PC_MV = 1728, PC_DQ = 1984, PC_DK = 2240, PC_DV = 2496;

constexpr size_t MiB = 1u << 20;
constexpr size_t WS_CTL = 0, CTL_ZERO_BYTES = 1 * MiB;
constexpr size_t WS_META = 1 * MiB;
constexpr size_t WS_W1T = 2 * MiB;
constexpr size_t WS_WOT = 14 * MiB;
constexpr size_t WS_WUQ = 18 * MiB;
constexpr size_t WS_WUKV = 19 * MiB;
constexpr size_t WS_WE1 = 32 * MiB;
constexpr size_t WS_WE2 = 288 * MiB;
constexpr size_t WS_H = 416 * MiB;
constexpr size_t WS_PROJ = 448 * MiB;
constexpr size_t WS_QA = 536 * MiB, WS_KA = 548 * MiB, WS_VAT = 560 * MiB;
constexpr size_t WS_QB = 568 * MiB, WS_KB = 576 * MiB, WS_VBT = 584 * MiB;
constexpr size_t WS_QC = 592 * MiB, WS_KC = 600 * MiB, WS_VCT = 608 * MiB;
constexpr size_t WS_QD = 616 * MiB, WS_KD = 624 * MiB, WS_VDT = 632 * MiB;
constexpr size_t WS_FLOC = 640 * MiB;
constexpr size_t WS_FTILE = 640 * MiB + 256 * 1024;
constexpr size_t WS_KSUM = 640 * MiB + 512 * 1024;
constexpr size_t WS_O = 642 * MiB;
constexpr size_t WS_X1 = 674 * MiB;
constexpr size_t WS_XC = 738 * MiB;
constexpr size_t WS_XS = 802 * MiB;
constexpr size_t WS_Y1 = 946 * MiB;
constexpr size_t WS_Y2 = 1090 * MiB;
constexpr size_t WS_TOKI = 1234 * MiB;
constexpr size_t WS_BLIST = 1236 * MiB;
constexpr size_t WS_PM = 1252 * MiB;
constexpr size_t WS_PO = 1254 * MiB;
constexpr size_t WS_DM = 1286 * MiB;
constexpr size_t WS_DO = 1288 * MiB;
constexpr size_t WS_INV = 1320 * MiB;
constexpr size_t WS_H8 = 1322 * MiB;
constexpr size_t WS_END = 1340 * MiB;
constexpr size_t META_MOD = 0;
constexpr size_t META_OFF = 64 * 1024;
constexpr size_t META_TILE = 68 * 1024;
constexpr int CW_BAR = 4096;
constexpr int CW_QUEUE = 8192;
constexpr int CW_ECNT = 12288;
constexpr int CW_BCNT = 16384;
constexpr int CW_MQ = 20480;
constexpr int CW_YCNT = 24576;

constexpr int GEN_BYTES = 139264;
constexpr int LDSCTL_OFF = GEN_BYTES;
constexpr int LDS_BYTES = GEN_BYTES + 1024;

DI float bf2f(bf16_t b) { return __uint_as_float(((unsigned)b) << 16); }
DI unsigned pk2(float lo, float hi) { f32x2_t v = {lo, hi}; bf16x2_t b = __builtin_convertvector(v, bf16x2_t); return __builtin_bit_cast(unsigned, b); }
DI bf16_t f2bf(float f) { return (bf16_t)(pk2(f, 0.f) & 0xffffu); }
DI float wave_sum(float v) {
#pragma unroll
    for (int o = 1; o < 64; o <<= 1) v += __shfl_xor(v, o);
    return v;
}
DI float wave_max(float v) {
#pragma unroll
    for (int o = 1; o < 64; o <<= 1) v = fmaxf(v, __shfl_xor(v, o));
    return v;
}
DI void unpack8(const bf16x8 r, float (&x)[8]) {
#pragma unroll
    for (int i = 0; i < 8; ++i) x[i] = bf2f((bf16_t)r[i]);
}
DI u32x4 pack8(const float (&y)[8]) { u32x4 w; w.x = pk2(y[0], y[1]); w.y = pk2(y[2], y[3]); w.z = pk2(y[4], y[5]); w.w = pk2(y[6], y[7]); return w; }
#ifndef UP_FP8
#define UP_FP8 1
#endif
#ifndef MOE_FP8
#define MOE_FP8 1
#endif
constexpr float WSCALE = 32.0f, WINV = 1.0f / 32.0f;
DI unsigned pk4_fp8(float a, float b, float c, float d) { int w = 0; w = __builtin_amdgcn_cvt_pk_fp8_f32(a, b, w, false); w = __builtin_amdgcn_cvt_pk_fp8_f32(c, d, w, true); return (unsigned)w; }
DI int crow(int r, int hi) { return (r & 3) + 8 * (r >> 2) + 4 * hi; }
DI float max_x32(float v) { const auto rr = __builtin_amdgcn_permlane32_swap(__float_as_uint(v), __float_as_uint(v), false, false); return fmaxf(__uint_as_float(rr[0]), __uint_as_float(rr[1])); }
DI float sum_x32(float v) { const auto rr = __builtin_amdgcn_permlane32_swap(__float_as_uint(v), __float_as_uint(v), false, false); return __uint_as_float(rr[0]) + __uint_as_float(rr[1]); }
#define MFMA32(a, b, c) __builtin_amdgcn_mfma_f32_32x32x16_bf16((a), (b), (c), 0, 0, 0)

struct Args { const float* in[27]; float* out; unsigned char* ws; int ph_lo, ph_hi; };
typedef const __attribute__((address_space(4))) Args* KArgP;
struct Frame {
    LAS unsigned char* lds;
    unsigned char* ws;
    unsigned* ctl;
    KArgP ap;
    int tid, lane, wave, G;
    DI const float* in(int i) const { return ap->in[i]; }
    DI void refresh() { int t = threadIdx.x; asm volatile("" : "+v"(t)); tid = t; lane = t & 63; wave = __builtin_amdgcn_readfirstlane(t >> 6); }
};
enum { I_X = 0, I_C, I_WMOD, I_BMOD, I_N1G, I_N2G, I_WIN, I_CQG, I_WUQ, I_CKVG, I_WUKV, I_MQG, I_MKG, I_FQG, I_FKG, I_FBF, I_MOQG, I_MOKG, I_DQG, I_DKG, I_WOUT, I_RW, I_RB, I_EW1, I_EB1, I_EW2, I_EB2 };

DI int map_win(int n) {
    if (n < 416) return n;
    if (n < 420) return 1184 + (n - 416);
    if (n < 448) return -1;
    if (n < 1216) return n - 32;
    if (n < 2752) return n - 28;
    return -1;
}
DI int map_w1(int n) { return ((n >> 7) & 1) * 1024 + (n >> 8) * 128 + (n & 127); }
template <int MAP> DI void transpose_item(const float* W, int K, int Nsrc, bf16_t* WT, int k0, int n0, LAS float* scr, int lane) {
    const int nn = n0 + (lane & 31);
    const int ns = (MAP == 0) ? nn : (MAP == 1 ? map_win(nn) : map_w1(nn));
    float v[32];
#pragma unroll
    for (int i = 0; i < 32; ++i) { const int kk = 2 * i + (lane >> 5); v[i] = (ns >= 0) ? W[(size_t)(k0 + kk) * Nsrc + ns] : 0.f; }
#pragma unroll
    for (int i = 0; i < 32; ++i) { const int kk = 2 * i + (lane >> 5); scr[kk * 33 + (lane & 31)] = v[i]; }
    asm volatile("s_waitcnt lgkmcnt(0)" ::: "memory");
    const int c = lane & 7;
#pragma unroll
    for (int j = 0; j < 4; ++j) { const int n = (lane >> 3) + 8 * j; const LAS float* s = scr + (8 * c) * 33 + n;
        u32x4 o; o.x = pk2(s[0 * 33], s[1 * 33]); o.y = pk2(s[2 * 33], s[3 * 33]); o.z = pk2(s[4 * 33], s[5 * 33]); o.w = pk2(s[6 * 33], s[7 * 33]);
        *(u32x4*)(WT + (size_t)(n0 + n) * K + k0 + 8 * c) = o; }
    asm volatile("s_waitcnt lgkmcnt(0)" ::: "memory");
}
DI void norm_mod_store(const f32x4 (&v)[4], const float* g, const float* sc, const float* sh, bf16_t* hrow, int lane) {
    float ss = 0.f;
#pragma unroll
    for (int j = 0; j < 4; ++j) ss += (v[j].x * v[j].x + v[j].y * v[j].y) + (v[j].z * v[j].z + v[j].w * v[j].w);
    ss = wave_sum(ss);
    const float rstd = 1.0f / sqrtf(ss * (1.0f / DM) + EPS);
#pragma unroll
    for (int j = 0; j < 4; ++j) {
        const int c = 4 * lane + 256 * j;
        const f32x4 g4 = *(const f32x4*)(g + c), s4 = *(const f32x4*)(sc + c), h4 = *(const f32x4*)(sh + c);
        const f32x4 y = (v[j] * rstd) * g4 * (s4 + 1.0f) + h4;
        u32x2 w; w.x = pk2(y.x, y.y); w.y = pk2(y.z, y.w);
        *(u32x2*)(hrow + c) = w;
    }
}
#ifndef BG_CONVERT
#define BG_CONVERT 1
#endif
DI void phase_prologue(Frame& F) {
    const int tid = F.tid, lane = F.lane, wave = F.wave;
    float* mod = (float*)(F.ws + WS_META + META_MOD);
    if (blockIdx.x < 192) {
        LAS float* scv = (LAS float*)F.lds;
        LAS float* part = (LAS float*)(F.lds + 4096);
        for (int i = tid; i < DM; i += NTHREADS) { const float cv = F.in(I_C)[i]; scv[i] = cv / (1.0f + __expf(-cv)); }
        __syncthreads();
        const int l = blockIdx.x / 96, col = (blockIdx.x % 96) * 64 + lane;
        const float* wm = F.in(I_WMOD) + (size_t)l * DM * 6144 + col;
        float acc = 0.f;
#pragma unroll 8
        for (int k = wave * 128; k < wave * 128 + 128; ++k) acc += scv[k] * wm[(size_t)k * 6144];
        part[wave * 64 + lane] = acc;
        __syncthreads();
        if (wave == 0) { float s = 0.f;
#pragma unroll
            for (int w = 0; w < 8; ++w) s += part[w * 64 + lane];
            mod[l * 6144 + col] = s + F.in(I_BMOD)[l * 6144 + col]; }
        __syncthreads();
    }
    {
        LAS float* scr = (LAS float*)(F.lds + 8192 + wave * 8704);
        const int gw = blockIdx.x * NWAVES + wave, NGW = F.G * NWAVES;
        constexpr int T_E1 = 32 * 16 * 64, T_E2 = 32 * 16 * 32, T_W1 = 16 * 88, T_WO = 16 * 32, T_UQ = 4 * 12, T_UKV = 2 * 16;
        constexpr int T_LAYER = T_E1 + T_E2 + T_W1 + T_WO + T_UQ + T_UKV;
        for (int it = gw; it < NLAYER * T_LAYER; it += NGW) {
            const int l = it / T_LAYER; int r = it % T_LAYER;
            if (BG_CONVERT && r < T_E1 + T_E2) continue;
            if (r < T_E1) { const int e = r / (16 * 64), q = r % (16 * 64), kb = q / 64, nb = q % 64;
                transpose_item<2>(F.in(I_EW1) + ((size_t)l * NEXP + e) * DM * 2048, DM, 2048, (bf16_t*)(F.ws + WS_WE1) + ((size_t)l * NEXP + e) * 2048 * DM, 64 * kb, 32 * nb, scr, lane); continue; }
            r -= T_E1;
            if (r < T_E2) { const int e = r / (16 * 32), q = r % (16 * 32), kb = q / 32, nb = q % 32;
                transpose_item<0>(F.in(I_EW2) + ((size_t)l * NEXP + e) * FEXP * DM, FEXP, DM, (bf16_t*)(F.ws + WS_WE2) + ((size_t)l * NEXP + e) * DM * FEXP, 64 * kb, 32 * nb, scr, lane); continue; }
            r -= T_E2;
            if (r < T_W1) { const int kb = r / 88, nb = r % 88;
                transpose_item<1>(F.in(I_WIN) + (size_t)l * DM * IN_COLS, DM, IN_COLS, (bf16_t*)(F.ws + WS_W1T) + (size_t)l * NP * DM, 64 * kb, 32 * nb, scr, lane); continue; }
            r -= T_W1;
            if (r < T_WO) { const int kb = r / 32, nb = r % 32;
                transpose_item<0>(F.in(I_WOUT) + (size_t)l * DM * DM, DM, DM, (bf16_t*)(F.ws + WS_WOT) + (size_t)l * DM * DM, 64 * kb, 32 * nb, scr, lane); continue; }
            r -= T_WO;
            if (r < T_UQ) { const int kb = r / 12, nb = r % 12;
                transpose_item<0>(F.in(I_WUQ) + (size_t)l * 256 * 384, 256, 384, (bf16_t*)(F.ws + WS_WUQ) + (size_t)l * 384 * 256, 64 * kb, 32 * nb, scr, lane); continue; }
            r -= T_UQ;
            { const int kb = r / 16, nb = r % 16;
                transpose_item<0>(F.in(I_WUKV) + (size_t)l * 128 * 512, 128, 512, (bf16_t*)(F.ws + WS_WUKV) + (size_t)l * 512 * 128, 64 * kb, 32 * nb, scr, lane); }
        }
    }
}
DI void phase_norm1_l0(Frame& F) {
    const float* mod = (const float*)(F.ws + WS_META + META_MOD);
    const int gw = blockIdx.x * NWAVES + F.wave, NGW = F.G * NWAVES;
    for (int m = gw; m < SEQ; m += 2 * NGW) {
        const int m2 = m + NGW;
        const f32x4* xr = (const f32x4*)(F.in(I_X) + (size_t)m * DM) + F.lane;
        const f32x4* xr2 = (const f32x4*)(F.in(I_X) + (size_t)(m2 < SEQ ? m2 : m) * DM) + F.lane;
        f32x4 v[4], w[4];
#pragma unroll
        for (int j = 0; j < 4; ++j) { v[j] = xr[64 * j]; w[j] = xr2[64 * j]; }
        norm_mod_store(v, F.in(I_N1G), mod + 1 * DM  , mod + 0 * DM  , (bf16_t*)(F.ws + WS_H) + (size_t)m * DM, F.lane);
        if (m2 < SEQ) norm_mod_store(w, F.in(I_N1G), mod + 1 * DM, mod + 0 * DM, (bf16_t*)(F.ws + WS_H) + (size_t)m2 * DM, F.lane);
    }
}

constexpr double rope_rev(int j) {
    return j == 0 ? 0.15915494309189535 : j == 1 ? 0.08949940160889101 : j == 2 ? 0.050329212104487035 : j == 3 ? 0.0283021958306234 : j == 4 ? 0.015915494309189534 :
           j == 5 ? 0.008949940160889102 : j == 6 ? 0.005032921210448704 : j == 7 ? 0.00283021958306234 : j == 8 ? 0.0015915494309189536 : j == 9 ? 0.0008949940160889102 :
           j == 10 ? 0.0005032921210448703 : j == 11 ? 0.00028302195830623395 : j == 12 ? 0.00015915494309189535 : j == 13 ? 8.949940160889102e-05 : j == 14 ? 5.0329212104487035e-05 : 2.8302195830623396e-05;
}
template <int JB> DI void rope_cs(int t, int hi, float& sn, float& cs) {
    const double c = hi ? rope_rev(JB + 4) : rope_rev(JB);
    const double rev = (double)t * c;
    const float fr = (float)(rev - __builtin_rint(rev));
    sn = __builtin_amdgcn_sinf(fr); cs = __builtin_amdgcn_cosf(fr);
}
DI void phase_postproj(Frame& F, int l) {
    const int tid0 = F.tid, wave = F.wave;
    const bf16_t* proj = (const bf16_t*)(F.ws + WS_PROJ);
    LAS bf16_t* KCl = (LAS bf16_t*)(F.lds);
    LAS bf16_t* AQ = (LAS bf16_t*)(F.lds + 32768);
    LAS bf16_t* AKV = (LAS bf16_t*)(F.lds + 32768 + 33792);
    LAS float* G6 = (LAS float*)(F.lds + 106496);
    LAS float* GCQ = G6 + 384; LAS float* GCKV = GCQ + 256; LAS float* GMQ = GCKV + 128; LAS float* GMK = GMQ + 96;
    for (int i = tid0; i < 960; i += NTHREADS) {
        float v;
        if (i < 384) { const int typ = i >> 6; v = F.in(typ == 0 ? I_FQG : typ == 1 ? I_FKG : typ == 2 ? I_MOQG : typ == 3 ? I_MOKG : typ == 4 ? I_DQG : I_DKG)[l * 64 + (i & 63)]; }
        else if (i < 640) v = F.in(I_CQG)[l * 256 + (i - 384)];
        else if (i < 768) v = F.in(I_CKVG)[l * 128 + (i - 640)];
        else if (i < 864) v = F.in(I_MQG)[l * 96 + (i - 768)];
        else v = F.in(I_MKG)[l * 96 + (i - 864)];
        G6[i] = v;
    }
    __syncthreads();
    for (int tile = blockIdx.x; tile < SEQ / 64; tile += F.G) {
        const int t0 = tile * 64;
        int tid_ = tid0; asm volatile("" : "+v"(tid_));
        const int tid = tid_, lane = tid & 63;
        const int sub = tid & 7, vslot = tid >> 3;
        bf16x8 rawA[24];
#define PP_LOADA(base_) do { _Pragma("unroll") for (int j = 0; j < 24; ++j) { const int it = (base_) + j, typ = it >> 2, hh = it & 3;       \
            const int cb = (typ == 0 ? PC_FQ : typ == 1 ? PC_FK : typ == 2 ? PC_MQ : typ == 3 ? PC_MK : typ == 4 ? PC_DQ : PC_DK) + 64 * hh; \
            rawA[j] = *(const bf16x8*)(proj + (size_t)(t0 + vslot) * NP + 8 * sub + cb); } } while (0)
        PP_LOADA(0);
        bf16x8 vr[2][8];
#pragma unroll
        for (int rnd = 0; rnd < 2; ++rnd) { const int pi = wave + 8 * rnd, mixer = pi >> 2, hh = pi & 3;
            const bf16_t* rp = proj + (size_t)(t0 + lane) * NP + ((pi < 12) ? (mixer == 0 ? PC_FV : mixer == 1 ? PC_MV : PC_DV) + 64 * hh : PC_FV);
#pragma unroll
            for (int i = 0; i < 8; ++i) vr[rnd][i] = *(const bf16x8*)(rp + 8 * i); }
        bf16x8 rawQ[4], rawKV[2];
#pragma unroll
        for (int it = 0; it < 4; ++it) { const int tok = it * 16 + wave * 2 + (lane >> 5); rawQ[it] = *(const bf16x8*)(proj + (size_t)(t0 + tok) * NP + PC_CQ + 8 * (lane & 31)); }
#pragma unroll
        for (int it = 0; it < 2; ++it) { const int tok = it * 32 + wave * 4 + (lane >> 4); rawKV[it] = *(const bf16x8*)(proj + (size_t)(t0 + tok) * NP + PC_CKV + 8 * (lane & 15)); }
        u32x2 krw[4];
        { const int tg = wave & 1, r32 = lane & 31, hi = lane >> 5, t = t0 + 32 * tg + r32;
#pragma unroll
          for (int g4 = 0; g4 < 4; ++g4) krw[g4] = *(const u32x2*)(proj + (size_t)t * NP + PC_KR + 8 * g4 + 4 * hi); }
        const float zraw = bf2f(proj[(size_t)(t0 + lane) * NP + PC_FLOG + (wave & 3)]), fbias = F.in(I_FBF)[l * 4 + (wave & 3)];
#pragma unroll
        for (int half = 0; half < 1; ++half) {
#pragma unroll
            for (int j = 0; j < 24; ++j) {
                const int it = j, tok = vslot, typ = it >> 2, hh = it & 3;
                float x[8]; unpack8(rawA[j], x);
                float ss = 0.f;
#pragma unroll
                for (int i = 0; i < 8; ++i) ss += x[i] * x[i];
                ss += __shfl_xor(ss, 1); ss += __shfl_xor(ss, 2); ss += __shfl_xor(ss, 4);
                const float rstd = 1.0f / sqrtf(ss * (1.0f / 64.0f) + EPS);
                const LAS float* gp = G6 + typ * 64 + 8 * sub;
                const float qs = ((typ & 1) == 0) ? QSCALE64 : 1.0f;
                const f32x4 g0 = *(const LAS f32x4*)gp, g1 = *(const LAS f32x4*)(gp + 4);
                float y[8];
#pragma unroll
                for (int i = 0; i < 4; ++i) { y[i] = x[i] * rstd * g0[i] * qs; y[4 + i] = x[4 + i] * rstd * g1[i] * qs; }
                const u32x4 w = pack8(y);
                const size_t dsto = (typ == 0 ? WS_QB : typ == 1 ? WS_KB : typ == 2 ? WS_QC : typ == 3 ? WS_KC : typ == 4 ? WS_QD : WS_KD);
                *(u32x4*)((bf16_t*)(F.ws + dsto) + ((size_t)hh * SEQ + t0 + tok) * 64 + 8 * sub) = w;
                if (typ == 3) *(LAS u32x4*)(KCl + (hh * 64 + tok) * 64 + 8 * sub) = w;
            }
        }
#undef PP_LOADA
        __syncthreads();
        if (wave < 4) { float s = 0.f;
            for (int tok = 0; tok < 64; ++tok) s += bf2f(KCl[(wave * 64 + tok) * 64 + lane]);
            ((float*)(F.ws + WS_KSUM))[((size_t)wave * 256 + tile) * 64 + lane] = s; }
        {
#pragma unroll
            for (int rnd = 0; rnd < 2; ++rnd) {
                const int pi = wave + 8 * rnd, mixer = pi >> 2, hh = pi & 3;
                LAS bf16_t* vt = (LAS bf16_t*)(F.lds + 32768 + wave * 9216);
                if (pi < 12) {
#pragma unroll
                    for (int i = 0; i < 8; ++i) {
#pragma unroll
                        for (int e = 0; e < 8; ++e) vt[(8 * i + e) * 72 + lane] = (bf16_t)vr[rnd][i][e]; }
                }
                __syncthreads();
                if (pi < 12) {
                    bf16_t* dst = (bf16_t*)(F.ws + (mixer == 0 ? WS_VBT : mixer == 1 ? WS_VCT : WS_VDT)) + (size_t)hh * 64 * SEQ;
#pragma unroll
                    for (int ps = 0; ps < 8; ++ps) { const int d = 8 * ps + (lane >> 3), c = lane & 7;
                        const u32x4 val = *(const LAS u32x4*)(vt + d * 72 + 8 * c);
                        *(u32x4*)(dst + (size_t)d * SEQ + t0 + 8 * c) = val; }
                }
                __syncthreads();
            }
        }
#pragma unroll
        for (int it = 0; it < 4; ++it) {
            const int tok = it * 16 + wave * 2 + (lane >> 5), sub32 = lane & 31;
            float x[8]; unpack8(rawQ[it], x);
            float ss = 0.f;
#pragma unroll
            for (int i = 0; i < 8; ++i) ss += x[i] * x[i];
            ss += __shfl_xor(ss, 1); ss += __shfl_xor(ss, 2); ss += __shfl_xor(ss, 4); ss += __shfl_xor(ss, 8); ss += __shfl_xor(ss, 16);
            const float rstd = 1.0f / sqrtf(ss * (1.0f / 256.0f) + EPS);
            const LAS float* gp = GCQ + 8 * sub32;
            const f32x4 g0 = *(const LAS f32x4*)gp, g1 = *(const LAS f32x4*)(gp + 4);
            float y[8];
#pragma unroll
            for (int i = 0; i < 4; ++i) { y[i] = x[i] * rstd * g0[i]; y[4 + i] = x[4 + i] * rstd * g1[i]; }
            *(LAS u32x4*)(AQ + tok * 264 + 8 * sub32) = pack8(y);
        }
#pragma unroll
        for (int it = 0; it < 2; ++it) {
            const int tok = it * 32 + wave * 4 + (lane >> 4), sub16 = lane & 15;
            float x[8]; unpack8(rawKV[it], x);
            float ss = 0.f;
#pragma unroll
            for (int i = 0; i < 8; ++i) ss += x[i] * x[i];
            ss += __shfl_xor(ss, 1); ss += __shfl_xor(ss, 2); ss += __shfl_xor(ss, 4); ss += __shfl_xor(ss, 8);
            const float rstd = 1.0f / sqrtf(ss * (1.0f / 128.0f) + EPS);
            const LAS float* gp = GCKV + 8 * sub16;
            const f32x4 g0 = *(const LAS f32x4*)gp, g1 = *(const LAS f32x4*)(gp + 4);
            float y[8];
#pragma unroll
            for (int i = 0; i < 4; ++i) { y[i] = x[i] * rstd * g0[i]; y[4 + i] = x[4 + i] * rstd * g1[i]; }
            *(LAS u32x4*)(AKV + tok * 136 + 8 * sub16) = pack8(y);
        }
        __syncthreads();
        {
            const int tg = wave & 1, hh = wave >> 1, r32 = lane & 31, hi = lane >> 5, t = t0 + 32 * tg + r32;
            {
                f32x16 accq[3];
#pragma unroll
                for (int i = 0; i < 3; ++i)
#pragma unroll
                    for (int r = 0; r < 16; ++r) accq[i][r] = 0.f;
                const bf16_t* wq = (const bf16_t*)(F.ws + WS_WUQ) + (size_t)l * 384 * 256 + (size_t)(96 * hh + r32) * 256 + 8 * hi;
                const LAS bf16_t* aq = AQ + (32 * tg + r32) * 264 + 8 * hi;
#pragma unroll 8
                for (int ks = 0; ks < 16; ++ks) {
                    const bf16x8 b = *(const LAS bf16x8*)(aq + 16 * ks);
#pragma unroll
                    for (int i = 0; i < 3; ++i) { const bf16x8 a = *(const bf16x8*)(wq + (size_t)i * 32 * 256 + 16 * ks); accq[i] = MFMA32(a, b, accq[i]); }
                }
                f32x16 acc[4];
#pragma unroll
                for (int i = 0; i < 4; ++i)
#pragma unroll
                    for (int r = 0; r < 16; ++r) acc[i][r] = 0.f;
                const bf16_t* wkv = (const bf16_t*)(F.ws + WS_WUKV) + (size_t)l * 512 * 128 + (size_t)(128 * hh + r32) * 128 + 8 * hi;
                const LAS bf16_t* akv = AKV + (32 * tg + r32) * 136 + 8 * hi;
#pragma unroll 4
                for (int ks = 0; ks < 8; ++ks) {
                    const bf16x8 b = *(const LAS bf16x8*)(akv + 16 * ks);
#pragma unroll
                    for (int i = 0; i < 4; ++i) { const bf16x8 a = *(const bf16x8*)(wkv + (size_t)i * 32 * 128 + 16 * ks); acc[i] = MFMA32(a, b, acc[i]); }
                }
                {
                float ss = 0.f;
#pragma unroll
                for (int i = 0; i < 3; ++i)
#pragma unroll
                    for (int r = 0; r < 16; ++r) ss += accq[i][r] * accq[i][r];
                ss += __shfl_xor(ss, 32);
                const float rstd = 1.0f / sqrtf(ss * (1.0f / 96.0f) + EPS);
                const LAS float* gq = GMQ;
#pragma unroll
                for (int i = 0; i < 3; ++i)
#pragma unroll
                    for (int g4 = 0; g4 < 4; ++g4) { const f32x4 gv = *(const LAS f32x4*)(gq + 32 * i + 8 * g4 + 4 * hi);
#pragma unroll
                        for (int e = 0; e < 4; ++e) accq[i][4 * g4 + e] *= rstd * gv[e]; }
#define ROPE_Q(r) { float sn, cs; rope_cs<((r) & 3) + 8 * ((r) >> 2)>(t, hi, sn, cs); const float x1 = accq[2][r], x2 = accq[2][(r) + 8]; accq[2][r] = x1 * cs - x2 * sn; accq[2][(r) + 8] = x2 * cs + x1 * sn; }
                ROPE_Q(0) ROPE_Q(1) ROPE_Q(2) ROPE_Q(3) ROPE_Q(4) ROPE_Q(5) ROPE_Q(6) ROPE_Q(7)
#undef ROPE_Q
                bf16_t* qd = (bf16_t*)(F.ws + WS_QA) + ((size_t)hh * SEQ + t) * 96 + 4 * hi;
#pragma unroll
                for (int i = 0; i < 3; ++i)
#pragma unroll
                    for (int g4 = 0; g4 < 4; ++g4) { u32x2 w; w.x = pk2(accq[i][4 * g4] * QSCALE96, accq[i][4 * g4 + 1] * QSCALE96); w.y = pk2(accq[i][4 * g4 + 2] * QSCALE96, accq[i][4 * g4 + 3] * QSCALE96);
                        *(u32x2*)(qd + 32 * i + 8 * g4) = w; }
                }
                float kr[16];
#pragma unroll
                for (int g4 = 0; g4 < 4; ++g4) { const u32x2 w = krw[g4];
                    kr[4 * g4 + 0] = bf2f((bf16_t)(w.x & 0xffffu)); kr[4 * g4 + 1] = bf2f((bf16_t)(w.x >> 16)); kr[4 * g4 + 2] = bf2f((bf16_t)(w.y & 0xffffu)); kr[4 * g4 + 3] = bf2f((bf16_t)(w.y >> 16)); }
                float ss = 0.f;
#pragma unroll
                for (int r = 0; r < 16; ++r) ss += acc[0][r] * acc[0][r] + acc[1][r] * acc[1][r] + kr[r] * kr[r];
                ss += __shfl_xor(ss, 32);
                const float rstd = 1.0f / sqrtf(ss * (1.0f / 96.0f) + EPS);
                const LAS float* gk = GMK;
                bf16_t* kd = (bf16_t*)(F.ws + WS_KA) + ((size_t)hh * SEQ + t) * 96 + 4 * hi;
#pragma unroll
                for (int i = 0; i < 2; ++i)
#pragma unroll
                    for (int g4 = 0; g4 < 4; ++g4) { const f32x4 gv = *(const LAS f32x4*)(gk + 32 * i + 8 * g4 + 4 * hi);
                        u32x2 w; w.x = pk2(acc[i][4 * g4] * rstd * gv[0], acc[i][4 * g4 + 1] * rstd * gv[1]); w.y = pk2(acc[i][4 * g4 + 2] * rstd * gv[2], acc[i][4 * g4 + 3] * rstd * gv[3]);
                        *(u32x2*)(kd + 32 * i + 8 * g4) = w; }
#pragma unroll
                for (int g4 = 0; g4 < 4; ++g4) { const f32x4 gv = *(const LAS f32x4*)(gk + 64 + 8 * g4 + 4 * hi);
#pragma unroll
                    for (int e = 0; e < 4; ++e) kr[4 * g4 + e] *= rstd * gv[e]; }
#define ROPE_K(r) { float sn, cs; rope_cs<((r) & 3) + 8 * ((r) >> 2)>(t, hi, sn, cs); const float x1 = kr[r], x2 = kr[(r) + 8]; kr[r] = x1 * cs - x2 * sn; kr[(r) + 8] = x2 * cs + x1 * sn; }
                ROPE_K(0) ROPE_K(1) ROPE_K(2) ROPE_K(3) ROPE_K(4) ROPE_K(5) ROPE_K(6) ROPE_K(7)
#undef ROPE_K
#pragma unroll
                for (int g4 = 0; g4 < 4; ++g4) { u32x2 w; w.x = pk2(kr[4 * g4], kr[4 * g4 + 1]); w.y = pk2(kr[4 * g4 + 2], kr[4 * g4 + 3]); *(u32x2*)(kd + 64 + 8 * g4) = w; }
                bf16_t* vd = (bf16_t*)(F.ws + WS_VAT) + (size_t)hh * 64 * SEQ + t;
#pragma unroll
                for (int i = 2; i < 4; ++i)
#pragma unroll
                    for (int r = 0; r < 16; ++r) vd[(size_t)(32 * (i - 2) + crow(r, hi)) * SEQ] = f2bf(acc[i][r]);
            }
        }
        if (wave < 4) {
            const int hh = wave;
            const float z = zraw + fbias;
            float sc = (fminf(z, 0.f) - log1pf(expf(-fabsf(z)))) * LOG2E;
#pragma unroll
            for (int d = 1; d < 64; d <<= 1) { const float o = __shfl_up(sc, d); if (lane >= d) sc += o; }
            ((float*)(F.ws + WS_FLOC))[(size_t)hh * SEQ + t0 + lane] = -sc;
            if (lane == 63) ((float*)(F.ws + WS_FTILE))[hh * 256 + tile] = sc;
        }
        __syncthreads();
    }
}

DI int swap23(int x) { return (x & ~12) | ((x & 4) << 1) | ((x & 8) >> 1); }
struct AttnShared { const LAS float* kmean; const LAS float* fpre; float fox_cut; };
DI void fox_unit(Frame& F, const AttnShared& A, int hh, int qt) {
    int tid_ = threadIdx.x; asm volatile("" : "+v"(tid_));
    const int lane = tid_ & 63, r32 = lane & 31, hi = lane >> 5, t = 32 * qt + r32;
    const float* nfloc = (const float*)(F.ws + WS_FLOC) + (size_t)hh * SEQ;
    const unsigned char* Kbase = (const unsigned char*)((const bf16_t*)(F.ws + WS_KB) + (size_t)hh * SEQ * 64);
    const unsigned char* Vbase = (const unsigned char*)((const bf16_t*)(F.ws + WS_VBT) + (size_t)hh * 64 * SEQ);
    const unsigned kofs = (unsigned)(swap23(r32) * 64 + 8 * hi) * 2u, vofs = (unsigned)(r32 * SEQ + 8 * hi) * 2u, cofs = 32u * (unsigned)hi;
    bf16x8 qf[4];
    { const bf16_t* Qp = (const bf16_t*)(F.ws + WS_QB) + ((size_t)hh * SEQ + t) * 64 + 8 * hi;
#pragma unroll
      for (int ks = 0; ks < 4; ++ks) qf[ks] = *(const bf16x8*)(Qp + 16 * ks); }
    const float Fq = A.fpre[hh * 256 + (t >> 6)] - nfloc[t];
    const float Ffirst = __builtin_bit_cast(float, __builtin_amdgcn_readfirstlane(__builtin_bit_cast(int, A.fpre[hh * 256 + ((32 * qt) >> 6)] - nfloc[32 * qt])));
    float m = 0.f, lsum = 0.f;
    f32x16 o0, o1;
#pragma unroll
    for (int r = 0; r < 16; ++r) { o0[r] = 0.f; o1[r] = 0.f; }
    bf16x8 kfA[4], vfA[4], kfB[4], vfB[4]; f32x16 cfA, cfB; float preA = 0.f, preB = 0.f;
#define FX_LOAD(kf, vf, cf, pre, kt_) do { \
        const GAS unsigned char* kb_ = (const GAS unsigned char*)(Kbase + (size_t)(kt_) * (32 * 64 * 2)); asm volatile("" : "+s"(kb_)); unsigned ko_ = kofs; asm volatile("" : "+v"(ko_)); \
        _Pragma("unroll") for (int ks = 0; ks < 4; ++ks) kf[ks] = *(const GAS bf16x8*)(kb_ + ko_ + 32 * ks); \
        const GAS unsigned char* v0_ = (const GAS unsigned char*)(Vbase + (size_t)(kt_) * 64); asm volatile("" : "+s"(v0_)); \
        const GAS unsigned char* v1_ = (const GAS unsigned char*)(Vbase + (size_t)(kt_) * 64 + (size_t)32 * SEQ * 2); asm volatile("" : "+s"(v1_)); unsigned vo_ = vofs; asm volatile("" : "+v"(vo_)); \
        vf[0] = *(const GAS bf16x8*)(v0_ + vo_); vf[1] = *(const GAS bf16x8*)(v0_ + vo_ + 32); vf[2] = *(const GAS bf16x8*)(v1_ + vo_); vf[3] = *(const GAS bf16x8*)(v1_ + vo_ + 32); \
        const GAS unsigned char* c_ = (const GAS unsigned char*)(nfloc + 32 * (kt_)); asm volatile("" : "+s"(c_)); unsigned co_ = cofs; asm volatile("" : "+v"(co_)); \
        { const f32x4 f0 = *(const GAS f32x4*)(c_ + co_), f1 = *(const GAS f32x4*)(c_ + co_ + 16), f2 = *(const GAS f32x4*)(c_ + co_ + 64), f3 = *(const GAS f32x4*)(c_ + co_ + 80); \
          _Pragma("unroll") for (int e = 0; e < 4; ++e) { cf[e] = f0[e]; cf[4 + e] = f1[e]; cf[8 + e] = f2[e]; cf[12 + e] = f3[e]; } } \
        pre = A.fpre[hh * 256 + ((kt_) >> 1)]; } while (0)
#define FX_NEXT(cf, pre, kt_) ({ int nk_ = (kt_) - 1; if (nk_ >= 0) { const float ff_ = __builtin_bit_cast(float, __builtin_amdgcn_readfirstlane(__builtin_bit_cast(int, pre - cf[0]))); \
        if (Ffirst - ff_ < -A.fox_cut) nk_ = -1; } nk_; })
    auto compute = [&](const bf16x8 (&kf)[4], const bf16x8 (&vf)[4], const f32x16& cf, const float pre, auto diagc) __attribute__((always_inline)) {
        f32x16 s = MFMA32(kf[0], qf[0], cf);
#pragma unroll
        for (int ks = 1; ks < 4; ++ks) s = MFMA32(kf[ks], qf[ks], s);
        if constexpr (decltype(diagc)::value) {
            const int d0 = r32 - 8 * hi;
#pragma unroll
            for (int i = 0; i < 16; ++i) if (d0 - (16 * (i >> 3) + (i & 7)) < 0) s[i] = -INFINITY;
        }
        float mj = m - (Fq - pre);
        float rm = fmaxf(s[0], s[1]);
#pragma unroll
        for (int i = 2; i < 16; ++i) rm = fmaxf(rm, s[i]);
        rm = max_x32(rm) - mj;
        if (__any(rm > 8.0f)) {
            const float dl = fmaxf(rm, 0.f), alpha = __builtin_amdgcn_exp2f(-dl);
            m += dl; mj += dl; lsum *= alpha;
#pragma unroll
            for (int r = 0; r < 16; ++r) { o0[r] *= alpha; o1[r] *= alpha; }
        }
        float p[16], psum = 0.f;
#pragma unroll
        for (int i = 0; i < 16; ++i) { p[i] = __builtin_amdgcn_exp2f(s[i] - mj); psum += p[i]; }
        lsum += psum;
        u32x4 w0, w1;
        w0.x = pk2(p[0], p[1]); w0.y = pk2(p[2], p[3]); w0.z = pk2(p[4], p[5]); w0.w = pk2(p[6], p[7]);
        w1.x = pk2(p[8], p[9]); w1.y = pk2(p[10], p[11]); w1.z = pk2(p[12], p[13]); w1.w = pk2(p[14], p[15]);
        const bf16x8 pf0 = __builtin_bit_cast(bf16x8, w0), pf1 = __builtin_bit_cast(bf16x8, w1);
        o0 = MFMA32(vf[0], pf0, o0); o0 = MFMA32(vf[1], pf1, o0);
        o1 = MFMA32(vf[2], pf0, o1); o1 = MFMA32(vf[3], pf1, o1);
    };
    int kt = qt;
    FX_LOAD(kfA, vfA, cfA, preA, kt);
    {   int nk = FX_NEXT(cfA, preA, kt);
        if (nk >= 0) FX_LOAD(kfB, vfB, cfB, preB, nk);
        compute(kfA, vfA, cfA, preA, std::true_type{});
        kt = nk; }
    while (kt >= 0) {
        int nk = FX_NEXT(cfB, preB, kt);
        if (nk >= 0) FX_LOAD(kfA, vfA, cfA, preA, nk);
        compute(kfB, vfB, cfB, preB, std::false_type{});
        kt = nk; if (kt < 0) break;
        nk = FX_NEXT(cfA, preA, kt);
        if (nk >= 0) FX_LOAD(kfB, vfB, cfB, preB, nk);
        compute(kfA, vfA, cfA, preA, std::false_type{});
        kt = nk;
    }
#undef FX_LOAD
#undef FX_NEXT
    const float ltot = sum_x32(lsum), inv = 1.0f / ltot;
    bf16_t* od = (bf16_t*)(F.ws + WS_O) + (size_t)t * DM + (4 + hh) * 64 + 4 * hi;
#pragma unroll
    for (int g4 = 0; g4 < 4; ++g4) {
        u32x2 w; w.x = pk2(o0[4 * g4] * inv, o0[4 * g4 + 1] * inv); w.y = pk2(o0[4 * g4 + 2] * inv, o0[4 * g4 + 3] * inv); *(u32x2*)(od + 8 * g4) = w;
        u32x2 z; z.x = pk2(o1[4 * g4] * inv, o1[4 * g4 + 1] * inv); z.y = pk2(o1[4 * g4 + 2] * inv, o1[4 * g4 + 3] * inv); *(u32x2*)(od + 32 + 8 * g4) = z;
    }
}

constexpr int BG_ITEMS = 32 * 32 * 64 + 32 * 32 * 32;
constexpr int ATT_BGSCR_OFF = 98816;
static_assert(UP_FP8 && MOE_FP8, "the background engine writes fp8");
struct BgConv {
    int it, stride, l, itp;
    DI void init(int gw, int ngw, int layer) { it = gw; stride = ngw; l = layer; itp = -1; }
    DI void finish(Frame& F, int wave, int lane) {
        const int id = itp; if (id < 0) return;
        unsigned char* dst; int K;
        if (id < 65536) { const int e = id >> 11, q = id & 2047, kb = q >> 6, nb = q & 63; dst = F.ws + WS_WE1 + (((size_t)l * NEXP + e) * 2048 * DM + (size_t)(32 * nb) * DM + 32 * kb); K = DM; }
        else { const int r = id - 65536, e = r >> 10, q = r & 1023, kb = q >> 5, nb = q & 31; dst = F.ws + WS_WE2 + (((size_t)l * NEXP + e) * DM * FEXP + (size_t)(32 * nb) * FEXP + 32 * kb); K = FEXP; }
        const LAS float* sp = (const LAS float*)(F.lds + ATT_BGSCR_OFF + wave * 4096) + (lane >> 5) * 512 + (lane & 31);
        float v[16];
#pragma unroll
        for (int i = 0; i < 16; ++i) v[i] = sp[32 * i];
        u32x4 o; o.x = pk4_fp8(v[0] * WSCALE, v[1] * WSCALE, v[2] * WSCALE, v[3] * WSCALE); o.y = pk4_fp8(v[4] * WSCALE, v[5] * WSCALE, v[6] * WSCALE, v[7] * WSCALE);
        o.z = pk4_fp8(v[8] * WSCALE, v[9] * WSCALE, v[10] * WSCALE, v[11] * WSCALE); o.w = pk4_fp8(v[12] * WSCALE, v[13] * WSCALE, v[14] * WSCALE, v[15] * WSCALE);
        *(u32x4*)(dst + (size_t)(lane & 31) * K + 16 * (lane >> 5)) = o;
        itp = -1;
    }
    template <bool UNCOND> DI void request(Frame& F, int wave, int lane) {
        if (it >= BG_ITEMS) {
            if (UNCOND) { const GAS unsigned char* rb = (const GAS unsigned char*)F.in(I_EW1); LAS unsigned char* scr = F.lds + ATT_BGSCR_OFF + wave * 4096;
#pragma unroll
                for (int i = 0; i < 4; ++i) { asm volatile("" : "+s"(rb)); __builtin_amdgcn_global_load_lds((const GAS unsigned*)rb, (LAS unsigned*)(scr + 1024 * i), 16, 0, 0); } }
            return;
        }
        const float* W; int Nsrc, k0, n0; bool m2;
        if (it < 65536) { const int e = it >> 11, q = it & 2047, kb = q >> 6, nb = q & 63; W = F.in(I_EW1) + ((size_t)l * NEXP + e) * DM * 2048; Nsrc = 2048; k0 = 32 * kb; n0 = 32 * nb; m2 = true; }
        else { const int r = it - 65536, e = r >> 10, q = r & 1023, kb = q >> 5, nb = q & 31; W = F.in(I_EW2) + ((size_t)l * NEXP + e) * FEXP * DM; Nsrc = DM; k0 = 32 * kb; n0 = 32 * nb; m2 = false; }
        const int ns = m2 ? map_w1(n0) : n0;
        const unsigned char* rowb = (const unsigned char*)(W + (size_t)k0 * Nsrc + ns);
        const unsigned boff = (unsigned)((lane >> 3) * Nsrc + 4 * (lane & 7)) * 4u;
        LAS unsigned char* scr = F.lds + ATT_BGSCR_OFF + wave * 4096;
#pragma unroll
        for (int i = 0; i < 4; ++i) { const GAS unsigned char* rb = (const GAS unsigned char*)(rowb + (size_t)(32 * i) * Nsrc); asm volatile("" : "+s"(rb));
            __builtin_amdgcn_global_load_lds((const GAS unsigned*)(rb + boff), (LAS unsigned*)(scr + 1024 * i), 16, 0, 0); }
        itp = it; it += stride;
    }
    DI void drain(Frame& F, int wave, int lane) { asm volatile("s_waitcnt vmcnt(0)" ::: "memory"); finish(F, wave, lane); }
    DI void rest(Frame& F, int wave, int lane) {
        while (it < BG_ITEMS) { request<false>(F, wave, lane); asm volatile("s_waitcnt vmcnt(0)" ::: "memory"); finish(F, wave, lane); asm volatile("s_waitcnt lgkmcnt(0)" ::: "memory"); }
    }
};
constexpr int ATT_BUF_BYTES = 88064;
constexpr int ATT_FPRE_OFF = 90112, ATT_SELM_OFF = 94208, ATT_MISC_OFF = 96256;
#ifndef MLA_BG
#define MLA_BG 1
#endif
#ifndef MLA_SGB
#define MLA_SGB 1
#endif
#ifndef MLA_PRIO
#define MLA_PRIO 0
#endif
#ifndef MLA_TR
#define MLA_TR 3
#define MLA_VA 4
#endif
template <int VAR = 0> DI void mla_wg_unit(Frame& F, int hh, int qb, BgConv& bg) {
    constexpr int DQ = 96, NKS = DQ / 16, KCH = DQ / 8, KSTR = DQ + 8, VSTR = 136;
    constexpr int KBYTES = 128 * KSTR * 2, VBYTES = 64 * VSTR * 2, BUF = KBYTES + VBYTES, KPC = 128 * KCH / NTHREADS;
    static_assert(2 * BUF <= ATT_BUF_BYTES, "attention LDS map");
    static_assert(DQ * 2 == KCH * 16, "K rows are contiguous");
#define ML_BAR do { asm volatile("s_waitcnt lgkmcnt(0)" ::: "memory"); __builtin_amdgcn_s_barrier(); asm volatile("" ::: "memory"); } while (0)
    int tid_ = threadIdx.x; asm volatile("" : "+v"(tid_));
    const int tid = tid_, lane = tid & 63, wave = __builtin_amdgcn_readfirstlane(tid >> 6), r32 = lane & 31, hi = lane >> 5, qg = wave & 3, kh = wave >> 2;
    const int t = 128 * qb + 32 * qg + r32;
    const bf16_t* Kg = (const bf16_t*)(F.ws + WS_KA) + (size_t)hh * SEQ * DQ;
    const bf16_t* Vg = (const bf16_t*)(F.ws + WS_VAT) + (size_t)hh * 64 * SEQ;
    bf16x8 qf[NKS];
    { const bf16_t* Qp = (const bf16_t*)(F.ws + WS_QA) + ((size_t)hh * SEQ + t) * DQ + 8 * hi;
#pragma unroll
      for (int ks = 0; ks < NKS; ++ks) qf[ks] = *(const bf16x8*)(Qp + 16 * ks);
#pragma unroll
      for (int ks = 0; ks < NKS; ++ks) asm volatile("" :: "v"(qf[ks])); }
    float m = 0.f, lsum = 0.f;
    f32x16 o0, o1;
#pragma unroll
    for (int r = 0; r < 16; ++r) { o0[r] = 0.f; o1[r] = 0.f; }
    const int n = qb + 1;
    u32x4 sk[KPC], sv[2];
    const unsigned gk0 = (unsigned)((tid >> 2) * (DQ * 2) + (tid & 3) * 16), lk0 = (unsigned)((tid >> 2) * (KSTR * 2) + (tid & 3) * 16);
    const unsigned gv0 = (unsigned)((tid >> 4) * SEQ + 8 * (tid & 15)) * 2u, lv0 = (unsigned)(KBYTES + ((tid >> 4) * VSTR + 8 * (tid & 15)) * 2);
    static_assert(KPC == 3, "three K chunks per thread");
#define ML_LOADK(dst_, T_) do { const GAS unsigned char* kb_ = (const GAS unsigned char*)(Kg + (size_t)(128 * (T_)) * DQ); asm volatile("" : "+s"(kb_)); unsigned o_ = gk0; asm volatile("" : "+v"(o_)); \
            _Pragma("unroll") for (int j = 0; j < KPC; ++j) dst_[j] = *(const GAS u32x4*)(kb_ + o_ + 64 * j); } while (0)
#define ML_LOADV(T_) do { _Pragma("unroll") for (int j = 0; j < 2; ++j) { const GAS unsigned char* vb_ = (const GAS unsigned char*)(Vg + 128 * (T_) + (size_t)(32 * j) * SEQ); asm volatile("" : "+s"(vb_)); \
            unsigned o_ = gv0; asm volatile("" : "+v"(o_)); sv[j] = *(const GAS u32x4*)(vb_ + o_); } } while (0)
#define ML_STOREK(src_, b_) do { const unsigned a_ = (unsigned)(size_t)(F.lds + (b_) * BUF) + lk0; _Pragma("unroll") for (int j = 0; j < KPC; ++j) asm volatile("ds_write_b128 %0, %1 offset:%2" :: "v"(a_), "v"(src_[j]), "n"(64 * j) : "memory"); } while (0)
#define ML_STOREV(b_) do { const unsigned a_ = (unsigned)(size_t)(F.lds + (b_) * BUF) + lv0; _Pragma("unroll") for (int j = 0; j < 2; ++j) asm volatile("ds_write_b128 %0, %1 offset:%2" :: "v"(a_), "v"(sv[j]), "n"(32 * j * VSTR * 2) : "memory"); } while (0)
    { u32x4 sk1[KPC];
      ML_LOADK(sk, 0); ML_LOADV(0); if (n > 1) ML_LOADK(sk1, 1);
      ML_STOREK(sk, 0); ML_STOREV(0); if (n > 1) ML_STOREK(sk1, 1); }
    if (n > 2) ML_LOADK(sk, 2);
    if (n > 1) ML_LOADV(1);
    ML_BAR;
    auto qk = [&](const int b, f32x16& s0, f32x16& s1) __attribute__((always_inline)) {
        const LAS bf16_t* kp = (const LAS bf16_t*)(F.lds + b * BUF) + (64 * kh + swap23(r32)) * KSTR + 8 * hi;
        bf16x8 kf0[NKS], kf1[NKS];
#pragma unroll
        for (int ks = 0; ks < NKS; ++ks) { kf0[ks] = *(const LAS bf16x8*)(kp + 16 * ks); kf1[ks] = *(const LAS bf16x8*)(kp + 32 * KSTR + 16 * ks); }
        f32x16 zz;
#pragma unroll
        for (int r = 0; r < 16; ++r) zz[r] = 0.f;
        s0 = MFMA32(kf0[0], qf[0], zz); s1 = MFMA32(kf1[0], qf[0], zz);
#pragma unroll
        for (int ks = 1; ks < NKS; ++ks) { s0 = MFMA32(kf0[ks], qf[ks], s0); s1 = MFMA32(kf1[ks], qf[ks], s1); }
    };
    auto step = [&](const int i, f32x16& c0, f32x16& c1, f32x16& n0, f32x16& n1, auto hasnextc, auto lastc, auto bgc) __attribute__((always_inline)) {
        constexpr bool HASNEXT = decltype(hasnextc)::value, LAST = decltype(lastc)::value; constexpr int BGM = (BG_CONVERT && VAR == 0 && MLA_BG) ? decltype(bgc)::value : 0;
        if (i + 2 < n) ML_STOREK(sk, i & 1);
        if (i + 1 < n) ML_STOREV((i + 1) & 1);
        if (i + 3 < n) ML_LOADK(sk, (VAR == 5 ? 0 : i + 3));
        if (i + 2 < n) ML_LOADV((VAR == 5 ? 0 : i + 2));
        if constexpr (BGM == 1) bg.template request<true>(F, wave, lane);
        const LAS bf16_t* kp = (const LAS bf16_t*)(F.lds + ((i + 1) & 1) * BUF) + (64 * kh + swap23(r32)) * KSTR + 8 * hi;
        bf16x8 kf[2 * NKS];
        if constexpr (HASNEXT) { kf[0] = *(const LAS bf16x8*)(kp); kf[1] = *(const LAS bf16x8*)(kp + 32 * KSTR); kf[2] = *(const LAS bf16x8*)(kp + 16); }
        if constexpr (LAST) {
            const int d0 = t - (128 * qb + 64 * kh + 8 * hi);
#pragma unroll
            for (int r = 0; r < 16; ++r) { const int dd = d0 - (16 * (r >> 3) + (r & 7)); if (dd < 0) c0[r] = -INFINITY; if (dd - 32 < 0) c1[r] = -INFINITY; }
        }
        if (!__all(m == 0.f)) {
#pragma unroll
            for (int r = 0; r < 16; ++r) { c0[r] -= m; c1[r] -= m; }
        }
        float rm = fmaxf(c0[0], c1[0]);
#pragma unroll
        for (int r = 1; r < 16; ++r) rm = fmaxf(fmaxf(rm, c0[r]), c1[r]);
        rm = max_x32(rm);
        if (__any(rm > 8.0f)) {
            const float dl = fmaxf(rm, 0.f), alpha = __builtin_amdgcn_exp2f(-dl);
            m += dl; lsum *= alpha;
#pragma unroll
            for (int r = 0; r < 16; ++r) { c0[r] -= dl; c1[r] -= dl; o0[r] *= alpha; o1[r] *= alpha; }
        }
        if constexpr (HASNEXT) {
            kf[3] = *(const LAS bf16x8*)(kp + 32 * KSTR + 16);
#pragma unroll
            for (int ks = 2; ks < NKS; ++ks) { kf[2 * ks] = *(const LAS bf16x8*)(kp + 16 * ks); kf[2 * ks + 1] = *(const LAS bf16x8*)(kp + 32 * KSTR + 16 * ks); }
            f32x16 zz;
#pragma unroll
            for (int r = 0; r < 16; ++r) zz[r] = 0.f;
            n0 = MFMA32(kf[0], qf[0], zz); n1 = MFMA32(kf[1], qf[0], zz);
#pragma unroll
            for (int ks = 1; ks < NKS; ++ks) { n0 = MFMA32(kf[2 * ks], qf[ks], n0); n1 = MFMA32(kf[2 * ks + 1], qf[ks], n1); }
        }
        float psum = 0.f;
#pragma unroll
        for (int r = 0; r < 16; ++r) { c0[r] = __builtin_amdgcn_exp2f(c0[r]); psum += c0[r]; }
#pragma unroll
        for (int r = 0; r < 16; ++r) { c1[r] = __builtin_amdgcn_exp2f(c1[r]); psum += c1[r]; }
        lsum += psum;
        u32x4 w0, w1, w2, w3;
        w0.x = pk2(c0[0], c0[1]); w0.y = pk2(c0[2], c0[3]); w0.z = pk2(c0[4], c0[5]); w0.w = pk2(c0[6], c0[7]);
        w1.x = pk2(c0[8], c0[9]); w1.y = pk2(c0[10], c0[11]); w1.z = pk2(c0[12], c0[13]); w1.w = pk2(c0[14], c0[15]);
        w2.x = pk2(c1[0], c1[1]); w2.y = pk2(c1[2], c1[3]); w2.z = pk2(c1[4], c1[5]); w2.w = pk2(c1[6], c1[7]);
        w3.x = pk2(c1[8], c1[9]); w3.y = pk2(c1[10], c1[11]); w3.z = pk2(c1[12], c1[13]); w3.w = pk2(c1[14], c1[15]);
        const bf16x8 pf0 = __builtin_bit_cast(bf16x8, w0), pf1 = __builtin_bit_cast(bf16x8, w1), pf2 = __builtin_bit_cast(bf16x8, w2), pf3 = __builtin_bit_cast(bf16x8, w3);
        const LAS bf16_t* vp = (const LAS bf16_t*)(F.lds + (i & 1) * BUF + KBYTES) + r32 * VSTR + 64 * kh + 8 * hi;
        bf16x8 vf0[4], vf1[4];
        vf0[0] = *(const LAS bf16x8*)(vp); vf0[2] = *(const LAS bf16x8*)(vp + 32 * VSTR); vf0[1] = *(const LAS bf16x8*)(vp + 16); vf0[3] = *(const LAS bf16x8*)(vp + 32 * VSTR + 16);
        vf1[0] = *(const LAS bf16x8*)(vp + 32); vf1[2] = *(const LAS bf16x8*)(vp + 32 * VSTR + 32); vf1[1] = *(const LAS bf16x8*)(vp + 48); vf1[3] = *(const LAS bf16x8*)(vp + 32 * VSTR + 48);
        o0 = MFMA32(vf0[0], pf0, o0); o1 = MFMA32(vf0[2], pf0, o1);
        o0 = MFMA32(vf0[1], pf1, o0); o1 = MFMA32(vf0[3], pf1, o1);
        o0 = MFMA32(vf1[0], pf2, o0); o1 = MFMA32(vf1[2], pf2, o1);
        o0 = MFMA32(vf1[1], pf3, o0); o1 = MFMA32(vf1[3], pf3, o1);
#if MLA_SGB
        if constexpr (HASNEXT) {
#pragma unroll
            for (int k = 0; k < 12; ++k) { __builtin_amdgcn_sched_group_barrier(0x008, 1, 0); __builtin_amdgcn_sched_group_barrier(0x100, 1, 0);
                __builtin_amdgcn_sched_group_barrier(0x400, MLA_TR, 0); __builtin_amdgcn_sched_group_barrier(0x002, MLA_VA, 0); }
            __builtin_amdgcn_sched_group_barrier(0x400, 8, 0); __builtin_amdgcn_sched_group_barrier(0x002, 16, 0);
#pragma unroll
            for (int k = 0; k < 8; ++k) { __builtin_amdgcn_sched_group_barrier(0x008, 1, 0); __builtin_amdgcn_sched_group_barrier(0x100, 1, 0); }
        }
#endif
        if constexpr (BGM == 2) { asm volatile("s_waitcnt vmcnt(0)" ::: "memory"); bg.finish(F, wave, lane); }
        ML_BAR;
    };
    if (BG_CONVERT && VAR == 0 && MLA_BG) { if (bg.itp >= 0) bg.drain(F, wave, lane); }
#if MLA_PRIO
    if (kh == 1) __builtin_amdgcn_s_setprio(1);
#endif
    f32x16 sA0, sA1, sB0, sB1;
    qk(0, sA0, sA1);
    ML_BAR;
    {   const std::true_type Y{}; const std::false_type N{}; const std::integral_constant<int, 0> B0{}; const std::integral_constant<int, 1> B1{}; const std::integral_constant<int, 2> B2{};
        int i = 0;
        for (; i + 2 < n; i += 2) { step(i, sA0, sA1, sB0, sB1, Y, N, B1); step(i + 1, sB0, sB1, sA0, sA1, Y, N, B2); }
        if (n - i == 2) { step(i, sA0, sA1, sB0, sB1, Y, N, B1); step(i + 1, sB0, sB1, sA0, sA1, N, Y, B2); }
        else step(i, sA0, sA1, sB0, sB1, N, Y, B0);
    }
#if MLA_PRIO
    __builtin_amdgcn_s_setprio(0);
#endif
#undef ML_LOADK
#undef ML_LOADV
#undef ML_STOREK
#undef ML_STOREV
#undef ML_BAR
    const float ltot = sum_x32(lsum);
    LAS float* mg = (LAS float*)F.lds + qg * (34 * 64) + lane;
    if (kh == 1) {
        mg[0] = m; mg[64] = ltot;
#pragma unroll
        for (int r = 0; r < 16; ++r) { mg[(2 + r) * 64] = o0[r]; mg[(18 + r) * 64] = o1[r]; }
    }
    __syncthreads();
    if (kh == 0) {
        const float m1 = mg[0], l1 = mg[64];
        const float M = fmaxf(m, m1), a0 = __builtin_amdgcn_exp2f(m - M), a1 = __builtin_amdgcn_exp2f(m1 - M);
        const float inv = 1.0f / (ltot * a0 + l1 * a1), c0 = a0 * inv, c1 = a1 * inv;
#pragma unroll
        for (int r = 0; r < 16; ++r) { o0[r] = o0[r] * c0 + mg[(2 + r) * 64] * c1; o1[r] = o1[r] * c0 + mg[(18 + r) * 64] * c1; }
        if (VAR != 0) { asm volatile("" :: "v"(o0), "v"(o1)); }
        else {
        bf16_t* od = (bf16_t*)(F.ws + WS_O) + (size_t)t * DM + hh * 64 + 4 * hi;
#pragma unroll
        for (int g4 = 0; g4 < 4; ++g4) {
            u32x2 w; w.x = pk2(o0[4 * g4], o0[4 * g4 + 1]); w.y = pk2(o0[4 * g4 + 2], o0[4 * g4 + 3]); *(u32x2*)(od + 8 * g4) = w;
            u32x2 z; z.x = pk2(o1[4 * g4], o1[4 * g4 + 1]); z.y = pk2(o1[4 * g4 + 2], o1[4 * g4 + 3]); *(u32x2*)(od + 32 + 8 * g4) = z;
        }
        }
    }
    __syncthreads();
}
struct DilUnit { int hh, p, c, ib; };
DI DilUnit dil_decode(int uid) { DilUnit u; u.hh = uid / 384; const int rem = uid % 384; u.p = rem >> 7; const int blk = rem & 127, bpc = 128 >> (2 * u.p); u.c = blk / bpc; u.ib = blk % bpc; return u; }
struct DilPre { u32x4 sk[2], sv[2], sk2[2], sv2[2]; bf16x8 qf[4]; };
DI void dil_preload(Frame& F, const DilUnit& u, DilPre& P) {
    int tid_ = threadIdx.x; asm volatile("" : "+v"(tid_));
    const int tid = tid_, lane = tid & 63, wave = __builtin_amdgcn_readfirstlane(tid >> 6), r32 = lane & 31, hi = lane >> 5, qg = wave & 3;
    const int rs = 2 * u.p;
    const bf16_t* Kg = (const bf16_t*)(F.ws + WS_KD) + (size_t)u.hh * SEQ * 64;
    const bf16_t* Vg = (const bf16_t*)(F.ws + WS_PROJ) + PC_DV + 64 * u.hh;
#pragma unroll
    for (int i = 0; i < 2; ++i) { const int pp = tid + NTHREADS * i, key = pp >> 3, ch = pp & 7; const size_t tok = ((size_t)(128 * u.ib + key) << rs) + u.c;
        P.sk[i] = *(const u32x4*)(Kg + tok * 64 + 8 * ch); P.sv[i] = *(const u32x4*)(Vg + tok * NP + 8 * ch); }
    if (u.ib > 0) {
#pragma unroll
        for (int i = 0; i < 2; ++i) { const int pp = tid + NTHREADS * i, key = pp >> 3, ch = pp & 7; const size_t tok = ((size_t)(128 * (u.ib - 1) + key) << rs) + u.c;
            P.sk2[i] = *(const u32x4*)(Kg + tok * 64 + 8 * ch); P.sv2[i] = *(const u32x4*)(Vg + tok * NP + 8 * ch); }
    }
    const int t = ((128 * u.ib + 32 * qg + r32) << rs) + u.c;
    const bf16_t* Qp = (const bf16_t*)(F.ws + WS_QD) + ((size_t)u.hh * SEQ + t) * 64 + 8 * hi;
#pragma unroll
    for (int ks = 0; ks < 4; ++ks) P.qf[ks] = *(const bf16x8*)(Qp + 16 * ks);
}
DI void dil_wg_unit(Frame& F, const DilUnit& U, DilPre& P, bool has_next, const DilUnit& N) {
    constexpr int KSTR = 72, VSTR = 136, KBYTES = 128 * KSTR * 2, VBYTES = 64 * VSTR * 2, BUF = KBYTES + VBYTES;
    const int hh = U.hh, p = U.p, c = U.c, ib = U.ib;
    int tid_ = threadIdx.x; asm volatile("" : "+v"(tid_));
    const int tid = tid_, lane = tid & 63, wave = __builtin_amdgcn_readfirstlane(tid >> 6), r32 = lane & 31, hi = lane >> 5, qg = wave & 3, kh = wave >> 2;
    const int rs = 2 * p, r = 1 << rs;
    const int iq = 128 * ib + 32 * qg + r32, t = (iq << rs) + c;
    const bf16_t* Kg = (const bf16_t*)(F.ws + WS_KD) + (size_t)hh * SEQ * 64;
    const bf16_t* Vg = (const bf16_t*)(F.ws + WS_PROJ) + PC_DV + 64 * hh;
    bf16x8 qf[4];
#pragma unroll
    for (int ks = 0; ks < 4; ++ks) { qf[ks] = P.qf[ks]; asm volatile("" :: "v"(qf[ks])); }
    float m = 0.f, lsum = 0.f;
    f32x16 o0, o1;
#pragma unroll
    for (int q = 0; q < 16; ++q) { o0[q] = 0.f; o1[q] = 0.f; }
    const float slope2 = exp2f(-(float)(2 * hh + 1)) * LOG2E * (float)r;
    f32x16 cb;
#pragma unroll
    for (int q = 0; q < 16; ++q) cb[q] = slope2 * (float)(16 * (q >> 3) + (q & 7) + 8 * hi);
    u32x4 sk[2], sv[2];
#define DL_STORE(b_) do { LAS unsigned char* kb_ = F.lds + (b_) * BUF; _Pragma("unroll") for (int i = 0; i < 2; ++i) { const int pp = tid + NTHREADS * i, key = pp >> 3, ch = pp & 7; \
        *(LAS u32x4*)(kb_ + (key * KSTR + 8 * ch) * 2) = sk[i]; LAS bf16_t* vb_ = (LAS bf16_t*)(kb_ + KBYTES) + (8 * ch) * VSTR + key; \
        vb_[0 * VSTR] = (bf16_t)(sv[i].x & 0xffffu); vb_[1 * VSTR] = (bf16_t)(sv[i].x >> 16); vb_[2 * VSTR] = (bf16_t)(sv[i].y & 0xffffu); vb_[3 * VSTR] = (bf16_t)(sv[i].y >> 16); \
        vb_[4 * VSTR] = (bf16_t)(sv[i].z & 0xffffu); vb_[5 * VSTR] = (bf16_t)(sv[i].z >> 16); vb_[6 * VSTR] = (bf16_t)(sv[i].w & 0xffffu); vb_[7 * VSTR] = (bf16_t)(sv[i].w >> 16); } } while (0)
#pragma unroll
    for (int i = 0; i < 2; ++i) { sk[i] = P.sk[i]; sv[i] = P.sv[i]; }
    DL_STORE(0);
    if (ib > 0) {
#pragma unroll
        for (int i = 0; i < 2; ++i) { sk[i] = P.sk2[i]; sv[i] = P.sv2[i]; }
        DL_STORE(1);
    }
    __syncthreads();
    const int nt = ib > 0 ? 2 : 1;
    for (int ti = 0; ti < nt; ++ti) {
        const int T = ib - ti;
        if (ti == nt - 1 && has_next) dil_preload(F, N, P);
        const LAS bf16_t* Kb = (const LAS bf16_t*)(F.lds + ti * BUF);
        const LAS bf16_t* Vb = (const LAS bf16_t*)(F.lds + ti * BUF + KBYTES);
#pragma unroll
        for (int jj = 0; jj < 2; ++jj) {
            const int j = 1 - jj, sidx = 2 * kh + j;
            if (T == ib && sidx > qg) continue;
            if (T < ib && sidx < qg) continue;
            const LAS bf16_t* kp = Kb + (64 * kh + 32 * j + swap23(r32)) * KSTR + 8 * hi;
            const LAS bf16_t* vp = Vb + r32 * VSTR + 64 * kh + 32 * j + 8 * hi;
            bf16x8 kf[4], vf[4];
#pragma unroll
            for (int ks = 0; ks < 4; ++ks) kf[ks] = *(const LAS bf16x8*)(kp + 16 * ks);
            vf[0] = *(const LAS bf16x8*)(vp); vf[1] = *(const LAS bf16x8*)(vp + 16); vf[2] = *(const LAS bf16x8*)(vp + 32 * VSTR); vf[3] = *(const LAS bf16x8*)(vp + 32 * VSTR + 16);
            f32x16 s = MFMA32(kf[0], qf[0], cb);
#pragma unroll
            for (int ks = 1; ks < 4; ++ks) s = MFMA32(kf[ks], qf[ks], s);
            const int D = iq - (128 * T + 64 * kh + 32 * j);
            if (sidx == qg) {
                const int d0 = D - 8 * hi;
#pragma unroll
                for (int i = 0; i < 16; ++i) { const int dl = d0 - (16 * (i >> 3) + (i & 7)); if (dl < 0 || dl > 128) s[i] = -INFINITY; }
            }
            float mj = m + slope2 * (float)D;
            float rm = fmaxf(s[0], s[1]);
#pragma unroll
            for (int i = 2; i < 16; ++i) rm = fmaxf(rm, s[i]);
            rm = max_x32(rm) - mj;
            if (__any(rm > 8.0f)) {
                const float dl = fmaxf(rm, 0.f), alpha = __builtin_amdgcn_exp2f(-dl);
                m += dl; mj += dl; lsum *= alpha;
#pragma unroll
                for (int q = 0; q < 16; ++q) { o0[q] *= alpha; o1[q] *= alpha; }
            }
            float pr[16], psum = 0.f;
#pragma unroll
            for (int i = 0; i < 16; ++i) { pr[i] = __builtin_amdgcn_exp2f(s[i] - mj); psum += pr[i]; }
            lsum += psum;
            u32x4 w0, w1;
            w0.x = pk2(pr[0], pr[1]); w0.y = pk2(pr[2], pr[3]); w0.z = pk2(pr[4], pr[5]); w0.w = pk2(pr[6], pr[7]);
            w1.x = pk2(pr[8], pr[9]); w1.y = pk2(pr[10], pr[11]); w1.z = pk2(pr[12], pr[13]); w1.w = pk2(pr[14], pr[15]);
            const bf16x8 pf0 = __builtin_bit_cast(bf16x8, w0), pf1 = __builtin_bit_cast(bf16x8, w1);
            o0 = MFMA32(vf[0], pf0, o0); o0 = MFMA32(vf[1], pf1, o0);
            o1 = MFMA32(vf[2], pf0, o1); o1 = MFMA32(vf[3], pf1, o1);
        }
    }
    __syncthreads();
#undef DL_STORE
    const float ltot = sum_x32(lsum);
    LAS float* mg = (LAS float*)F.lds + qg * (34 * 64) + lane;
    if (kh == 1) {
        mg[0] = m; mg[64] = ltot;
#pragma unroll
        for (int q = 0; q < 16; ++q) { mg[(2 + q) * 64] = o0[q]; mg[(18 + q) * 64] = o1[q]; }
    }
    __syncthreads();
    if (kh == 0) {
        const float m1 = mg[0], l1 = mg[64];
        const float M = fmaxf(m, m1), a0 = __builtin_amdgcn_exp2f(m - M), a1 = __builtin_amdgcn_exp2f(m1 - M);
        const float L = ltot * a0 + l1 * a1, inv = 1.0f / L, c0 = a0 * inv, c1 = a1 * inv;
#pragma unroll
        for (int q = 0; q < 16; ++q) { o0[q] = o0[q] * c0 + mg[(2 + q) * 64] * c1; o1[q] = o1[q] * c0 + mg[(18 + q) * 64] * c1; }
        const size_t pidx = ((size_t)hh * SEQ + t) * 4 + p;
        if (hi == 0) { float* pm = (float*)(F.ws + WS_DM) + pidx * 2; pm[0] = M; pm[1] = L; }
        bf16_t* od = (bf16_t*)(F.ws + WS_DO) + pidx * 64 + 4 * hi;
#pragma unroll
        for (int g4 = 0; g4 < 4; ++g4) {
            u32x2 w; w.x = pk2(o0[4 * g4], o0[4 * g4 + 1]); w.y = pk2(o0[4 * g4 + 2], o0[4 * g4 + 3]); *(u32x2*)(od + 8 * g4) = w;
            u32x2 z; z.x = pk2(o1[4 * g4], o1[4 * g4 + 1]); z.y = pk2(o1[4 * g4 + 2], o1[4 * g4 + 3]); *(u32x2*)(od + 32 + 8 * g4) = z;
        }
    }
    __syncthreads();
}
DI void moba_select(Frame& F, const LAS float* kmean, int hh, int t, int ownb, int& o1, int& o2, int& o3) {
    const int lane = F.lane, r32 = lane & 31, hi = lane >> 5;
    float qv[64];
    { const bf16_t* qrow = (const bf16_t*)(F.ws + WS_QC) + ((size_t)hh * SEQ + t) * 64;
#pragma unroll
      for (int i = 0; i < 8; ++i) { const bf16x8 r = *(const bf16x8*)(qrow + 8 * i);
#pragma unroll
          for (int e = 0; e < 8; ++e) qv[8 * i + e] = bf2f((bf16_t)r[e]); } }
    float v1 = -INFINITY, v2 = -INFINITY, v3 = -INFINITY; int i1 = -1, i2 = -1, i3 = -1;
    for (int n = hi; n < ownb; n += 2) {
        const LAS f32x4* km = (const LAS f32x4*)(kmean + (hh * 64 + n) * 64);
        float g0 = 0.f, g1 = 0.f;
#pragma unroll
        for (int d4 = 0; d4 < 16; d4 += 2) { const f32x4 k0 = km[d4], k1 = km[d4 + 1];
            g0 += qv[4 * d4] * k0.x + qv[4 * d4 + 1] * k0.y + qv[4 * d4 + 2] * k0.z + qv[4 * d4 + 3] * k0.w;
            g1 += qv[4 * d4 + 4] * k1.x + qv[4 * d4 + 5] * k1.y + qv[4 * d4 + 6] * k1.z + qv[4 * d4 + 7] * k1.w; }
        const float g = g0 + g1;
        if (g > v1) { v3 = v2; i3 = i2; v2 = v1; i2 = i1; v1 = g; i1 = n; }
        else if (g > v2) { v3 = v2; i3 = i2; v2 = g; i2 = n; }
        else if (g > v3) { v3 = g; i3 = n; }
    }
    float pv[3]; int pi[3];
    pv[0] = __shfl_xor(v1, 32); pv[1] = __shfl_xor(v2, 32); pv[2] = __shfl_xor(v3, 32);
    pi[0] = __shfl_xor(i1, 32); pi[1] = __shfl_xor(i2, 32); pi[2] = __shfl_xor(i3, 32);
#pragma unroll
    for (int c = 0; c < 3; ++c) {
        const float g = pv[c]; const int n = pi[c];
        if (n >= 0) {
            if (g > v1 || (g == v1 && n < i1)) { v3 = v2; i3 = i2; v2 = v1; i2 = i1; v1 = g; i1 = n; }
            else if (g > v2 || (g == v2 && n < i2)) { v3 = v2; i3 = i2; v2 = g; i2 = n; }
            else if (g > v3 || (g == v3 && n < i3)) { v3 = g; i3 = n; }
        }
    }
    o1 = i1; o2 = i2; o3 = i3; (void)r32;
}
struct MobaPre { int e; u32x4 sk[4], sv[4]; };
DI void moba_request(Frame& F, int hh, int n, const int* list, int q0, int cnt, bool own, MobaPre& P) {
    int tid_ = threadIdx.x; asm volatile("" : "+v"(tid_));
    const int tid = tid_, lane = tid & 63, wave = __builtin_amdgcn_readfirstlane(tid >> 6), r32 = lane & 31;
    const bf16_t* Kg = (const bf16_t*)(F.ws + WS_KC) + ((size_t)hh * SEQ + 256 * n) * 64;
    const bf16_t* Vg = (const bf16_t*)(F.ws + WS_VCT) + (size_t)hh * 64 * SEQ + 256 * n;
    P.e = 0;
    if (!own) { const int idx = q0 + 32 * wave + r32; P.e = list[idx < cnt ? idx : q0]; }
#pragma unroll
    for (int i = 0; i < 4; ++i) { const int p = tid + NTHREADS * i; P.sk[i] = *(const u32x4*)(Kg + (size_t)(p >> 3) * 64 + 8 * (p & 7)); P.sv[i] = *(const u32x4*)(Vg + (size_t)(p >> 5) * SEQ + 8 * (p & 31)); }
}
template <class Hook> DI void moba_block_unit(Frame& F, int hh, int n, int q0, int cnt, bool own, MobaPre& P, Hook&& hook) {
    constexpr int KSTR = 72, VSTR = 264, KBYTES = 256 * KSTR * 2;
    int tid_ = threadIdx.x; asm volatile("" : "+v"(tid_));
    const int tid = tid_, lane = tid & 63, wave = __builtin_amdgcn_readfirstlane(tid >> 6), r32 = lane & 31, hi = lane >> 5;
    LAS bf16_t* Kb = (LAS bf16_t*)F.lds; LAS bf16_t* Vb = (LAS bf16_t*)(F.lds + KBYTES);
    int t, slot = 3; const int e = P.e; bool valid = true;
    if (!own) valid = (q0 + 32 * wave + r32) < cnt;
    const bool wave_any = own || (q0 + 32 * wave < cnt);
    if (own) t = 256 * n + 32 * wave + r32; else { t = e & 0xffff; slot = e >> 16; }
    bf16x8 qf[4];
    { const bf16_t* Qp = (const bf16_t*)(F.ws + WS_QC) + ((size_t)hh * SEQ + t) * 64 + 8 * hi;
#pragma unroll
      for (int ks = 0; ks < 4; ++ks) qf[ks] = *(const bf16x8*)(Qp + 16 * ks); }
#pragma unroll
    for (int i = 0; i < 4; ++i) { const int p = tid + NTHREADS * i; *(LAS u32x4*)(Kb + (p >> 3) * KSTR + 8 * (p & 7)) = P.sk[i]; *(LAS u32x4*)(Vb + (p >> 5) * VSTR + 8 * (p & 31)) = P.sv[i]; }
    __syncthreads();
    float m = 0.f, ltot = 1.f; f32x16 o0, o1;
#pragma unroll
    for (int r = 0; r < 16; ++r) { o0[r] = 0.f; o1[r] = 0.f; }
    if (wave_any) {
        const float slope2 = exp2f(-(float)(2 * hh + 2)) * LOG2E;
        f32x16 cb;
#pragma unroll
        for (int r = 0; r < 16; ++r) cb[r] = slope2 * (float)(16 * (r >> 3) + (r & 7) + 8 * hi);
        const int jend = own ? wave : 7;
        m = slope2 * (float)(32 * jend + 31); float lsum = 0.f;
        for (int j = jend; j >= 0; --j) {
            const LAS bf16_t* kp = Kb + (32 * j + swap23(r32)) * KSTR + 8 * hi;
            const LAS bf16_t* vp = Vb + r32 * VSTR + 32 * j + 8 * hi;
            bf16x8 kf[4], vf[4];
#pragma unroll
            for (int ks = 0; ks < 4; ++ks) kf[ks] = *(const LAS bf16x8*)(kp + 16 * ks);
            vf[0] = *(const LAS bf16x8*)(vp); vf[1] = *(const LAS bf16x8*)(vp + 16); vf[2] = *(const LAS bf16x8*)(vp + 32 * VSTR); vf[3] = *(const LAS bf16x8*)(vp + 32 * VSTR + 16);
            f32x16 s = MFMA32(kf[0], qf[0], cb);
#pragma unroll
            for (int ks = 1; ks < 4; ++ks) s = MFMA32(kf[ks], qf[ks], s);
            if (own && j == wave) {
                const int d0 = t - (256 * n + 32 * j + 8 * hi);
#pragma unroll
                for (int i = 0; i < 16; ++i) { const int dl = d0 - (16 * (i >> 3) + (i & 7)); if (dl < 0) s[i] = -INFINITY; }
            }
            float mj = m - slope2 * (float)(32 * j);
            float rm = fmaxf(s[0], s[1]);
#pragma unroll
            for (int i = 2; i < 16; ++i) rm = fmaxf(rm, s[i]);
            rm = max_x32(rm) - mj;
            if (__any(rm > 8.0f)) {
                const float dl = fmaxf(rm, 0.f), alpha = __builtin_amdgcn_exp2f(-dl);
                m += dl; mj += dl; lsum *= alpha;
#pragma unroll
                for (int r = 0; r < 16; ++r) { o0[r] *= alpha; o1[r] *= alpha; }
            }
            float p[16], psum = 0.f;
#pragma unroll
            for (int i = 0; i < 16; ++i) { p[i] = __builtin_amdgcn_exp2f(s[i] - mj); psum += p[i]; }
            lsum += psum;
            u32x4 w0, w1;
            w0.x = pk2(p[0], p[1]); w0.y = pk2(p[2], p[3]); w0.z = pk2(p[4], p[5]); w0.w = pk2(p[6], p[7]);
            w1.x = pk2(p[8], p[9]); w1.y = pk2(p[10], p[11]); w1.z = pk2(p[12], p[13]); w1.w = pk2(p[14], p[15]);
            const bf16x8 pf0 = __builtin_bit_cast(bf16x8, w0), pf1 = __builtin_bit_cast(bf16x8, w1);
            o0 = MFMA32(vf[0], pf0, o0); o0 = MFMA32(vf[1], pf1, o0);
            o1 = MFMA32(vf[2], pf0, o1); o1 = MFMA32(vf[3], pf1, o1);
        }
        m -= slope2 * (float)(t - 256 * n);
        ltot = sum_x32(lsum);
    }
    hook();
    if (wave_any) {
        const float inv = 1.0f / ltot;
        if (valid) {
            const size_t pidx = ((size_t)hh * SEQ + t) * 4 + slot;
            if (hi == 0) { float* pm = (float*)(F.ws + WS_PM) + pidx * 2; pm[0] = m; pm[1] = ltot; }
            bf16_t* od = (bf16_t*)(F.ws + WS_PO) + pidx * 64 + 4 * hi;
#pragma unroll
            for (int g4 = 0; g4 < 4; ++g4) {
                u32x2 w; w.x = pk2(o0[4 * g4] * inv, o0[4 * g4 + 1] * inv); w.y = pk2(o0[4 * g4 + 2] * inv, o0[4 * g4 + 3] * inv); *(u32x2*)(od + 8 * g4) = w;
                u32x2 z; z.x = pk2(o1[4 * g4] * inv, o1[4 * g4 + 1] * inv); z.y = pk2(o1[4 * g4 + 2] * inv, o1[4 * g4 + 3] * inv); *(u32x2*)(od + 32 + 8 * g4) = z;
            }
        }
    }
    __syncthreads();
}
DI int grab_unit(unsigned* ctr, int lane) {
    int u = 0;
    if (lane == 0) u = (int)__hip_atomic_fetch_add(ctr, 1u, __ATOMIC_RELAXED, __HIP_MEMORY_SCOPE_AGENT);
    return __builtin_amdgcn_readfirstlane(u);
}
DI void phase_attention(Frame& F, int l, int rep) {
    const int tid = F.tid, lane = F.lane, wave = F.wave;
    LAS float* kmean = (LAS float*)F.lds;
    LAS float* fpre = (LAS float*)(F.lds + ATT_FPRE_OFF);
    LAS unsigned* cntl = (LAS unsigned*)(F.lds + ATT_SELM_OFF);
    LAS float* misc = (LAS float*)(F.lds + ATT_MISC_OFF);
    const float* ksum = (const float*)(F.ws + WS_KSUM);
    if (tid < 4) { const float* ft = (const float*)(F.ws + WS_FTILE) + tid * 256; float run = 0.f;
        for (int i = 0; i < 256; ++i) { fpre[tid * 256 + i] = run; run += ft[i]; } }
    if (wave == 1) {
        const float gq = wave_max(fabsf(F.in(I_FQG)[l * 64 + lane])), gk = wave_max(fabsf(F.in(I_FKG)[l * 64 + lane]));
        if (lane == 0) misc[0] = (40.0f + 2.0f * 8.0f * 1.03f * gq * gk) * LOG2E;
    }
    if (rep == 0) {
        for (int idx = tid; idx < 4 * 64 * 64; idx += NTHREADS) {
            const int h2 = idx >> 12, n = (idx >> 6) & 63, d = idx & 63;
            const float* kp = ksum + ((size_t)h2 * 256 + 4 * n) * 64 + d;
            kmean[idx] = ((kp[0] + kp[64]) + (kp[128] + kp[192])) * (1.0f / 256.0f);
        }
        unsigned* bcnt = F.ctl + CW_BCNT + 256 * l; int* blist = (int*)(F.ws + WS_BLIST);
        for (int tile = blockIdx.x; tile < SEQ / 64; tile += F.G) {
            if (tid < 256) cntl[tid] = 0u;
            __syncthreads();
            const int hh = wave >> 1, t = 64 * tile + 32 * (wave & 1) + (lane & 31);
            int sel[3]; moba_select(F, kmean, hh, t, t >> 8, sel[0], sel[1], sel[2]);
            unsigned rank[3] = {0u, 0u, 0u};
            if (lane < 32) {
#pragma unroll
                for (int j = 0; j < 3; ++j) if (sel[j] >= 0) rank[j] = __hip_atomic_fetch_add(cntl + hh * 64 + sel[j], 1u, __ATOMIC_RELAXED, __HIP_MEMORY_SCOPE_WORKGROUP);
            }
            __syncthreads();
            if (tid < 256) { const unsigned c = cntl[tid]; cntl[256 + tid] = c ? __hip_atomic_fetch_add(bcnt + tid, c, __ATOMIC_RELAXED, __HIP_MEMORY_SCOPE_AGENT) : 0u; }
            __syncthreads();
            if (lane < 32) {
#pragma unroll
                for (int j = 0; j < 3; ++j) if (sel[j] >= 0) blist[(size_t)(hh * 64 + sel[j]) * SEQ + cntl[256 + hh * 64 + sel[j]] + rank[j]] = t | (j << 16);
            }
            __syncthreads();
        }
    }
    __syncthreads();
#ifndef ATT_REP
#define ATT_REP 0
#endif
    BgConv bg; bg.init(blockIdx.x * NWAVES + wave, F.G * NWAVES, l); if (rep != 0 || !BG_CONVERT) bg.it = BG_ITEMS;
    for (int vc = blockIdx.x; vc < 256; vc += F.G) {
        const int hh = (vc & 7) >> 1, q = ((vc & 1) << 5) | (vc >> 3);
        for (int rr = 0; rr < 1 + ((ATT_REP >> 0) & 1); ++rr) { mla_wg_unit<0>(F, hh, 127 - q, bg); mla_wg_unit<0>(F, hh, q, bg); }
        if (BG_CONVERT) bg.drain(F, wave, lane);
#ifdef A_SHADOW
        mla_wg_unit<A_SHADOW>(F, hh, 127 - q, bg); mla_wg_unit<A_SHADOW>(F, hh, q, bg);
#endif
        for (int rr = 0; rr < 1 + ((ATT_REP >> 3) & 1); ++rr)
        {
            DilPre pre; DilUnit du = dil_decode(vc * 6); dil_preload(F, du, pre);
            for (int k = 0; k < 6; ++k) { const DilUnit dn = dil_decode(vc * 6 + (k < 5 ? k + 1 : k)); dil_wg_unit(F, du, pre, k < 5, dn); du = dn; }
        }
        for (int rr = 0; rr < 1 + ((ATT_REP >> 2) & 1); ++rr) { MobaPre mp; moba_request(F, hh, q, nullptr, 0, 0, true, mp); moba_block_unit(F, hh, q, 0, 0, true, mp, [] {}); }
    }
    if (BG_CONVERT) { bg.drain(F, wave, lane); bg.rest(F, wave, lane); }
    __syncthreads();
    AttnShared A; A.kmean = kmean; A.fpre = fpre; A.fox_cut = misc[0];
    unsigned* qctr = F.ctl + CW_QUEUE + 64 * (l * 4) + 1024 * rep;
    for (;;) { const int u = grab_unit(qctr + 1 * 64, lane); if (u >= 2048) break; fox_unit(F, A, u & 3, 511 - (u >> 2)); }
}
DI void phase_moba_items(Frame& F, int l, int rep) {
    const int tid = F.tid;
    LAS int* istart = (LAS int*)(F.lds + ATT_SELM_OFF);
    LAS int* bc = (LAS int*)(F.lds + ATT_SELM_OFF + 2048);
    LAS int* cur = (LAS int*)(F.lds + ATT_SELM_OFF + 4096);
    const unsigned* bcnt = F.ctl + CW_BCNT + 256 * l;
    if (tid < 256) bc[tid] = (int)__hip_atomic_load(bcnt + tid, __ATOMIC_RELAXED, __HIP_MEMORY_SCOPE_AGENT);
    __syncthreads();
    if (tid == 0) { int run = 0; for (int i = 0; i < 256; ++i) { istart[i] = run; run += (bc[i] + 255) >> 8; } istart[256] = run; }
    __syncthreads();
    const int nitems = istart[256];
    unsigned* qctr = F.ctl + CW_MQ + 64 * l + 1024 * rep;
    const int* blist = (const int*)(F.ws + WS_BLIST);
    auto grab = [&](int& b, int& q0) __attribute__((always_inline)) {
        if (tid == 0) { const int it = (int)__hip_atomic_fetch_add(qctr, 1u, __ATOMIC_RELAXED, __HIP_MEMORY_SCOPE_AGENT);
            int bb = -1, qq = 0;
            if (it < nitems) { int lo = 0, hi = 255; while (lo < hi) { const int mid = (lo + hi + 1) >> 1; if (istart[mid] <= it) lo = mid; else hi = mid - 1; } bb = lo; qq = (it - istart[lo]) << 8; }
            cur[0] = bb; cur[1] = qq; }
        __syncthreads();
        b = cur[0]; q0 = cur[1];
        __syncthreads();
    };
    MobaPre mp; int b, q0;
    grab(b, q0);
    if (b >= 0) moba_request(F, b >> 6, b & 63, blist + (size_t)b * SEQ, q0, bc[b], false, mp);
    while (b >= 0) {
        int nb = -1, nq0 = 0;
        moba_block_unit(F, b >> 6, b & 63, q0, bc[b], false, mp, [&] { grab(nb, nq0); if (nb >= 0) moba_request(F, nb >> 6, nb & 63, blist + (size_t)nb * SEQ, nq0, bc[nb], false, mp); });
        b = nb; q0 = nq0;
    }
}
DI void phase_moba_combine(Frame& F) {
    const int lane = F.lane, sub = lane & 15;
    bf16_t* o = (bf16_t*)(F.ws + WS_O);
    const int gw = blockIdx.x * NWAVES + F.wave, NGW = F.G * NWAVES;
    for (int it0 = gw; it0 < 2 * SEQ; it0 += 2 * NGW) {
        f32x2_t pmv[2][4]; u32x2 pov[2][4]; int tt[2], hh2[2], wh[2], ns[2]; bool act[2];
#pragma unroll
        for (int q = 0; q < 2; ++q) {
            const int it = it0 + q * NGW; act[q] = it < 2 * SEQ; const int itc = act[q] ? it : it0;
            const int which = itc >= SEQ;
            const int pair = (itc - which * SEQ) * 4 + (lane >> 4), t = pair >> 2, hh = pair & 3;
            const float* pm = (const float*)(F.ws + (which ? WS_DM : WS_PM)); const bf16_t* po = (const bf16_t*)(F.ws + (which ? WS_DO : WS_PO));
            const size_t base = ((size_t)hh * SEQ + t) * 4;
            tt[q] = t; hh2[q] = hh; wh[q] = which; ns[q] = which ? 3 : ((t >> 8) < 3 ? (t >> 8) : 3);
#pragma unroll
            for (int j = 0; j < 4; ++j) { pmv[q][j] = *(const f32x2_t*)(pm + (base + j) * 2); pov[q][j] = *(const u32x2*)(po + (base + j) * 64 + 4 * sub); }
        }
#pragma unroll
        for (int q = 0; q < 2; ++q) {
            if (!act[q]) break;
            float mj[4], lj[4]; float M = -1e30f;
#pragma unroll
            for (int j = 0; j < 4; ++j) { const bool use = (j == 3) ? !wh[q] : (j < ns[q]); mj[j] = use ? pmv[q][j].x : -1e30f; lj[j] = use ? pmv[q][j].y : 0.f; M = fmaxf(M, mj[j]); }
            float acc[4] = {0.f, 0.f, 0.f, 0.f}, W = 0.f;
#pragma unroll
            for (int j = 0; j < 4; ++j) { const bool use = (j == 3) ? !wh[q] : (j < ns[q]);
                const float w = use ? lj[j] * __builtin_amdgcn_exp2f(mj[j] - M) : 0.f; W += w; const u32x2 v = pov[q][j];
                if (use) {
                acc[0] += w * bf2f((bf16_t)(v.x & 0xffffu)); acc[1] += w * bf2f((bf16_t)(v.x >> 16)); acc[2] += w * bf2f((bf16_t)(v.y & 0xffffu)); acc[3] += w * bf2f((bf16_t)(v.y >> 16)); } }
            const float inv = 1.0f / W;
            u32x2 r; r.x = pk2(acc[0] * inv, acc[1] * inv); r.y = pk2(acc[2] * inv, acc[3] * inv);
            *(u32x2*)(o + (size_t)tt[q] * DM + ((wh[q] ? 12 : 8) + hh2[q]) * 64 + 4 * sub) = r;
        }
    }
}

struct EpiGateRes {
    static constexpr bool PERM = false, AFTER_DRAIN = false;
    const float* xin; float* xout; const float* gate;
    DI void operator()(const pg8::f32x4 (&acc)[2][2][4][2], const pg8::Unit& u, int wr, int wc, int fr, int fq) const {
        const int row0 = u.pm * 256 + wr * 64 + fr, col0 = u.pn * 256 + wc * 32 + 4 * fq;
        pg8::f32x4 gv[2][2];
#pragma unroll
        for (int bj = 0; bj < 2; ++bj)
#pragma unroll
            for (int n = 0; n < 2; ++n) gv[bj][n] = *(const pg8::f32x4*)(gate + col0 + bj * 128 + n * 16);
        pg8::f32x4 xa[2][2], xb[2][2];
#define EGR_LOAD(x_, g_) do { const size_t o_ = (size_t)(row0 + ((g_) >> 2) * 128 + ((g_) & 3) * 16) * DM + col0; _Pragma("unroll") for (int bj = 0; bj < 2; ++bj) _Pragma("unroll") for (int n = 0; n < 2; ++n) x_[bj][n] = *(const pg8::f32x4*)(xin + o_ + bj * 128 + n * 16); } while (0)
#define EGR_STORE(x_, g_) do { const size_t o_ = (size_t)(row0 + ((g_) >> 2) * 128 + ((g_) & 3) * 16) * DM + col0; _Pragma("unroll") for (int bj = 0; bj < 2; ++bj) _Pragma("unroll") for (int n = 0; n < 2; ++n) \
            *(pg8::f32x4*)(xout + o_ + bj * 128 + n * 16) = x_[bj][n] + gv[bj][n] * acc[(g_) >> 2][bj][(g_) & 3][n]; } while (0)
        EGR_LOAD(xa, 0);
        EGR_LOAD(xb, 1); EGR_STORE(xa, 0);
        EGR_LOAD(xa, 2); EGR_STORE(xb, 1);
        EGR_LOAD(xb, 3); EGR_STORE(xa, 2);
        EGR_LOAD(xa, 4); EGR_STORE(xb, 3);
        EGR_LOAD(xb, 5); EGR_STORE(xa, 4);
        EGR_LOAD(xa, 6); EGR_STORE(xb, 5);
        EGR_LOAD(xb, 7); EGR_STORE(xa, 6);
        EGR_STORE(xb, 7);
#undef EGR_LOAD
#undef EGR_STORE
    }
};
#ifndef GROUPED_2D
#define GROUPED_2D 1
#endif
struct GroupedOrder {
    const LAS int* tile_e; int nMt, NT, G, c;
    const LAS int* tile0; const LAS int* ecnt; const int* inv;
    DI bool next(int i, pg8::Unit& u) const {
        int mt, nt;
        if (GROUPED_2D) {
            const int x = c & 7, j = i * (G >> 3) + (c >> 3);
            if (NT == 8) { mt = (j >> 1) * 2 + (x >> 2); nt = 2 * (x & 3) + (j & 1); }
            else         { mt = (j >> 1) * 4 + (x >> 1); nt = 2 * (x & 1) + (j & 1); }
            if (mt >= nMt) return false;
        } else {
            const long L = (long)i * G + c; if (L >= (long)nMt * NT) return false;
            mt = (int)(L / NT); nt = (int)(L % NT);
        }
        u.pm = mt; u.pn = tile_e[mt] * NT + nt; return true;
    }
    DI int arow(const pg8::Unit& u, int r) const { const int e = u.pn / NT, slot = (u.pm - tile0[e]) * 256 + r; return slot < ecnt[e] ? inv[e * SEQ + slot] : 0; }
    unsigned* ycnt; int role; unsigned* tmo;
    DI void done(const pg8::Unit& u) const {
        if (role == 1) { asm volatile("s_waitcnt vmcnt(0)" ::: "memory");
            if ((threadIdx.x & 63) == 0) __hip_atomic_fetch_add(ycnt + 64 * u.pm, 1u, __ATOMIC_RELAXED, __HIP_MEMORY_SCOPE_AGENT); }
    }
    DI void a_ready(const pg8::Unit& u) const {
        if (role == 2) {
            if (threadIdx.x < 64) {
                const unsigned long long t0 = __builtin_amdgcn_s_memrealtime(); unsigned polls = 0;
                while ((unsigned)__builtin_amdgcn_readfirstlane(__hip_atomic_load(ycnt + 64 * u.pm, __ATOMIC_RELAXED, __HIP_MEMORY_SCOPE_AGENT)) < 64u) {
                    if ((++polls & 255u) == 0u && __builtin_amdgcn_readfirstlane(__hip_atomic_load(tmo, __ATOMIC_RELAXED, __HIP_MEMORY_SCOPE_AGENT)) != 0u) break;
                    if (__builtin_amdgcn_s_memrealtime() - t0 > 2000000ull) { if (threadIdx.x == 0) __hip_atomic_store(tmo, 1u, __ATOMIC_RELAXED, __HIP_MEMORY_SCOPE_AGENT); break; }
                    __builtin_amdgcn_s_sleep(2); }
                __builtin_amdgcn_fence(__ATOMIC_ACQUIRE, "agent");
                asm volatile("s_waitcnt vmcnt(0)" ::: "memory");
            }
            asm volatile("" ::: "memory"); __builtin_amdgcn_s_barrier(); asm volatile("" ::: "memory");
        }
    }
};
template <bool WT> struct EpiSwigluT {
    static constexpr bool PERM = true, AFTER_DRAIN = false;
    bf16_t* Y; const float* b1;
    DI void operator()(const pg8::f32x4 (&acc)[2][2][4][2], const pg8::Unit& u, int wr, int wc, int fr, int fq) const {
        const int e = u.pn >> 3, nt = u.pn & 7;
        const int row0 = u.pm * 256 + wr * 64 + fr, col0 = nt * 128 + wc * 32 + 8 * fq;
        const float* bp = b1 + (size_t)e * 2048 + col0;
        const float sc = UP_FP8 ? WINV : 1.0f;
        pg8::f32x4 bgv[2], buv[2];
#pragma unroll
        for (int n = 0; n < 2; ++n) { bgv[n] = *(const pg8::f32x4*)(bp + 4 * n); buv[n] = *(const pg8::f32x4*)(bp + 1024 + 4 * n); }
#pragma unroll
        for (int ai = 0; ai < 2; ++ai)
#pragma unroll
            for (int m = 0; m < 4; ++m) {
                float y[8];
#pragma unroll
                for (int n = 0; n < 2; ++n) { const pg8::f32x4 gg = acc[ai][0][m][n] * sc + bgv[n], uu = acc[ai][1][m][n] * sc + buv[n];
#pragma unroll
                    for (int j = 0; j < 4; ++j) { const float g = fminf(gg[j], 7.0f), uc = fminf(fmaxf(uu[j], -7.0f), 7.0f);
                        y[4 * n + j] = (uc + 1.0f) * g * __builtin_amdgcn_rcpf(1.0f + __builtin_amdgcn_exp2f(-1.702f * LOG2E * g)); } }
                const size_t ro = (size_t)(row0 + ai * 128 + m * 16) * FEXP + col0;
                if (MOE_FP8) { GAS unsigned long long* y8 = (GAS unsigned long long*)((unsigned char*)Y + ro);
                    const unsigned long long v8 = ((unsigned long long)pk4_fp8(y[4], y[5], y[6], y[7]) << 32) | pk4_fp8(y[0], y[1], y[2], y[3]);
                    if (WT) __hip_atomic_store(y8, v8, __ATOMIC_RELAXED, __HIP_MEMORY_SCOPE_AGENT); else *y8 = v8; }
                else { const u32x4 w = pack8(y); GAS unsigned long long* yp = (GAS unsigned long long*)(Y + ro);
                    if (WT) { __hip_atomic_store(yp, ((unsigned long long)w.y << 32) | w.x, __ATOMIC_RELAXED, __HIP_MEMORY_SCOPE_AGENT); __hip_atomic_store(yp + 1, ((unsigned long long)w.w << 32) | w.z, __ATOMIC_RELAXED, __HIP_MEMORY_SCOPE_AGENT); }
                    else *(GAS u32x4*)yp = w; }
                asm volatile("" ::: "memory");
            }
    }
};
struct EpiDown {
    static constexpr bool PERM = true, AFTER_DRAIN = false;
    bf16_t* Y; const float* b2;
    DI void operator()(const pg8::f32x4 (&acc)[2][2][4][2], const pg8::Unit& u, int wr, int wc, int fr, int fq) const {
        const int e = u.pn >> 2, nt = u.pn & 3;
        const int row0 = u.pm * 256 + wr * 64 + fr, col0 = nt * 256 + wc * 32 + 8 * fq;
        const float* bp = b2 + (size_t)e * DM + col0;
        pg8::f32x4 bv[2][2];
#pragma unroll
        for (int bj = 0; bj < 2; ++bj)
#pragma unroll
            for (int n = 0; n < 2; ++n) bv[bj][n] = *(const pg8::f32x4*)(bp + bj * 128 + 4 * n);
#pragma unroll
        for (int ai = 0; ai < 2; ++ai)
#pragma unroll
            for (int m = 0; m < 4; ++m)
#pragma unroll
                for (int bj = 0; bj < 2; ++bj) {
                    const pg8::f32x4 v0 = acc[ai][bj][m][0] * (MOE_FP8 ? WINV : 1.0f) + bv[bj][0], v1 = acc[ai][bj][m][1] * (MOE_FP8 ? WINV : 1.0f) + bv[bj][1];
                    u32x4 w; w.x = pk2(v0[0], v0[1]); w.y = pk2(v0[2], v0[3]); w.z = pk2(v1[0], v1[1]); w.w = pk2(v1[2], v1[3]);
                    *(u32x4*)(Y + (size_t)(row0 + ai * 128 + m * 16) * DM + col0 + bj * 128) = w;
                }
    }
};

DI void phase_router(Frame& F, int l) {
    const int tid = F.tid, lane = F.lane, wave = F.wave;
    constexpr int WST = 1028;
    LAS float* wrt = (LAS float*)F.lds;
    LAS unsigned* cnt = (LAS unsigned*)(F.lds + 131584);
    LAS unsigned* basew = (LAS unsigned*)(F.lds + 131584 + 128);
    LAS int* info_e = (LAS int*)(F.lds + 131584 + 256);
    LAS float* info_g = (LAS float*)(F.lds + 131584 + 256 + 1024);
    const float* rw = F.in(I_RW) + (size_t)l * DM * NEXP;
    for (int idx = tid; idx < DM * NEXP; idx += NTHREADS) { const int c = idx >> 5, e = idx & 31; wrt[e * WST + c] = rw[idx]; }
    const float* mod = (const float*)(F.ws + WS_META + META_MOD) + l * 6144;
    const float* x1 = (const float*)(F.ws + WS_X1);
    bf16_t* h2 = (bf16_t*)(F.ws + WS_H);
    int* toki = (int*)(F.ws + WS_TOKI); float* tokg = (float*)(F.ws + WS_TOKI + 256 * 1024);
    unsigned* gcnt = F.ctl + CW_ECNT + 64 * l;
    for (int tile = blockIdx.x; tile < SEQ / 64; tile += F.G) {
        if (tid < 32) cnt[tid] = 0u;
        __syncthreads();
        LAS float* lg = (LAS float*)(F.lds + 131584 + 256 + 2048) + wave * 48;
#ifndef RROWS
#define RROWS 1
#endif
#pragma unroll 1
        for (int rr = 0; rr < 8; rr += RROWS) {
            f32x4 hv[RROWS][4];
#pragma unroll
            for (int q = 0; q < RROWS; ++q) {
                const int tok = tile * 64 + wave * 8 + rr + q;
                const f32x4* xr = (const f32x4*)(x1 + (size_t)tok * DM) + lane;
                f32x4 v[4]; float ss = 0.f;
#pragma unroll
                for (int j = 0; j < 4; ++j) { v[j] = xr[64 * j]; ss += (v[j].x * v[j].x + v[j].y * v[j].y) + (v[j].z * v[j].z + v[j].w * v[j].w); }
                ss = wave_sum(ss);
                const float rstd = 1.0f / sqrtf(ss * (1.0f / DM) + EPS);
#pragma unroll
                for (int j = 0; j < 4; ++j) { const int c = 4 * lane + 256 * j;
                    const f32x4 g4 = *(const f32x4*)(F.in(I_N2G) + l * DM + c), s4 = *(const f32x4*)(mod + 4 * DM + c), h4 = *(const f32x4*)(mod + 3 * DM + c);
                    hv[q][j] = (v[j] * rstd) * g4 * (s4 + 1.0f) + h4;
                    if (UP_FP8) *(unsigned*)((unsigned char*)(F.ws + WS_H8) + (size_t)tok * DM + c) = pk4_fp8(hv[q][j].x, hv[q][j].y, hv[q][j].z, hv[q][j].w);
                    else { u32x2 w; w.x = pk2(hv[q][j].x, hv[q][j].y); w.y = pk2(hv[q][j].z, hv[q][j].w); *(u32x2*)(h2 + (size_t)tok * DM + c) = w; } }
            }
            float pe[RROWS][32];
#pragma unroll
            for (int e = 0; e < 32; ++e) { float a[RROWS];
#pragma unroll
                for (int q = 0; q < RROWS; ++q) a[q] = 0.f;
#pragma unroll
                for (int j = 0; j < 4; ++j) { const f32x4 w4 = *(const LAS f32x4*)(wrt + e * WST + 4 * lane + 256 * j);
#pragma unroll
                    for (int q = 0; q < RROWS; ++q) a[q] += hv[q][j].x * w4.x + hv[q][j].y * w4.y + hv[q][j].z * w4.z + hv[q][j].w * w4.w; }
#pragma unroll
                for (int q = 0; q < RROWS; ++q) pe[q][e] = a[q]; if ((e & 1) == 1) asm volatile("" ::: "memory"); }
            const int my_e = ((lane >> 5) & 1) * 16 + ((lane >> 4) & 1) * 8 + ((lane >> 3) & 1) * 4 + ((lane >> 2) & 1) * 2 + ((lane >> 1) & 1);
#pragma unroll
            for (int q = 0; q < RROWS; ++q) {
                const int tl = wave * 8 + rr + q;
                { const bool up = (lane & 32) != 0;
#pragma unroll
                  for (int e = 0; e < 16; ++e) { const float send = up ? pe[q][e] : pe[q][e + 16], keep = up ? pe[q][e + 16] : pe[q][e]; pe[q][e] = keep + __shfl_xor(send, 32); } }
                { const bool up = (lane & 16) != 0;
#pragma unroll
                  for (int e = 0; e < 8; ++e) { const float send = up ? pe[q][e] : pe[q][e + 8], keep = up ? pe[q][e + 8] : pe[q][e]; pe[q][e] = keep + __shfl_xor(send, 16); } }
                { const bool up = (lane & 8) != 0;
#pragma unroll
                  for (int e = 0; e < 4; ++e) { const float send = up ? pe[q][e] : pe[q][e + 4], keep = up ? pe[q][e + 4] : pe[q][e]; pe[q][e] = keep + __shfl_xor(send, 8); } }
                { const bool up = (lane & 4) != 0;
#pragma unroll
                  for (int e = 0; e < 2; ++e) { const float send = up ? pe[q][e] : pe[q][e + 2], keep = up ? pe[q][e + 2] : pe[q][e]; pe[q][e] = keep + __shfl_xor(send, 4); } }
                { const bool up = (lane & 2) != 0; const float send = up ? pe[q][0] : pe[q][1], keep = up ? pe[q][1] : pe[q][0]; pe[q][0] = keep + __shfl_xor(send, 2); }
                pe[q][0] += __shfl_xor(pe[q][0], 1);
                const float val = pe[q][0] + F.in(I_RB)[l * NEXP + my_e];
                asm volatile("s_waitcnt lgkmcnt(0)" ::: "memory");
                if ((lane & 1) == 0) lg[my_e] = val;
                asm volatile("s_waitcnt lgkmcnt(0)" ::: "memory");
                const int ee = lane & 31; const float mine = lg[ee];
                int rank = 0;
#pragma unroll
                for (int j4 = 0; j4 < 8; ++j4) { const f32x4 t4 = *(const LAS f32x4*)(lg + 4 * j4);
                    rank += (t4.x > mine || (t4.x == mine && 4 * j4 + 0 < ee)) ? 1 : 0; rank += (t4.y > mine || (t4.y == mine && 4 * j4 + 1 < ee)) ? 1 : 0;
                    rank += (t4.z > mine || (t4.z == mine && 4 * j4 + 2 < ee)) ? 1 : 0; rank += (t4.w > mine || (t4.w == mine && 4 * j4 + 3 < ee)) ? 1 : 0; }
                if (lane < 32 && rank < 4) { lg[32 + rank] = mine; lg[36 + rank] = __int_as_float(ee); }
                asm volatile("s_waitcnt lgkmcnt(0)" ::: "memory");
                const f32x4 tv4 = *(const LAS f32x4*)(lg + 32), te4 = *(const LAS f32x4*)(lg + 36);
                const float e1 = __expf(tv4.y - tv4.x), e2 = __expf(tv4.z - tv4.x), e3 = __expf(tv4.w - tv4.x);
                const float rs = 1.0f / (1.0f + e1 + e2 + e3);
                if (lane < 4) {
                    const int sel = __float_as_int(lane == 0 ? te4.x : lane == 1 ? te4.y : lane == 2 ? te4.z : te4.w);
                    const float gg = (lane == 0 ? 1.0f : lane == 1 ? e1 : lane == 2 ? e2 : e3) * rs;
                    const unsigned slot = __hip_atomic_fetch_add(cnt + sel, 1u, __ATOMIC_RELAXED, __HIP_MEMORY_SCOPE_WORKGROUP);
                    info_e[tl * 4 + lane] = (sel << 20) | (int)slot; info_g[tl * 4 + lane] = gg;
                }
                asm volatile("s_waitcnt lgkmcnt(0)" ::: "memory");
            }
        }
        __syncthreads();
        if (tid < 32) basew[tid] = __hip_atomic_fetch_add(gcnt + tid, cnt[tid], __ATOMIC_RELAXED, __HIP_MEMORY_SCOPE_AGENT);
        __syncthreads();
        if (tid < 256) { const int ie = info_e[tid]; const int ee = ie >> 20, slot = ie & 0xfffff;
            const int fs = (int)(basew[ee] + (unsigned)slot);
            toki[(size_t)tile * 256 + tid] = (ee << 20) | fs; tokg[(size_t)tile * 256 + tid] = info_g[tid]; ((int*)(F.ws + WS_INV))[ee * SEQ + fs] = tile * 64 + (tid >> 2); }
        __syncthreads();
    }
}
DI void phase_gather8(Frame& F, int l) {
    const int tid = F.tid, lane = F.lane, wave = F.wave;
    LAS int* offs = (LAS int*)F.lds;
    if (tid == 0) { int run = 0; const unsigned* gcnt = F.ctl + CW_ECNT + 64 * l;
        for (int e = 0; e < NEXP; ++e) { const int c = (int)__hip_atomic_load(gcnt + e, __ATOMIC_RELAXED, __HIP_MEMORY_SCOPE_AGENT); offs[e] = run; run += ((c + 255) / 256) * 256; }
        offs[32] = run; }
    __syncthreads();
    const int* toki = (const int*)(F.ws + WS_TOKI);
    const unsigned char* h8 = (const unsigned char*)(F.ws + WS_H8); unsigned char* xs = (unsigned char*)(F.ws + WS_XS);
    const int gw = blockIdx.x * NWAVES + wave, NGW = F.G * NWAVES;
#pragma unroll 4
    for (int item = gw; item < SEQ * TOPK; item += NGW) {
        const int ie = toki[item], ee = ie >> 20, slot = ie & 0xfffff, tok = item >> 2;
        const size_t row = (size_t)offs[ee] + slot;
        *((u32x4*)(xs + row * DM) + lane) = *((const u32x4*)(h8 + (size_t)tok * DM) + lane);
    }
}
constexpr int ETAB_OFF = 131072;
DI void build_expert_tables(Frame& F, int l) {
    LAS int* tile_e = (LAS int*)(F.lds + ETAB_OFF); LAS int* tile0 = tile_e + 512; LAS int* ecnt = tile0 + 32;
    if (F.tid == 0) { int run = 0; const unsigned* gcnt = F.ctl + CW_ECNT + 64 * l;
        int* goff = (int*)(F.ws + WS_META + META_OFF) + l * 64; int* gtile = (int*)(F.ws + WS_META + META_TILE) + l * 512;
        for (int e = 0; e < NEXP; ++e) { const int c = (int)__hip_atomic_load(gcnt + e, __ATOMIC_RELAXED, __HIP_MEMORY_SCOPE_AGENT); ecnt[e] = c; tile0[e] = run >> 8;
            for (int i = 0; i < (c + 255) / 256; ++i) tile_e[(run >> 8) + i] = e;
            if (blockIdx.x == 0) { goff[e] = run; for (int i = 0; i < (c + 255) / 256; ++i) gtile[(run >> 8) + i] = e; }
            run += ((c + 255) / 256) * 256; }
        tile_e[511] = run >> 8; if (blockIdx.x == 0) { goff[32] = run; gtile[511] = run >> 8; } }
    __syncthreads();
}
DI void phase_combine(Frame& F, int l) {
    const int lane = F.lane;
    const float* mod = (const float*)(F.ws + WS_META + META_MOD) + l * 6144;
    const int* goff = (const int*)(F.ws + WS_META + META_OFF) + l * 64;
    const int* toki = (const int*)(F.ws + WS_TOKI); const float* tokg = (const float*)(F.ws + WS_TOKI + 256 * 1024);
    const float* x1 = (const float*)(F.ws + WS_X1); const bf16_t* y2 = (const bf16_t*)(F.ws + WS_Y2);
    float* xo = (l == NLAYER - 1) ? F.ap->out : (float*)(F.ws + WS_XC);
    const int gw = blockIdx.x * NWAVES + F.wave, NGW = F.G * NWAVES;
    for (int i0 = 0; gw + NGW * i0 < SEQ; i0 += 8) {
    int myrow = 0; float mygate = 0.f;
    if (lane < 32) { const int tok = gw + NGW * (i0 + (lane >> 2)); if (tok < SEQ) { const int ie = toki[tok * 4 + (lane & 3)]; mygate = tokg[tok * 4 + (lane & 3)]; myrow = goff[ie >> 20] + (ie & 0xfffff); } }
    for (int i = 0; i < 8; i += 2) {
        const int tokA = gw + NGW * (i0 + i); if (tokA >= SEQ) break;
        const int tokB0 = gw + NGW * (i0 + i + 1); const bool hasB = tokB0 < SEQ; const int tokB = hasB ? tokB0 : tokA;
        u32x2 ya[4][4], yb[4][4]; f32x4 xa[4], xb[4]; float ga[4], gb[4];
#pragma unroll
        for (int k = 0; k < 4; ++k) {
            const int rowA = __shfl(myrow, 4 * i + k), rowB = __shfl(myrow, hasB ? 4 * i + 4 + k : 4 * i + k); ga[k] = __shfl(mygate, 4 * i + k); gb[k] = __shfl(mygate, hasB ? 4 * i + 4 + k : 4 * i + k);
            const u32x2* pa = (const u32x2*)(y2 + (size_t)rowA * DM) + lane; const u32x2* pb = (const u32x2*)(y2 + (size_t)rowB * DM) + lane;
#pragma unroll
            for (int j = 0; j < 4; ++j) { ya[k][j] = pa[64 * j]; yb[k][j] = pb[64 * j]; }
        }
#pragma unroll
        for (int j = 0; j < 4; ++j) { const int c = 4 * lane + 256 * j; xa[j] = *(const f32x4*)(x1 + (size_t)tokA * DM + c); xb[j] = *(const f32x4*)(x1 + (size_t)tokB * DM + c); }
#pragma unroll
        for (int r = 0; r < 2; ++r) {
            if (r == 1 && !hasB) break;
            const int tok = r ? tokB : tokA;
            f32x4 v[4];
#pragma unroll
            for (int j = 0; j < 4; ++j) { const int c = 4 * lane + 256 * j;
                f32x4 acc = (f32x4){0.f, 0.f, 0.f, 0.f};
#pragma unroll
                for (int k = 0; k < 4; ++k) { const u32x2 w = r ? yb[k][j] : ya[k][j]; const float g = r ? gb[k] : ga[k];
                    acc.x += g * bf2f((bf16_t)(w.x & 0xffffu)); acc.y += g * bf2f((bf16_t)(w.x >> 16)); acc.z += g * bf2f((bf16_t)(w.y & 0xffffu)); acc.w += g * bf2f((bf16_t)(w.y >> 16)); }
                const f32x4 g2 = *(const f32x4*)(mod + 5 * DM + c);
                v[j] = (r ? xb[j] : xa[j]) + g2 * acc;
                *(f32x4*)(xo + (size_t)tok * DM + c) = v[j]; }
            if (l + 1 < NLAYER) { const float* mod1 = (const float*)(F.ws + WS_META + META_MOD) + (l + 1) * 6144;
                norm_mod_store(v, F.in(I_N1G) + (l + 1) * DM, mod1 + 1 * DM, mod1 + 0 * DM, (bf16_t*)(F.ws + WS_H) + (size_t)tok * DM, lane); }
        }
    }
    }
}

#ifndef PH_MASK
#define PH_MASK 0xFFFFF
#endif
#define PHON(k) (((PH_MASK) >> (k)) & 1)
#ifndef REP_MASK
#define REP_MASK 0
#endif
#define NREP(k) ((((REP_MASK) >> (k)) & 1) ? 2 : 1)
constexpr int N_PHASES = 2 + 11 * NLAYER;
__global__ void __launch_bounds__(NTHREADS, 2) mk_fwd(Args args) {
    extern __shared__ __attribute__((aligned(16))) unsigned char lds_raw[];
    Frame F;
    F.lds = (LAS unsigned char*)lds_raw; F.ws = args.ws; F.ctl = (unsigned*)(args.ws + WS_CTL);
    F.ap = (KArgP)__builtin_amdgcn_kernarg_segment_ptr();
    F.refresh(); F.G = gridDim.x;
    volatile LAS unsigned* MISC = (volatile LAS unsigned*)(F.lds + LDSCTL_OFF);
    for (int u = F.tid; u < (LDS_BYTES - LDSCTL_OFF) / 4; u += NTHREADS) MISC[u] = 0u;
    __syncthreads();
    const int lo = args.ph_lo, hi = args.ph_hi;
    XcdBarrier bar; bar.bar = F.ctl + CW_BAR; bar.x = 0; bar.st = MISC + 8;
    if (hi - lo > 1) bar = xcd_barrier_post(F.ctl + CW_BAR, MISC + 8);
#define IN(k) (lo <= (k) && (k) < hi)
#define SEAM(k) do { if (IN(k) && IN((k) + 1)) xcd_barrier(bar); } while (0)
    for (int rep = 0; rep < NREP(0); ++rep) if (PHON(0) && IN(0)) { if (rep) xcd_barrier(bar); F.refresh(); phase_prologue(F); }
    SEAM(0);
    for (int rep = 0; rep < NREP(1); ++rep) if (PHON(1) && IN(1)) { if (rep) xcd_barrier(bar); F.refresh(); phase_norm1_l0(F); }
    SEAM(1);
#ifdef EXTRA_BARS
    for (int xb = 0; xb < EXTRA_BARS; ++xb) xcd_barrier(bar);
#endif
    for (int l = 0; l < NLAYER; ++l) {
        const int pb = 2 + 11 * l;
        const float* mod = (const float*)(F.ws + WS_META + META_MOD) + l * 6144;
        for (int rep = 0; rep < NREP(2); ++rep) if (PHON(2) && IN(pb + 0)) { if (rep) xcd_barrier(bar);
            pg8::Gemm g{(const pg8::bf16_t*)(F.ws + WS_H), (const pg8::bf16_t*)(F.ws + WS_W1T) + (size_t)l * NP * DM, SEQ, NP, DM};
            pg8::StaticOrder S; S.init(SEQ, NP, F.G, (int)blockIdx.x);
            pg8::EpiBf16Plain E{(pg8::bf16_t*)(F.ws + WS_PROJ), NP};
            pg8::gemm_phase<pg8::EpiBf16Plain, pg8::StaticOrder>(F.lds, g, S, E, nullptr);
        }
        SEAM(pb + 0);
        for (int rep = 0; rep < NREP(3); ++rep) if (PHON(3) && IN(pb + 1)) { if (rep) xcd_barrier(bar); F.refresh(); phase_postproj(F, l); }
        SEAM(pb + 1);
        for (int rep = 0; rep < NREP(4); ++rep) if (PHON(4) && IN(pb + 2)) { if (rep) xcd_barrier(bar); F.refresh(); phase_attention(F, l, rep); }
        SEAM(pb + 2);
        for (int rep = 0; rep < NREP(5); ++rep) if (PHON(5) && IN(pb + 3)) { if (rep) xcd_barrier(bar); F.refresh(); phase_moba_items(F, l, rep); }
        SEAM(pb + 3);
        for (int rep = 0; rep < NREP(6); ++rep) if (PHON(6) && IN(pb + 4)) { if (rep) xcd_barrier(bar); F.refresh(); phase_moba_combine(F); }
        SEAM(pb + 4);
        for (int rep = 0; rep < NREP(7); ++rep) if (PHON(7) && IN(pb + 5)) { if (rep) xcd_barrier(bar);
            pg8::Gemm g{(const pg8::bf16_t*)(F.ws + WS_O), (const pg8::bf16_t*)(F.ws + WS_WOT) + (size_t)l * DM * DM, SEQ, DM, DM};
            pg8::StaticOrder S; S.init(SEQ, DM, F.G, (int)blockIdx.x);
            EpiGateRes E{(l == 0) ? F.in(I_X) : (const float*)(F.ws + WS_XC), (float*)(F.ws + WS_X1), mod + 2 * DM};
            pg8::gemm_phase<EpiGateRes, pg8::StaticOrder>(F.lds, g, S, E, nullptr);
        }
        SEAM(pb + 5);
        for (int rep = 0; rep < NREP(8); ++rep) if (PHON(8) && IN(pb + 6)) { if (rep) xcd_barrier(bar); F.refresh(); phase_router(F, l); }
        SEAM(pb + 6);
#ifndef GATHER8_PHASE
#define GATHER8_PHASE 0
#endif
        for (int rep = 0; rep < NREP(9); ++rep) if (UP_FP8 && GATHER8_PHASE && PHON(9) && IN(pb + 7)) { if (rep) xcd_barrier(bar); F.refresh(); phase_gather8(F, l); }
        if (UP_FP8 && GATHER8_PHASE) SEAM(pb + 7);
#ifndef FUSE_UPDOWN
#define FUSE_UPDOWN 0
#endif
        for (int rep = 0; rep < NREP(10); ++rep) if (PHON(10) && IN(pb + 8)) { if (rep) xcd_barrier(bar);
            F.refresh(); build_expert_tables(F, l);
            const LAS int* ltile = (const LAS int*)(F.lds + ETAB_OFF);
            unsigned* ycnt = F.ctl + CW_YCNT + 32768 * l + 16384 * rep;
            {
            pg8::Gemm g{(const pg8::bf16_t*)(F.ws + (UP_FP8 ? (GATHER8_PHASE ? WS_XS : WS_H8) : WS_H)), (const pg8::bf16_t*)(F.ws + WS_WE1 + (size_t)l * NEXP * 2048 * DM * (UP_FP8 ? 1 : 2)), (UP_FP8 && GATHER8_PHASE) ? MAXROWS : SEQ, NEXP * 2048, DM};
            GroupedOrder S{ltile, ltile[511], 8, F.G, (int)blockIdx.x, ltile + 512, ltile + 544, (const int*)(F.ws + WS_INV), ycnt, FUSE_UPDOWN ? 1 : 0, F.ctl};
            typedef EpiSwigluT<(FUSE_UPDOWN != 0)> EpiSwiglu; EpiSwiglu E{(bf16_t*)(F.ws + WS_Y1), F.in(I_EB1) + (size_t)l * NEXP * 2048};
            pg8::gemm_phase<EpiSwiglu, GroupedOrder, false, !(UP_FP8 && GATHER8_PHASE), UP_FP8 ? 1 : 2>(F.lds, g, S, E, nullptr);
            }
            if (FUSE_UPDOWN) {
            unsigned ldsb = (unsigned)(size_t)F.lds, tb = (unsigned)(size_t)ltile; unsigned long long yc = (unsigned long long)ycnt;
            asm volatile("" : "+s"(ldsb), "+s"(tb), "+s"(yc));
            LAS unsigned char* lds2 = (LAS unsigned char*)(size_t)ldsb; const LAS int* ltile2 = (const LAS int*)(size_t)tb; unsigned* ycnt2 = (unsigned*)yc;
            pg8::Gemm g{(const pg8::bf16_t*)(F.ws + WS_Y1), (const pg8::bf16_t*)(F.ws + WS_WE2 + (size_t)l * NEXP * DM * FEXP * (MOE_FP8 ? 1 : 2)), MAXROWS, NEXP * DM, FEXP};
            GroupedOrder S{ltile2, ltile2[511], 4, F.G, F.G - 1 - (int)blockIdx.x, ltile2 + 512, ltile2 + 544, nullptr, ycnt2, 2, F.ctl};
            EpiDown E{(bf16_t*)(F.ws + WS_Y2), F.in(I_EB2) + (size_t)l * NEXP * DM};
            pg8::gemm_phase<EpiDown, GroupedOrder, false, false, MOE_FP8 ? 1 : 2>(lds2, g, S, E, nullptr);
            }
        }
        SEAM(pb + 8);
        for (int rep = 0; rep < NREP(11); ++rep) if (!FUSE_UPDOWN && PHON(11) && IN(pb + 9)) { if (rep) xcd_barrier(bar);
            F.refresh(); build_expert_tables(F, l);
            const LAS int* ltile = (const LAS int*)(F.lds + ETAB_OFF);
            pg8::Gemm g{(const pg8::bf16_t*)(F.ws + WS_Y1), (const pg8::bf16_t*)(F.ws + WS_WE2 + (size_t)l * NEXP * DM * FEXP * (MOE_FP8 ? 1 : 2)), MAXROWS, NEXP * DM, FEXP};
            GroupedOrder S{ltile, ltile[511], 4, F.G, (int)blockIdx.x, ltile + 512, ltile + 544, nullptr, nullptr, 0, F.ctl};
            EpiDown E{(bf16_t*)(F.ws + WS_Y2), F.in(I_EB2) + (size_t)l * NEXP * DM};
            pg8::gemm_phase<EpiDown, GroupedOrder, false, false, MOE_FP8 ? 1 : 2>(F.lds, g, S, E, nullptr);
        }
        if (!FUSE_UPDOWN)
        SEAM(pb + 9);
        for (int rep = 0; rep < NREP(12); ++rep) if (PHON(12) && IN(pb + 10)) { if (rep) xcd_barrier(bar); F.refresh(); phase_combine(F, l); }
        SEAM(pb + 10);
    }
#undef IN
#undef SEAM
}

#ifndef MK_PER_PHASE
#define MK_PER_PHASE 0
#endif
extern "C" void kernel_launch(void* const* d_in, const int* in_sizes, int n_in, void* d_out, int out_size, void* d_ws, size_t ws_size, hipStream_t stream) {
    static int grid = 0;
    if (grid == 0) {
        if (n_in != 27 || out_size != SEQ * DM || ws_size < WS_END) { fprintf(stderr, "kernel_launch: unexpected shapes (n_in %d, out %d, ws %zu)\n", n_in, out_size, ws_size); grid = -1; return; }
        int dev = 0, cus = 0, per_cu = 0;
        if (hipGetDevice(&dev) != hipSuccess || hipDeviceGetAttribute(&cus, hipDeviceAttributeMultiprocessorCount, dev) != hipSuccess) { grid = -1; return; }
        if (hipFuncSetAttribute((const void*)mk_fwd, hipFuncAttributeMaxDynamicSharedMemorySize, LDS_BYTES) != hipSuccess) { fprintf(stderr, "kernel_launch: hipFuncSetAttribute failed\n"); grid = -1; return; }
        if (hipOccupancyMaxActiveBlocksPerMultiprocessor(&per_cu, (const void*)mk_fwd, NTHREADS, LDS_BYTES) != hipSuccess || per_cu < 1) fprintf(stderr, "kernel_launch: occupancy query reports %d\n", per_cu);
        (void)hipGetLastError();
        grid = cus - (cus % 8);
    }
    if (grid < 0) return;
    (void)in_sizes;
    if (hipMemsetAsync((char*)d_ws + WS_CTL, 0, CTL_ZERO_BYTES, stream) != hipSuccess) return;
    Args a{};
    for (int i = 0; i < 27; ++i) a.in[i] = (const float*)d_in[i];
    a.out = (float*)d_out; a.ws = (unsigned char*)d_ws;
#if MK_PER_PHASE
    for (int p = 0; p < N_PHASES; ++p) { a.ph_lo = p; a.ph_hi = p + 1; hipLaunchKernelGGL(mk_fwd, dim3(grid), dim3(NTHREADS), LDS_BYTES, stream, a); }
#else
    a.ph_lo = 0; a.ph_hi = N_PHASES;
    hipLaunchKernelGGL(mk_fwd, dim3(grid), dim3(NTHREADS), LDS_BYTES, stream, a);
#endif
}
```
